# Optimizing an MI355X kernel written in HIP

```python
import math
import jax, jax.numpy as jnp
from jax import lax
import numpy as np

D_MODEL = 1024
BATCH = 2
SEQ = 8192
DEPTH = 2
DEC_BATCH = 8
DEC_SEQ = 8192
PAST_LEN = 128

GRID_W = 64
HEAD_DIM = 64
GROUP_W = D_MODEL // 4
N_HEADS_A = GROUP_W // HEAD_DIM
N_GROUPS_B = GROUP_W // HEAD_DIM
HY_CH = GROUP_W
N_HEADS_D = GROUP_W // HEAD_DIM
KH_MAX = 8
KW = 16
HY_ORDER = 2
HY_EMB = 33
HY_BANDS = (HY_EMB - 1) // 2
HY_FILT = 64
ML_CHUNK = 128
PLE_DIM = 256
D_FF = -(-8 * D_MODEL // (3 * 256)) * 256
EPS = 1e-6
A_COLS = 3 * GROUP_W
B_COLS = GROUP_W
C_COLS = 3 * HY_CH
D_COLS = 4 * GROUP_W + 4 * N_HEADS_D
N_IN = A_COLS + B_COLS + C_COLS + D_COLS

kernel_name = 'hybrid_bidir_na_fnet_hyena_mlstm'


def rmsnorm(x, g):
    xf = x.astype(jnp.float32)
    xf = xf * lax.rsqrt(jnp.mean(xf * xf, axis=-1, keepdims=True) + EPS)
    return (xf * g.astype(jnp.float32)).astype(x.dtype)


def head_rmsnorm(y, g):
    yf = y.astype(jnp.float32)
    sh = yf.shape
    yh = yf.reshape(sh[:-1] + (sh[-1] // HEAD_DIM, HEAD_DIM))
    yh = yh * lax.rsqrt(jnp.mean(yh * yh, axis=-1, keepdims=True) + EPS)
    return (yh.reshape(sh) * g.astype(jnp.float32)).astype(y.dtype)


def neighbourhood_attention(q, k, v, rpb):
    bsz, L, _ = q.shape
    rows = L // GRID_W
    kh = min(KH_MAX, rows)
    n_keys = kh * KW
    r = np.arange(rows)
    c = np.arange(GRID_W)
    key_r = np.clip(r - kh // 2, 0, rows - kh)[:, None] + np.arange(kh)[None, :]
    key_c = np.clip(c - KW // 2, 0, GRID_W - KW)[:, None] + np.arange(KW)[None, :]
    idx = (key_r[:, None, :, None] * GRID_W + key_c[None, :, None, :]).reshape(rows, GRID_W, n_keys)
    dr = (key_r - r[:, None] + KH_MAX - 1)[:, None, :, None]
    dc = (key_c - c[:, None] + KW - 1)[None, :, None, :]
    bias = rpb.astype(jnp.float32)[:, dr, dc].reshape(N_HEADS_A, rows, GRID_W, n_keys).transpose(1, 0, 2, 3)
    qr = q.reshape(bsz, rows, GRID_W, N_HEADS_A, HEAD_DIM).transpose(1, 0, 3, 2, 4)
    kk = k.reshape(bsz, L, N_HEADS_A, HEAD_DIM).transpose(0, 2, 1, 3)
    vv = v.reshape(bsz, L, N_HEADS_A, HEAD_DIM).transpose(0, 2, 1, 3)
    scale = HEAD_DIM ** -0.5

    def one_row(args):
        q_r, idx_r, bias_r = args
        kg = jnp.take(kk, idx_r, axis=2)
        vg = jnp.take(vv, idx_r, axis=2)
        s = jnp.einsum('bhwd,bhwnd->bhwn', q_r, kg).astype(jnp.float32) * scale + bias_r[None]
        pr = jax.nn.softmax(s, axis=-1).astype(vv.dtype)
        return jnp.einsum('bhwn,bhwnd->bhwd', pr, vg)

    out = lax.map(one_row, (qr, jnp.asarray(idx, dtype=jnp.int32), bias))
    return out.transpose(1, 0, 3, 2, 4).reshape(bsz, L, N_HEADS_A * HEAD_DIM)


def fourier_mix(u, w):
    bsz, L, _ = u.shape
    uf = u.astype(jnp.float32).reshape(bsz, L, N_GROUPS_B, HEAD_DIM)
    f = jnp.fft.fft2(uf, axes=(1, 3), norm='ortho').real
    y = jnp.einsum('blgc,gcd->blgd', f, w.astype(jnp.float32))
    return y.reshape(bsz, L, N_GROUPS_B * HEAD_DIM).astype(u.dtype)


def hyena_filters(L, w1, b1, freq, w2, b2, w3, decay):
    f32 = jnp.float32
    s = jnp.arange(L, dtype=f32)
    t = s / max(L - 1, 1)
    ang = (2.0 * math.pi / L) * s
    bands = jnp.linspace(1e-4, HY_BANDS - 1, HY_BANDS, dtype=f32)
    fb = ang[:, None] * bands[None, :]
    feats = jnp.concatenate([t[:, None], jnp.cos(fb), -jnp.sin(fb)], axis=-1)
    freq = freq.astype(f32)
    h = jnp.sin(freq[0] * (feats @ w1.astype(f32) + b1.astype(f32)))
    h = jnp.sin(freq[1] * (h @ w2.astype(f32) + b2.astype(f32)))
    h = (h @ w3.astype(f32)).reshape(L, HY_ORDER, 2, HY_CH)
    h = h * jnp.exp(-t[:, None, None, None] * decay.astype(f32))
    fwd = h[:, :, 0]
    bwd = h[1:, :, 1][::-1]
    full = jnp.concatenate([fwd, jnp.zeros((1, HY_ORDER, HY_CH), f32), bwd], axis=0)
    return jnp.fft.rfft(full, axis=0)


def fftconv(u, kf, skip):
    L = u.shape[1]
    U = jnp.fft.rfft(u, n=2 * L, axis=1)
    y = jnp.fft.irfft(U * kf[None], n=2 * L, axis=1)[:, :L]
    return y + u * skip


def short_conv(z, w, b):
    zp = jnp.pad(z, ((0, 0), (1, 1), (0, 0)))
    return zp[:, :-2] * w[0] + zp[:, 1:-1] * w[1] + zp[:, 2:] * w[2] + b


def hyena(u, conv_w, conv_b, w1, b1, freq, w2, b2, w3, decay, skip):
    f32 = jnp.float32
    L = u.shape[1]
    z = short_conv(u.astype(f32), conv_w.astype(f32), conv_b.astype(f32))
    v, x1, x2 = jnp.split(z, 3, axis=-1)
    kf = hyena_filters(L, w1, b1, freq, w2, b2, w3, decay)
    skip = skip.astype(f32)
    y = x1 * fftconv(v, kf[:, 0], skip[0])
    y = x2 * fftconv(y, kf[:, 1], skip[1])
    return y.astype(u.dtype)


def mlstm_chunkwise(q, k, v, ipre, fpre):
    bsz, H, L, dh = q.shape
    nc = L // ML_CHUNK
    q = q.reshape(bsz, H, nc, ML_CHUNK, dh)
    k = k.reshape(bsz, H, nc, ML_CHUNK, dh)
    v = v.reshape(bsz, H, nc, ML_CHUNK, dh)
    lf = jax.nn.log_sigmoid(fpre).reshape(bsz, H, nc, ML_CHUNK)
    li = ipre.reshape(bsz, H, nc, ML_CHUNK)
    b = jnp.cumsum(lf, axis=-1)
    g = b[..., -1]
    a = g[..., None] - b + li
    m_loc = jnp.max(a, axis=-1)
    w = jnp.exp(a - m_loc[..., None])
    S_loc = jnp.einsum('bhnc,bhncd,bhnce->bhnde', w, k, v)
    n_loc = jnp.einsum('bhnc,bhncd->bhnd', w, k)

    def step(carry, xs):
        S, n, m = carry
        g_c, m_c, S_c, n_c = xs
        m_new = jnp.maximum(g_c + m, m_c)
        d_old = jnp.exp(g_c + m - m_new)
        d_new = jnp.exp(m_c - m_new)
        S_new = d_old[..., None, None] * S + d_new[..., None, None] * S_c
        n_new = d_old[..., None] * n + d_new[..., None] * n_c
        return (S_new, n_new, m_new), (S, n, m)

    init = (jnp.zeros((bsz, H, dh, dh), jnp.float32), jnp.zeros((bsz, H, dh), jnp.float32),
            jnp.zeros((bsz, H), jnp.float32))
    xs = (jnp.moveaxis(g, 2, 0), jnp.moveaxis(m_loc, 2, 0), jnp.moveaxis(S_loc, 2, 0), jnp.moveaxis(n_loc, 2, 0))
    _, (S0, n0, m0) = lax.scan(step, init, xs)
    S0 = jnp.moveaxis(S0, 0, 2)
    n0 = jnp.moveaxis(n0, 0, 2)
    m0 = jnp.moveaxis(m0, 0, 2)
    inter = b + m0[..., None]
    lower = np.tril(np.ones((ML_CHUNK, ML_CHUNK), dtype=bool))
    Dm = jnp.where(lower, b[..., :, None] - b[..., None, :] + li[..., None, :], -jnp.inf)
    m_t = jnp.maximum(inter, jnp.max(Dm, axis=-1))
    P = jnp.exp(Dm - m_t[..., None]) * jnp.einsum('bhncd,bhnsd->bhncs', q, k)
    wi = jnp.exp(inter - m_t)
    num = wi[..., None] * jnp.einsum('bhncd,bhnde->bhnce', q, S0) + jnp.einsum('bhncs,bhnse->bhnce', P, v)
    den = wi * jnp.einsum('bhncd,bhnd->bhnc', q, n0) + jnp.sum(P, axis=-1)
    h = num / jnp.maximum(jnp.abs(den), jnp.exp(-m_t))[..., None]
    return h.reshape(bsz, H, L, dh)


def mlstm_bidir(q, k, v, o, gates, gate_b):
    f32 = jnp.float32
    bsz, L, _ = q.shape
    def heads(t):
        return t.astype(f32).reshape(bsz, L, N_HEADS_D, HEAD_DIM).transpose(0, 2, 1, 3)
    qh = heads(q)
    kh = heads(k) * (HEAD_DIM ** -0.5)
    vh = heads(v)
    gt = (gates.astype(f32).reshape(bsz, L, 4, N_HEADS_D) + gate_b.astype(f32)).transpose(2, 0, 3, 1)
    h_f = mlstm_chunkwise(qh, kh, vh, gt[0], gt[1])
    fl = lambda t: jnp.flip(t, axis=2)
    h_b = fl(mlstm_chunkwise(fl(qh), fl(kh), fl(vh), fl(gt[2]), fl(gt[3])))
    h = (h_f + h_b).transpose(0, 2, 1, 3).reshape(bsz, L, N_HEADS_D * HEAD_DIM)
    return (jax.nn.sigmoid(o.astype(f32)) * h).astype(q.dtype)


def _layer(x, p_i, norm_mix, w_in, attn_rpb, fnet_w, hy_conv_w, hy_conv_b, hy_w1, hy_b1, hy_freq, hy_w2,
           hy_b2, hy_w3, hy_decay, hy_skip, ml_gate_b, out_norm, w_out, norm_ffn, w_gate, w_up, w_down,
           ple_norm, w_ple_gate, w_ple_proj):
    xn = rmsnorm(x, norm_mix)
    z = xn @ w_in
    splits = [GROUP_W, GROUP_W, GROUP_W, B_COLS, C_COLS, GROUP_W, GROUP_W, GROUP_W, GROUP_W, 4 * N_HEADS_D]
    qa, ka, va, ub, uc, qd, kd, vd, od, gd = jnp.split(z, list(np.cumsum(splits)[:-1]), axis=-1)
    ya = neighbourhood_attention(qa, ka, va, attn_rpb)
    yb = fourier_mix(ub, fnet_w)
    yc = hyena(uc, hy_conv_w, hy_conv_b, hy_w1, hy_b1, hy_freq, hy_w2, hy_b2, hy_w3, hy_decay, hy_skip)
    yd = mlstm_bidir(qd, kd, vd, od, gd, ml_gate_b)
    y = head_rmsnorm(jnp.concatenate([ya, yb, yc, yd], axis=-1), out_norm)
    x = x + y @ w_out
    hn = rmsnorm(x, norm_ffn)
    x = x + (jax.nn.silu(hn @ w_gate) * (hn @ w_up)) @ w_down
    gate = jax.nn.sigmoid(rmsnorm(x, ple_norm) @ w_ple_gate)
    return x + gate * (p_i @ w_ple_proj)


def _trunk(x, p, layer_weights, final_norm):
    for i in range(DEPTH):
        x = _layer(x, p[i], *[w[i] for w in layer_weights])
    return rmsnorm(x, final_norm)


def setup_inputs(seed: int = 0) -> dict:
    key = jax.random.key(seed)
    ks = list(jax.random.split(key, 40))
    f32 = jnp.float32
    def nk():
        return ks.pop()
    def nrm(shape, scale):
        return jax.random.normal(nk(), shape, f32) * scale
    def gain(shape):
        return 1.0 + 0.05 * jax.random.normal(nk(), shape, f32)
    def unif(shape, lo, hi):
        return jax.random.uniform(nk(), shape, f32, lo, hi)
    inp = {}
    inp['x_prompt'] = nrm((BATCH, SEQ, D_MODEL), 1.0)
    inp['x_sample'] = nrm((DEC_BATCH, DEC_SEQ, D_MODEL), 1.0)
    inp['p_prompt'] = nrm((DEPTH, BATCH, SEQ, PLE_DIM), 1.0)
    inp['p_sample'] = nrm((DEPTH, DEC_BATCH, DEC_SEQ, PLE_DIM), 1.0)
    inp['norm_mix'] = gain((DEPTH, D_MODEL))
    inp['w_in'] = nrm((DEPTH, D_MODEL, N_IN), D_MODEL ** -0.5)
    inp['attn_rpb'] = nrm((DEPTH, N_HEADS_A, 2 * KH_MAX - 1, 2 * KW - 1), 0.1)
    inp['fnet_w'] = nrm((DEPTH, N_GROUPS_B, HEAD_DIM, HEAD_DIM), HEAD_DIM ** -0.5)
    inp['hy_conv_w'] = nrm((DEPTH, 3, C_COLS), 3 ** -0.5)
    inp['hy_conv_b'] = nrm((DEPTH, C_COLS), 0.02)
    inp['hy_w1'] = nrm((DEPTH, HY_EMB, HY_FILT), HY_EMB ** -0.5)
    inp['hy_b1'] = nrm((DEPTH, HY_FILT), 0.1)
    inp['hy_freq'] = gain((DEPTH, 2, HY_FILT))
    inp['hy_w2'] = nrm((DEPTH, HY_FILT, HY_FILT), HY_FILT ** -0.5)
    inp['hy_b2'] = nrm((DEPTH, HY_FILT), 0.1)
    inp['hy_w3'] = nrm((DEPTH, HY_FILT, HY_ORDER * 2 * HY_CH), HY_FILT ** -0.5)
    inp['hy_decay'] = unif((DEPTH, HY_ORDER, 2, HY_CH), 3.0, 15.0)
    inp['hy_skip'] = nrm((DEPTH, HY_ORDER, HY_CH), 1.0)
    ib = nrm((DEPTH, 2, N_HEADS_D), 0.1)
    fb = unif((DEPTH, 2, N_HEADS_D), 3.0, 6.0)
    inp['ml_gate_b'] = jnp.stack([ib[:, 0], fb[:, 0], ib[:, 1], fb[:, 1]], axis=1)
    inp['out_norm'] = gain((DEPTH, D_MODEL))
    inp['w_out'] = nrm((DEPTH, D_MODEL, D_MODEL), D_MODEL ** -0.5)
    inp['norm_ffn'] = gain((DEPTH, D_MODEL))
    inp['w_gate'] = nrm((DEPTH, D_MODEL, D_FF), D_MODEL ** -0.5)
    inp['w_up'] = nrm((DEPTH, D_MODEL, D_FF), D_MODEL ** -0.5)
    inp['w_down'] = nrm((DEPTH, D_FF, D_MODEL), D_FF ** -0.5)
    inp['ple_norm'] = gain((DEPTH, D_MODEL))
    inp['w_ple_gate'] = nrm((DEPTH, D_MODEL, D_MODEL), D_MODEL ** -0.5)
    inp['w_ple_proj'] = nrm((DEPTH, PLE_DIM, D_MODEL), PLE_DIM ** -0.5)
    inp['final_norm'] = gain((D_MODEL,))
    return inp


def reference(x_prompt, x_sample, p_prompt, p_sample, norm_mix, w_in, attn_rpb, fnet_w, hy_conv_w, hy_conv_b,
              hy_w1, hy_b1, hy_freq, hy_w2, hy_b2, hy_w3, hy_decay, hy_skip, ml_gate_b, out_norm, w_out,
              norm_ffn, w_gate, w_up, w_down, ple_norm, w_ple_gate, w_ple_proj, final_norm):
    layer_weights = (norm_mix, w_in, attn_rpb, fnet_w, hy_conv_w, hy_conv_b, hy_w1, hy_b1, hy_freq, hy_w2,
                     hy_b2, hy_w3, hy_decay, hy_skip, ml_gate_b, out_norm, w_out, norm_ffn, w_gate, w_up,
                     w_down, ple_norm, w_ple_gate, w_ple_proj)
    y_prompt = _trunk(x_prompt, p_prompt, layer_weights, final_norm)
    y_sample = _trunk(x_sample, p_sample, layer_weights, final_norm)
    return (y_prompt, y_sample)
```

```cpp
#include <hip/hip_runtime.h>
#include <hip/hip_cooperative_groups.h>
#include <cstdio>
namespace cg = cooperative_groups;
namespace pg8 {
#define PG8_LAS __attribute__((address_space(3)))
typedef unsigned short bf16_t;
typedef short bf16x8 __attribute__((ext_vector_type(8)));
typedef float f32x4 __attribute__((ext_vector_type(4)));
typedef unsigned u32x4 __attribute__((ext_vector_type(4)));
constexpr int BM = 256, BK = 64, HALF = 128, HTB = HALF * BK * 2  , STAGE_BYTES = 8 * HTB, NXCD = 8, WGM = 8;

__host__ __device__ __forceinline__ int lds_byte(int r, int c) { const int st = (r >> 4) * 2 + (c >> 5), rr = r & 15, cc = c & 31, ob = rr * 64 + cc * 2; return st * 1024 + (ob ^ (((ob >> 9) & 1) << 5)); }
__host__ __device__ __forceinline__ void stage_rc(int b, int& R, int& C) { const int st = b / 1024, sb = b % 1024, swz = sb ^ (((sb >> 9) & 1) << 5); R = (st >> 1) * 16 + swz / 64; C = (st & 1) * 32 + (swz % 64) / 2; }
__host__ __device__ __forceinline__ int perm32(int rho) { const int n = rho >> 4, i = rho & 15; return 8 * (i >> 2) + 4 * n + (i & 3); }

struct Unit { int pm, pn; };
struct Gemm { const bf16_t* A; const bf16_t* Bt; int M, N, K; };

struct StaticOrder {
    int nM, nN, nwg, G, c;
    __host__ __device__ void init(int M, int N, int G_, int c_) { nM = M / BM; nN = N / BM; nwg = nM * nN; G = G_; c = c_; }
    __host__ __device__ bool next(int i, Unit& u) const {
        const long L = (long)i * G + c; if (L >= nwg) return false;
        int wgid = (int)L; { const int q = nwg / NXCD, r = nwg % NXCD, xcd = wgid % NXCD, off = wgid / NXCD; wgid = (xcd < r ? xcd * (q + 1) : r * (q + 1) + (xcd - r) * q) + off; }
        const int nig = WGM * nN, gid = wgid / nig, fm = gid * WGM, gsz = (nM - fm) < WGM ? (nM - fm) : WGM;
        u.pm = fm + ((wgid % nig) % gsz); u.pn = (wgid % nig) / gsz; return true;
    }
    __device__ __forceinline__ void a_ready(const Unit&) const {}
    __device__ __forceinline__ void done(const Unit&) const {}
};
struct CountedOrder : StaticOrder {
    const unsigned* ready; unsigned need; unsigned* tmo;
    __device__ __forceinline__ void a_ready(const Unit& u) const {
        if (threadIdx.x < 64) {
            const unsigned long long t0 = __builtin_amdgcn_s_memrealtime(); unsigned polls = 0;
            while ((unsigned)__builtin_amdgcn_readfirstlane(__hip_atomic_load(ready + 64 * u.pm, __ATOMIC_RELAXED, __HIP_MEMORY_SCOPE_AGENT)) < need) {
                if ((++polls & 255u) == 0u && __builtin_amdgcn_readfirstlane(__hip_atomic_load(tmo, __ATOMIC_RELAXED, __HIP_MEMORY_SCOPE_AGENT)) != 0u) break;
                if (__builtin_amdgcn_s_memrealtime() - t0 > 2000000ull) {
                    if (threadIdx.x == 0) { unsigned expect = 0u; __hip_atomic_compare_exchange_strong(tmo + 1, &expect, 0x600u | (unsigned)(u.pm & 0xff), __ATOMIC_RELAXED, __ATOMIC_RELAXED, __HIP_MEMORY_SCOPE_AGENT); __hip_atomic_store(tmo, 1u, __ATOMIC_RELAXED, __HIP_MEMORY_SCOPE_AGENT); }
                    break; }
                __builtin_amdgcn_s_sleep(2); }
            __builtin_amdgcn_fence(__ATOMIC_ACQUIRE, "agent");
            asm volatile("s_waitcnt vmcnt(0)" ::: "memory");
        }
#if !defined(BROKEN_HOOK_NO_BARRIER)
        asm volatile("" ::: "memory"); __builtin_amdgcn_s_barrier(); asm volatile("" ::: "memory");
#endif
    }
};

__device__ __forceinline__ unsigned cvt_pk_bf16(float lo, float hi) { unsigned r; asm volatile("v_cvt_pk_bf16_f32 %0, %1, %2" : "=v"(r) : "v"(lo), "v"(hi)); return r; }
typedef float f32x2 __attribute__((ext_vector_type(2)));
__device__ __forceinline__ f32x2 gelu_pk(f32x2 v) {
    const f32x2 av = __builtin_elementwise_abs(v), d = av * 0.2316418882f + 1.0f;
    f32x2 t; t.x = __builtin_amdgcn_rcpf(d.x); t.y = __builtin_amdgcn_rcpf(d.y);
    f32x2 q = t * 0.5307027145f + (-0.7265760135f); q = q * t + 0.7107068705f; q = q * t + (-0.142248368f); q = q * t + 0.127414796f; q = q * t;
    const f32x2 s = (v * v) * (-0.72134752044f);
    f32x2 e; e.x = __builtin_amdgcn_exp2f(s.x); e.y = __builtin_amdgcn_exp2f(s.y);
    const f32x2 m = v * (q * e), r = v - m;
    f32x2 o; o.x = v.x < 0.f ? m.x : r.x; o.y = v.y < 0.f ? m.y : r.y; return o;
}

struct EpiF32 {
    static constexpr bool PERM = false, AFTER_DRAIN = false;
    float* C; int ldc; const float* bias;
    __device__ __forceinline__ void operator()(const f32x4 (&acc)[2][2][4][2], const Unit& u, int wr, int wc, int fr, int fq) const {
        const int row0 = u.pm * BM + wr * 64 + fr, col0 = u.pn * BM + wc * 32 + 4 * fq;
        f32x4 bv[2][2];
#pragma unroll
        for (int bj = 0; bj < 2; ++bj)
#pragma unroll
            for (int n = 0; n < 2; ++n) bv[bj][n] = bias ? *(const f32x4*)(bias + col0 + bj * HALF + n * 16) : (f32x4){0.f, 0.f, 0.f, 0.f};
#pragma unroll
        for (int ai = 0; ai < 2; ++ai)
#pragma unroll
            for (int m = 0; m < 4; ++m) { float* rowp = C + (size_t)(row0 + ai * HALF + m * 16) * ldc + col0;
#pragma unroll
                for (int bj = 0; bj < 2; ++bj)
#pragma unroll
                    for (int n = 0; n < 2; ++n) *(f32x4*)(rowp + bj * HALF + n * 16) = acc[ai][bj][m][n] + bv[bj][n]; }
    }
};
template <int ACT  > struct EpiBf16 {
    static constexpr bool PERM = true, AFTER_DRAIN = false;
    bf16_t* O; int ldc; const float* bias; int split_cols; size_t split_stride;
    __device__ __forceinline__ void operator()(const f32x4 (&acc)[2][2][4][2], const Unit& u, int wr, int wc, int fr, int fq) const {
        const int row0 = u.pm * BM + wr * 64 + fr; int colt = u.pn * BM; bf16_t* base = O;
        if (split_cols) { const int t = colt / split_cols; base += (size_t)t * split_stride; colt -= t * split_cols; }
        const int col0 = colt + wc * 32 + 8 * fq, bcol0 = u.pn * BM + wc * 32 + 8 * fq;
        f32x4 bv[2][2];
#pragma unroll
        for (int bj = 0; bj < 2; ++bj)
#pragma unroll
            for (int n = 0; n < 2; ++n) bv[bj][n] = bias ? *(const f32x4*)(bias + bcol0 + bj * HALF + 4 * n) : (f32x4){0.f, 0.f, 0.f, 0.f};
#pragma unroll
        for (int ai = 0; ai < 2; ++ai)
#pragma unroll
            for (int m = 0; m < 4; ++m) { bf16_t* rowp = base + (size_t)(row0 + ai * HALF + m * 16) * ldc + col0;
#pragma unroll
                for (int bj = 0; bj < 2; ++bj) { f32x4 v0 = acc[ai][bj][m][0] + bv[bj][0], v1 = acc[ai][bj][m][1] + bv[bj][1];
                    if (ACT == 1) { f32x2 a = gelu_pk((f32x2){v0[0], v0[1]}), b = gelu_pk((f32x2){v0[2], v0[3]}), c = gelu_pk((f32x2){v1[0], v1[1]}), d = gelu_pk((f32x2){v1[2], v1[3]});
                        v0 = (f32x4){a.x, a.y, b.x, b.y}; v1 = (f32x4){c.x, c.y, d.x, d.y}; }
                    if (ACT == 2) {
#pragma unroll
                        for (int j = 0; j < 4; ++j) { v0[j] = 0.5f * v0[j] * (1.0f + erff(v0[j] * 0.70710678f)); v1[j] = 0.5f * v1[j] * (1.0f + erff(v1[j] * 0.70710678f)); } }
                    u32x4 w; w.x = cvt_pk_bf16(v0[0], v0[1]); w.y = cvt_pk_bf16(v0[2], v0[3]); w.z = cvt_pk_bf16(v1[0], v1[1]); w.w = cvt_pk_bf16(v1[2], v1[3]);
                    *(u32x4*)(rowp + bj * HALF) = w; } }
    }
};
template <class Epi, class Sched, bool STAMP = false>
__device__ __forceinline__ void gemm_phase(PG8_LAS unsigned char* lds, const Gemm g, const Sched& S, const Epi& E, unsigned long long* stamps) {
    int tid_ = threadIdx.x; asm volatile("" : "+v"(tid_)); const int tid = tid_, wid = __builtin_amdgcn_readfirstlane(tid >> 6), lane = tid & 63, wr = wid >> 2, wc = wid & 3, fr = lane & 15, fq = lane >> 4;
    const int K = g.K, nt = K / BK;
    int ts_lo = 0, ts_hi = 0, nts = 0; const unsigned long long rt_entry = STAMP ? (unsigned long long)wall_clock64() : 0ull;
#define PG8_STAMP() do { if (STAMP && wid == 0 && nts < 64) { const unsigned long long _c = (unsigned long long)clock64(); \
        ts_lo = (lane == nts) ? (int)(unsigned)_c : ts_lo; ts_hi = (lane == nts) ? (int)(unsigned)(_c >> 32) : ts_hi; ++nts; } } while (0)
    PG8_STAMP();
    unsigned voffA[2], voffB[2];
#pragma unroll
    for (int i = 0; i < 2; ++i) { int R, C; stage_rc(tid * 16 + i * 8192, R, C); const int Rb = Epi::PERM ? ((R & ~31) + perm32(R & 31)) : R;
        voffA[i] = (unsigned)(R * K + C) * 2u; voffB[i] = (unsigned)(Rb * K + C) * 2u; }
    const size_t kstep = (size_t)(BK * 2);
    const size_t hstep = (size_t)HALF * K * 2;
    const size_t tstep = 2 * hstep;
    const unsigned ldsw = (unsigned)wid * 1024u;
    const int aoff = lds_byte(wr * 64 + fr, fq * 8), boff = lds_byte(wc * 32 + fr, fq * 8);
#define PG8_SA(b, h) (((b) * 2 + (h)) * HTB)
#define PG8_SB(b, h) ((4 + (b) * 2 + (h)) * HTB)
#define PG8_STAGE(bufoff, gbase, voff) do { _Pragma("unroll") for (int _i = 0; _i < 2; ++_i) \
        __builtin_amdgcn_global_load_lds((const unsigned*)((const char*)(gbase) + (voff)[_i]), (PG8_LAS unsigned*)(lds + (bufoff) + ldsw + _i * 8192), 16, 0, 0); } while (0)
#define PG8_LDA(dst, b, h) do { _Pragma("unroll") for (int m = 0; m < 4; ++m) _Pragma("unroll") for (int k = 0; k < 2; ++k) dst[m][k] = *(const PG8_LAS bf16x8*)(lds + PG8_SA(b, h) + aoff + m * 2048 + k * 1024); } while (0)
#define PG8_LDB(dst, b, h) do { _Pragma("unroll") for (int n = 0; n < 2; ++n) _Pragma("unroll") for (int k = 0; k < 2; ++k) dst[n][k] = *(const PG8_LAS bf16x8*)(lds + PG8_SB(b, h) + boff + n * 2048 + k * 1024); } while (0)
#define PG8_MMA(ai, bj, At, Bt) do { __builtin_amdgcn_s_setprio(1); _Pragma("unroll") for (int m = 0; m < 4; ++m) _Pragma("unroll") for (int n = 0; n < 2; ++n) _Pragma("unroll") for (int k = 0; k < 2; ++k) \
        acc[ai][bj][m][n] = __builtin_amdgcn_mfma_f32_16x16x32_bf16(Bt[n][k], At[m][k], acc[ai][bj][m][n], 0, 0, 0); __builtin_amdgcn_s_setprio(0); } while (0)
#define PG8_WAIT_V(n) asm volatile("s_waitcnt vmcnt(" #n ")" ::: "memory")
#define PG8_WAIT_L(n) asm volatile("s_waitcnt lgkmcnt(" #n ")" ::: "memory")
#define PG8_BAR __builtin_amdgcn_s_barrier()
#define PG8_SCHED __builtin_amdgcn_sched_barrier(0)
    Unit cur, nxt; int ui = 0;
    if (!S.next(0, cur)) return;
    f32x4 acc[2][2][4][2];
#pragma unroll
    for (int a = 0; a < 2; ++a)
#pragma unroll
        for (int b = 0; b < 2; ++b)
#pragma unroll
            for (int m = 0; m < 4; ++m)
#pragma unroll
                for (int n = 0; n < 2; ++n) acc[a][b][m][n] = (f32x4){0.f, 0.f, 0.f, 0.f};
    bf16x8 At[4][2], B0[2][2], B1[2][2];
    const char* cA = (const char*)g.A + (size_t)cur.pm * tstep; const char* cB = (const char*)g.Bt + (size_t)cur.pn * tstep;
    S.a_ready(cur);
    PG8_STAGE(PG8_SB(0, 0), cB, voffB); PG8_STAGE(PG8_SA(0, 0), cA, voffA); PG8_STAGE(PG8_SB(0, 1), cB + hstep, voffB); PG8_STAGE(PG8_SA(0, 1), cA + hstep, voffA);
    if (wr == 1) PG8_BAR;
    PG8_WAIT_V(4); PG8_BAR;
    PG8_STAGE(PG8_SB(1, 0), cB + kstep, voffB); PG8_STAGE(PG8_SA(1, 0), cA + kstep, voffA); PG8_STAGE(PG8_SB(1, 1), cB + hstep + kstep, voffB);
    PG8_WAIT_V(6); PG8_BAR;
    PG8_STAMP();
    for (;;) {
        const bool has_next = S.next(ui + 1, nxt);
        const char* nA = has_next ? (const char*)g.A + (size_t)nxt.pm * tstep : cA; const char* nB = has_next ? (const char*)g.Bt + (size_t)nxt.pn * tstep : cB;
        for (int t = 0; t < nt; t += 2) {
            const bool last = (t == nt - 2);
            const char* a1 = cA + (size_t)(t + 1) * kstep;
            const char* a2 = last ? nA : cA + (size_t)(t + 2) * kstep; const char* b2 = last ? nB : cB + (size_t)(t + 2) * kstep;
            const char* a3 = a2 + kstep; const char* b3 = b2 + kstep;
            if (last && has_next) S.a_ready(nxt);
            PG8_LDB(B0, 0, 0); PG8_SCHED; PG8_LDA(At, 0, 0); PG8_STAGE(PG8_SA(1, 1), a1 + hstep, voffA);
            PG8_WAIT_L(8); PG8_BAR; PG8_WAIT_L(0); PG8_MMA(0, 0, At, B0); PG8_BAR; PG8_SCHED;
            PG8_LDB(B1, 0, 1); PG8_STAGE(PG8_SB(0, 0), b2, voffB);
            PG8_BAR; PG8_WAIT_L(0); PG8_MMA(0, 1, At, B1); PG8_BAR;
            PG8_LDA(At, 0, 1); PG8_STAGE(PG8_SA(0, 0), a2, voffA);
            PG8_BAR; PG8_WAIT_L(0); PG8_MMA(1, 0, At, B0); PG8_BAR; PG8_SCHED;
            PG8_STAGE(PG8_SB(0, 1), b2 + hstep, voffB);
            PG8_WAIT_V(6); PG8_BAR; PG8_MMA(1, 1, At, B1); PG8_BAR;
            PG8_LDB(B0, 1, 0); PG8_SCHED; PG8_LDA(At, 1, 0); PG8_STAGE(PG8_SA(0, 1), a2 + hstep, voffA);
            PG8_WAIT_L(8); PG8_BAR; PG8_WAIT_L(0); PG8_MMA(0, 0, At, B0); PG8_BAR; PG8_SCHED;
            PG8_LDB(B1, 1, 1); PG8_STAGE(PG8_SB(1, 0), b3, voffB);
            PG8_BAR; PG8_WAIT_L(0); PG8_MMA(0, 1, At, B1); PG8_BAR;
            PG8_LDA(At, 1, 1); PG8_STAGE(PG8_SA(1, 0), a3, voffA);
            PG8_BAR; PG8_WAIT_L(0); PG8_MMA(1, 0, At, B0); PG8_BAR; PG8_SCHED;
            PG8_STAGE(PG8_SB(1, 1), b3 + hstep, voffB);
            PG8_WAIT_V(6); PG8_BAR; PG8_MMA(1, 1, At, B1); PG8_BAR;
        }
        PG8_STAMP();
        if constexpr (!Epi::AFTER_DRAIN) { E(acc, cur, wr, wc, fr, fq); S.done(cur); }
        PG8_STAMP();
        if (!has_next) break;
#pragma unroll
        for (int a = 0; a < 2; ++a)
#pragma unroll
            for (int b = 0; b < 2; ++b)
#pragma unroll
                for (int m = 0; m < 4; ++m)
#pragma unroll
                    for (int n = 0; n < 2; ++n) acc[a][b][m][n] = (f32x4){0.f, 0.f, 0.f, 0.f};
        cur = nxt; cA = nA; cB = nB; ++ui;
    }
    PG8_WAIT_V(0);
    if (wr == 0) PG8_BAR;
    PG8_BAR;
    if constexpr (Epi::AFTER_DRAIN) { E.fused(acc, cur, wr, wc, fr, fq, lds, wid, lane); S.done(cur); }
    PG8_STAMP();
    if (STAMP && wid == 0) { stamps[lane] = lane < nts ? (((unsigned long long)(unsigned)ts_hi << 32) | (unsigned)ts_lo) : 0ull;
        if (lane == 62) stamps[62] = rt_entry; if (lane == 63) stamps[63] = (unsigned long long)wall_clock64(); }
#undef PG8_STAMP
#undef PG8_SA
#undef PG8_SB
#undef PG8_STAGE
#undef PG8_LDA
#undef PG8_LDB
#undef PG8_MMA
#undef PG8_WAIT_V
#undef PG8_WAIT_L
#undef PG8_BAR
#undef PG8_SCHED
}
}

typedef unsigned short bf16_t;
typedef float f32x4 __attribute__((ext_vector_type(4)));
typedef unsigned u32x4 __attribute__((ext_vector_type(4)));
typedef unsigned u32x2 __attribute__((ext_vector_type(2)));
#define LAS __attribute__((address_space(3)))

constexpr int T_TOK = 81920, T_PROMPT = 16384, SEQL = 8192, NSEQ = 10, DM = 1024, DFF = 2816, NIN = 2832;
constexpr int ZA_LD = 1792;
constexpr int ZB_ROWS = 1280;
constexpr float EPSF = 1e-6f;
constexpr int NTHR = 512;
constexpr int LDS_BYTES = 150 * 1024;

constexpr size_t al256(size_t x) { return (x + 255) & ~(size_t)255; }
constexpr size_t OFF_TW = 0;
constexpr size_t OFF_H2 = OFF_TW + 8192 * 8;
constexpr size_t OFF_FAB = OFF_H2 + (size_t)2 * 8192 * 64 * 4;
constexpr size_t OFF_W = OFF_FAB + (size_t)2 * 4 * 2 * 4096 * 4;
constexpr size_t W_INA = 0;
constexpr size_t W_INB = W_INA + (size_t)1792 * 1024 * 2;
constexpr size_t W_OUT = W_INB + (size_t)1280 * 1024 * 2;
constexpr size_t W_GU = W_OUT + (size_t)1024 * 1024 * 2;
constexpr size_t W_DOWN = W_GU + (size_t)5632 * 1024 * 2;
constexpr size_t W_PG = W_DOWN + (size_t)1024 * 2816 * 2;
constexpr size_t W_PP = W_PG + (size_t)1024 * 1024 * 2;
constexpr size_t W_LAYER = W_PP + (size_t)1024 * 256 * 2;
constexpr size_t OFF_KS = OFF_W + 2 * W_LAYER;
constexpr size_t OFF_XB = OFF_KS + (size_t)2 * 256 * 16384 * 8;
constexpr size_t OFF_GATES = OFF_XB + (size_t)T_TOK * 1024 * 2;
constexpr size_t OFF_PB = OFF_GATES + (size_t)T_TOK * 16 * 4;
constexpr size_t OFF_STS = OFF_PB + (size_t)T_TOK * 256 * 2;
constexpr size_t OFF_STN = OFF_STS + (size_t)80 * 64 * 4096 * 4;
constexpr size_t OFF_STC = OFF_STN + (size_t)80 * 64 * 64 * 4;
constexpr size_t OFF_Z = al256(OFF_STC + (size_t)80 * 64 * 4 * 4);
constexpr size_t OFF_ZB = OFF_Z + (size_t)T_TOK * ZA_LD * 2;
constexpr size_t OFF_SCR = OFF_ZB + (size_t)ZB_ROWS * T_TOK * 2;
constexpr size_t WS_END = OFF_SCR + (size_t)256 * 8192 * 8;

struct Params { const float* in[29]; float* out; unsigned char* ws; };

__device__ __forceinline__ bf16_t f2bf(float f) { unsigned u = __float_as_uint(f); u += 0x7FFFu + ((u >> 16) & 1u); return (bf16_t)(u >> 16); }
__device__ __forceinline__ float bf2f(bf16_t b) { return __uint_as_float(((unsigned)b) << 16); }
__device__ __forceinline__ unsigned pack2bf(float lo, float hi) { return (unsigned)f2bf(lo) | ((unsigned)f2bf(hi) << 16); }
__device__ __forceinline__ float wave_sum(float v) {
#pragma unroll
    for (int o = 32; o >= 1; o >>= 1) v += __shfl_xor(v, o);
    return v;
}
__device__ __forceinline__ float wave_max(float v) {
#pragma unroll
    for (int o = 32; o >= 1; o >>= 1) v = fmaxf(v, __shfl_xor(v, o));
    return v;
}
__device__ __forceinline__ float sigmoidf_(float x) { return 1.0f / (1.0f + __expf(-x)); }
__device__ __forceinline__ float logsigmoidf_(float x) { return x >= 0.f ? -log1pf(expf(-x)) : x - log1pf(expf(x)); }
__device__ __forceinline__ const float* xrow_ptr(const float* x0, const float* x1, int row) { return row < T_PROMPT ? x0 + (size_t)row * DM : x1 + (size_t)(row - T_PROMPT) * DM; }

struct EpiResF32 {
    static constexpr bool PERM = false, AFTER_DRAIN = false;
    const float* b0; const float* b1; float* out;
    __device__ __forceinline__ void operator()(const pg8::f32x4 (&acc)[2][2][4][2], const pg8::Unit& u, int wr, int wc, int fr, int fq) const {
        const int row0 = u.pm * 256 + wr * 64 + fr, col0 = u.pn * 256 + wc * 32 + 4 * fq;
        const float* base = (u.pm * 256 < T_PROMPT) ? b0 : b1 - (size_t)T_PROMPT * DM;
#pragma unroll
        for (int ai = 0; ai < 2; ++ai)
#pragma unroll
            for (int m = 0; m < 4; ++m) { const size_t off = (size_t)(row0 + ai * 128 + m * 16) * DM + col0;
#pragma unroll
                for (int bj = 0; bj < 2; ++bj)
#pragma unroll
                    for (int n = 0; n < 2; ++n) { const f32x4 bs = *(const f32x4*)(base + off + bj * 128 + n * 16); *(f32x4*)(out + off + bj * 128 + n * 16) = bs + acc[ai][bj][m][n]; }
                asm volatile("" ::: "memory"); }
    }
};
struct EpiSwiGLU {
    static constexpr bool PERM = true, AFTER_DRAIN = false;
    bf16_t* O;
    __device__ __forceinline__ void operator()(const pg8::f32x4 (&acc)[2][2][4][2], const pg8::Unit& u, int wr, int wc, int fr, int fq) const {
        const int row0 = u.pm * 256 + wr * 64 + fr, col0 = (u.pn * 256 + wc * 32 + 8 * fq) >> 1;
#pragma unroll
        for (int ai = 0; ai < 2; ++ai)
#pragma unroll
            for (int m = 0; m < 4; ++m) { bf16_t* rowp = O + (size_t)(row0 + ai * 128 + m * 16) * DFF + col0;
#pragma unroll
                for (int bj = 0; bj < 2; ++bj) { const f32x4 g = acc[ai][bj][m][0], up = acc[ai][bj][m][1]; float r[4];
#pragma unroll
                    for (int j = 0; j < 4; ++j) r[j] = g[j] * sigmoidf_(g[j]) * up[j];
                    u32x2 w; w.x = pack2bf(r[0], r[1]); w.y = pack2bf(r[2], r[3]); *(u32x2*)(rowp + bj * 64) = w; } }
    }
};
struct EpiPle {
    static constexpr bool PERM = false, AFTER_DRAIN = false;
    float* out; const bf16_t* proj;
    __device__ __forceinline__ void operator()(const pg8::f32x4 (&acc)[2][2][4][2], const pg8::Unit& u, int wr, int wc, int fr, int fq) const {
        const int row0 = u.pm * 256 + wr * 64 + fr, col0 = u.pn * 256 + wc * 32 + 4 * fq;
#pragma unroll
        for (int ai = 0; ai < 2; ++ai)
#pragma unroll
            for (int m = 0; m < 4; ++m) { const size_t off = (size_t)(row0 + ai * 128 + m * 16) * DM + col0;
#pragma unroll
                for (int bj = 0; bj < 2; ++bj)
#pragma unroll
                    for (int n = 0; n < 2; ++n) { const size_t o2 = off + bj * 128 + n * 16; const f32x4 bs = *(const f32x4*)(out + o2); const u32x2 pw = *(const u32x2*)(proj + o2);
                        f32x4 a = acc[ai][bj][m][n], r;
                        r[0] = bs[0] + sigmoidf_(a[0]) * __uint_as_float(pw.x << 16); r[1] = bs[1] + sigmoidf_(a[1]) * __uint_as_float(pw.x & 0xffff0000u);
                        r[2] = bs[2] + sigmoidf_(a[2]) * __uint_as_float(pw.y << 16); r[3] = bs[3] + sigmoidf_(a[3]) * __uint_as_float(pw.y & 0xffff0000u);
                        *(f32x4*)(out + o2) = r; }
                asm volatile("" ::: "memory"); }
    }
};

constexpr int PARAM_OFF = LDS_BYTES - 512;
struct Ctx { int tid, lane, wid, bid, nb; unsigned char* ws; LAS unsigned char* lds;
    __device__ __forceinline__ unsigned long long raw(int i) const { const unsigned long long v = ((const LAS unsigned long long*)(lds + PARAM_OFF))[i];
        const unsigned lo = __builtin_amdgcn_readfirstlane((unsigned)v), hi = __builtin_amdgcn_readfirstlane((unsigned)(v >> 32)); return ((unsigned long long)hi << 32) | lo; }
    __device__ __forceinline__ const float* in(int i) const { return (const float*)(const __attribute__((address_space(1))) float*)raw(i); }
    __device__ __forceinline__ unsigned char* gptr(int i) const { return (unsigned char*)(__attribute__((address_space(1))) unsigned char*)raw(i); }
};

__device__ __forceinline__ void phase_prep0a(const Ctx& C) {
    const int gt = C.bid * NTHR + C.tid, gn = C.nb * NTHR;
    typedef float f32x2_ __attribute__((ext_vector_type(2))); f32x2_* TW = (f32x2_*)(C.ws + OFF_TW);
    for (int k = gt; k < 8192; k += gn) { float s, c; sincospif((float)k * (1.0f / 8192.0f), &s, &c); { f32x2_ tv; tv.x = c; tv.y = -s; TW[k] = tv; } }
    float* FAB = (float*)(C.ws + OFF_FAB);
    for (int i = gt; i < 2 * 4 * 2 * 4096; i += gn) {
        const int d = i & 63, c = (i >> 6) & 63, ab = (i >> 12) & 1, g = (i >> 13) & 3, l = i >> 15;
        const float* w = C.in(7) + (size_t)((l * 4 + g) * 64) * 64;
        float acc = 0.f;
        for (int dp = 0; dp < 64; ++dp) { float s, cc; sincospif((float)((dp * c) & 63) * (1.0f / 32.0f), &s, &cc); acc += (ab ? s : cc) * w[dp * 64 + d]; }
        const float sc = 1.0f / sqrtf(64.0f * 8192.0f);
        FAB[i] = ab ? -acc * sc : acc * sc;
    }
    float* H2 = (float*)(C.ws + OFF_H2);
    const int gw = C.bid * 8 + C.wid, lane = C.lane;
    for (int it = gw; it < 2 * 8192; it += C.nb * 8) {
        const int l = it >> 13, s = it & 8191;
        const float* w1 = C.in(10) + l * 33 * 64; const float* b1 = C.in(11) + l * 64; const float* fq = C.in(12) + l * 128; const float* w2 = C.in(13) + l * 4096; const float* b2 = C.in(14) + l * 64;
        const float t = (float)s / 8191.0f;
        const float ang = (float)(2.0 * 3.14159265358979323846 / 8192.0) * (float)s;
        float feat = 0.f;
        if (lane == 0) feat = t;
        else if (lane <= 32) { const int bi = (lane - 1) & 15; const float band = 1e-4f + (float)bi * ((15.0f - 1e-4f) / 15.0f); const float fb = ang * band; feat = lane <= 16 ? cosf(fb) : -sinf(fb); }
        float a = b1[lane];
        for (int i = 0; i < 33; ++i) a += __shfl(feat, i) * w1[i * 64 + lane];
        const float h1 = sinf(fq[lane] * a);
        float a2 = b2[lane];
        for (int i = 0; i < 64; ++i) a2 += __shfl(h1, i) * w2[i * 64 + lane];
        H2[(size_t)(l * 8192 + s) * 64 + lane] = sinf(fq[64 + lane] * a2);
    }
}

template <class ColF>
__device__ __forceinline__ void wtranspose(ColF colp, int ldw, int NOUT, int K, const float* gain, bf16_t* dst, const Ctx& C) {
    LAS float* tile = (LAS float*)C.lds;
    const int ntn = NOUT / 64, ntk = K / 64;
    for (int t = C.bid; t < ntn * ntk; t += C.nb) {
        const int tn = t % ntn, tk = t / ntn;
#pragma unroll
        for (int i = 0; i < 8; ++i) { const int e = C.tid + NTHR * i, jj = e & 63, ii = e >> 6, k = tk * 64 + ii;
            float v = colp(tn * 64 + jj)[(size_t)k * ldw]; if (gain) v *= gain[k]; tile[ii * 65 + jj] = v; }
        __syncthreads();
#pragma unroll
        for (int i = 0; i < 8; ++i) { const int e = C.tid + NTHR * i, ii = e & 63, jj = e >> 6; dst[(size_t)(tn * 64 + jj) * K + tk * 64 + ii] = f2bf(tile[ii * 65 + jj]); }
        __syncthreads();
    }
}
__device__ __forceinline__ void phase_weights(const Ctx& C) {
    for (int l = 0; l < 2; ++l) {
        unsigned char* wb = C.ws + OFF_W + (size_t)l * W_LAYER;
        const float* w_in = C.in(5) + (size_t)l * DM * NIN;
        const float* g_mix = C.in(4) + l * DM;
        wtranspose([=](int n) { return w_in + (n < 768 ? n : n + 1024); }, NIN, 1792, DM, g_mix, (bf16_t*)(wb + W_INA), C);
        wtranspose([=](int n) { return w_in + 1024 + n; }, NIN, 768, DM, g_mix, (bf16_t*)(wb + W_INB) + (size_t)512 * DM, C);
        const float* w_out = C.in(20) + (size_t)l * DM * DM;
        wtranspose([=](int n) { return w_out + n; }, DM, DM, DM, C.in(19) + l * DM, (bf16_t*)(wb + W_OUT), C);
        const float* w_g = C.in(22) + (size_t)l * DM * DFF; const float* w_u = C.in(23) + (size_t)l * DM * DFF;
        const long long gu_delta = (long long)(w_u - w_g);
        wtranspose([=](int r) { return w_g + ((r & 4) ? gu_delta : 0ll) + 4 * (r >> 3) + (r & 3); }, DFF, 2 * DFF, DM, C.in(21) + l * DM, (bf16_t*)(wb + W_GU), C);
        const float* w_d = C.in(24) + (size_t)l * DFF * DM;
        wtranspose([=](int n) { return w_d + n; }, DM, DM, DFF, nullptr, (bf16_t*)(wb + W_DOWN), C);
        const float* w_pg = C.in(26) + (size_t)l * DM * DM;
        wtranspose([=](int n) { return w_pg + n; }, DM, DM, DM, C.in(25) + l * DM, (bf16_t*)(wb + W_PG), C);
        const float* w_pp = C.in(27) + (size_t)l * 256 * DM;
        wtranspose([=](int n) { return w_pp + n; }, DM, DM, 256, nullptr, (bf16_t*)(wb + W_PP), C);
    }
    LAS float* wt = (LAS float*)C.lds; LAS float* fa = wt + 64 * 65; LAS float* fb = fa + 4096;
    const float* FAB = (const float*)(C.ws + OFF_FAB);
    for (int t = C.bid; t < 2 * 4 * 16; t += C.nb) {
        const int tk = t & 15, g = (t >> 4) & 3, l = t >> 6;
        const float* w_in = C.in(5) + (size_t)l * DM * NIN; const float* g_mix = C.in(4) + l * DM;
#pragma unroll
        for (int i = 0; i < 8; ++i) { const int e = C.tid + NTHR * i, cc = e & 63, ii = e >> 6, k = tk * 64 + ii;
            wt[ii * 65 + cc] = w_in[(size_t)k * NIN + 768 + 64 * g + cc] * g_mix[k];
            fa[e] = FAB[((l * 4 + g) * 2 + 0) * 4096 + e]; fb[e] = FAB[((l * 4 + g) * 2 + 1) * 4096 + e]; }
        __syncthreads();
        const int k = C.tid & 63, dg = C.tid >> 6;
        float ap[8], aq[8];
#pragma unroll
        for (int i = 0; i < 8; ++i) { ap[i] = 0.f; aq[i] = 0.f; }
        for (int c = 0; c < 64; ++c) { const float w = wt[k * 65 + c];
#pragma unroll
            for (int i = 0; i < 8; ++i) { ap[i] += w * fa[c * 64 + dg * 8 + i]; aq[i] += w * fb[c * 64 + dg * 8 + i]; } }
        bf16_t* wB = (bf16_t*)(C.ws + OFF_W + (size_t)l * W_LAYER + W_INB);
#pragma unroll
        for (int i = 0; i < 8; ++i) { const int d = dg * 8 + i; wB[(size_t)(64 * g + d) * DM + tk * 64 + k] = f2bf(ap[i]); wB[(size_t)(256 + 64 * g + d) * DM + tk * 64 + k] = f2bf(aq[i]); }
        __syncthreads();
    }
}

__device__ __forceinline__ void phase_norm(const float* x0, const float* x1, const Ctx& C, const float* gate_w  , const float* gate_gain) {
    bf16_t* XB = (bf16_t*)(C.ws + OFF_XB);
    float* gates = (float*)(C.ws + OFF_GATES);
    LAS float* wg = (LAS float*)C.lds;
    if (gate_w) {
        for (int e = C.tid; e < 16 * 1024; e += NTHR) { const int j = e & 15, k = e >> 4; wg[j * 1024 + k] = gate_w[(size_t)k * NIN + 2816 + j] * gate_gain[k]; }
        __syncthreads();
    }
    const int lane = C.lane;
    for (int row = C.bid * 8 + C.wid; row < T_TOK; row += C.nb * 8) {
        const float* xr = xrow_ptr(x0, x1, row);
        f32x4 v[4]; float ss = 0.f;
#pragma unroll
        for (int j = 0; j < 4; ++j) { v[j] = *(const f32x4*)(xr + 4 * lane + 256 * j); ss += v[j][0] * v[j][0] + v[j][1] * v[j][1] + v[j][2] * v[j][2] + v[j][3] * v[j][3]; }
        ss = wave_sum(ss);
        const float rstd = rsqrtf(ss * (1.0f / 1024.0f) + EPSF);
#pragma unroll
        for (int j = 0; j < 4; ++j) { u32x2 w; w.x = pack2bf(v[j][0] * rstd, v[j][1] * rstd); w.y = pack2bf(v[j][2] * rstd, v[j][3] * rstd); *(u32x2*)(XB + (size_t)row * DM + 4 * lane + 256 * j) = w; }
        if (gate_w) {
            float mine = 0.f;
#pragma unroll 1
            for (int jg = 0; jg < 16; ++jg) { float p = 0.f;
#pragma unroll
                for (int j = 0; j < 4; ++j) { const f32x4 w4 = *(const LAS f32x4*)(wg + jg * 1024 + 4 * lane + 256 * j); p += v[j][0] * w4[0] + v[j][1] * w4[1] + v[j][2] * w4[2] + v[j][3] * w4[3]; }
                p = wave_sum(p); if (lane == jg) mine = p; }
            if (lane < 16) gates[(size_t)row * 16 + lane] = mine * rstd;
        }
    }
    if (gate_w) __syncthreads();
}
__device__ __forceinline__ void phase_pconv(const float* p0, const float* p1, const Ctx& C) {
    bf16_t* PB = (bf16_t*)(C.ws + OFF_PB);
    const size_t n4 = (size_t)T_TOK * 256 / 4, split = (size_t)T_PROMPT * 256 / 4;
    for (size_t i = (size_t)C.bid * NTHR + C.tid; i < n4; i += (size_t)C.nb * NTHR) {
        const f32x4 v = i < split ? ((const f32x4*)p0)[i] : ((const f32x4*)p1)[i - split];
        u32x2 w; w.x = pack2bf(v[0], v[1]); w.y = pack2bf(v[2], v[3]); ((u32x2*)PB)[i] = w;
    }
}
__device__ __forceinline__ void phase_final_norm(float* out, const float* gain, const Ctx& C) {
    const int lane = C.lane;
    for (int row = C.bid * 8 + C.wid; row < T_TOK; row += C.nb * 8) {
        float* xr = out + (size_t)row * DM;
        f32x4 v[4]; float ss = 0.f;
#pragma unroll
        for (int j = 0; j < 4; ++j) { v[j] = *(const f32x4*)(xr + 4 * lane + 256 * j); ss += v[j][0] * v[j][0] + v[j][1] * v[j][1] + v[j][2] * v[j][2] + v[j][3] * v[j][3]; }
        ss = wave_sum(ss);
        const float rstd = rsqrtf(ss * (1.0f / 1024.0f) + EPSF);
#pragma unroll
        for (int j = 0; j < 4; ++j) { const f32x4 g = *(const f32x4*)(gain + 4 * lane + 256 * j); *(f32x4*)(xr + 4 * lane + 256 * j) = v[j] * rstd * g; }
    }
}

typedef float f32x2 __attribute__((ext_vector_type(2)));
__device__ __forceinline__ f32x2 mk2(float a, float b) { f32x2 r; r.x = a; r.y = b; return r; }
template <int LOGN>
__device__ __forceinline__ void fft_fwd(LAS f32x2* X, const f32x2* __restrict__ TW, int tid) {
    constexpr int N = 1 << LOGN;
#pragma unroll 1
    for (int s = LOGN - 1; s >= 0; --s) {
        const int half = 1 << s;
#pragma unroll 4
        for (int j = tid; j < N / 2; j += NTHR) {
            const int pos = j & (half - 1), i0 = ((j >> s) << (s + 1)) + pos, i1 = i0 + half;
            const f32x2 a = X[i0], b = X[i1], w = TW[pos << (13 - s)];
            X[i0] = mk2(a.x + b.x, a.y + b.y);
            const float dx = a.x - b.x, dy = a.y - b.y;
            X[i1] = mk2(dx * w.x - dy * w.y, dx * w.y + dy * w.x);
        }
        __syncthreads();
    }
}
template <int LOGN>
__device__ __forceinline__ void fft_inv(LAS f32x2* X, const f32x2* __restrict__ TW, int tid) {
    constexpr int N = 1 << LOGN;
#pragma unroll 1
    for (int s = 0; s < LOGN; ++s) {
        const int half = 1 << s;
#pragma unroll 4
        for (int j = tid; j < N / 2; j += NTHR) {
            const int pos = j & (half - 1), i0 = ((j >> s) << (s + 1)) + pos, i1 = i0 + half;
            const f32x2 a = X[i0], b = X[i1], w = TW[pos << (13 - s)];
            const float bx = b.x * w.x + b.y * w.y, by = b.y * w.x - b.x * w.y;
            X[i0] = mk2(a.x + bx, a.y + by);
            X[i1] = mk2(a.x - bx, a.y - by);
        }
        __syncthreads();
    }
}

__device__ __forceinline__ void phase_kspec(const Ctx& C, int l) {
    LAS f32x2* X = (LAS f32x2*)C.lds;
    LAS float* w3s = (LAS float*)(C.lds + 131072);
    const f32x2* TW = (const f32x2*)(C.ws + OFF_TW);
    const float* H2 = (const float*)(C.ws + OFF_H2) + (size_t)l * 8192 * 64;
    f32x2* KS = (f32x2*)(C.ws + OFF_KS);
    const float* w3 = C.in(15) + (size_t)l * 64 * 1024;
    const float* dec = C.in(16) + l * 1024;
    for (int task = C.bid; task < 512; task += C.nb) {
        const int o = task >> 8, ch = task & 255;
        if (C.tid < 128) { const int dir = C.tid >> 6, i = C.tid & 63; w3s[C.tid] = w3[i * 1024 + o * 512 + dir * 256 + ch]; }
        const float dfw = dec[o * 512 + ch], dbw = dec[o * 512 + 256 + ch];
        __syncthreads();
        for (int s = C.tid; s < 8192; s += NTHR) {
            const f32x4* h = (const f32x4*)(H2 + (size_t)s * 64);
            float af = 0.f, ab = 0.f;
#pragma unroll 4
            for (int i4 = 0; i4 < 16; ++i4) { const f32x4 hv = h[i4];
                af += hv[0] * w3s[4 * i4] + hv[1] * w3s[4 * i4 + 1] + hv[2] * w3s[4 * i4 + 2] + hv[3] * w3s[4 * i4 + 3];
                ab += hv[0] * w3s[64 + 4 * i4] + hv[1] * w3s[64 + 4 * i4 + 1] + hv[2] * w3s[64 + 4 * i4 + 2] + hv[3] * w3s[64 + 4 * i4 + 3]; }
            const float t = (float)s / 8191.0f;
            af *= expf(-t * dfw); ab *= expf(-t * dbw);
            X[s] = mk2(af, 0.f);
            if (s >= 1) X[16384 - s] = mk2(ab, 0.f);
        }
        if (C.tid == 0) X[8192] = mk2(0.f, 0.f);
        __syncthreads();
        fft_fwd<14>(X, TW, C.tid);
        f32x2* dst = KS + (size_t)(o * 256 + ch) * 16384;
        for (int i = C.tid; i < 16384; i += NTHR) dst[i] = X[i];
        __syncthreads();
    }
}

__device__ __forceinline__ float sconv3(const bf16_t* row, int i, float w0, float w1, float w2, float bias) {
    const int im = i > 0 ? i - 1 : 0, ip = i < SEQL - 1 ? i + 1 : SEQL - 1;
    const float um = i > 0 ? bf2f(row[im]) : 0.f, u0 = bf2f(row[i]), up = i < SEQL - 1 ? bf2f(row[ip]) : 0.f;
    return um * w0 + u0 * w1 + up * w2 + bias;
}
__device__ __forceinline__ void phase_hyena(const Ctx& C, int l) {
    LAS f32x2* X = (LAS f32x2*)C.lds;
    const f32x2* TW = (const f32x2*)(C.ws + OFF_TW);
    const f32x2* KS = (const f32x2*)(C.ws + OFF_KS);
    f32x2* SCR = (f32x2*)(C.ws + OFF_SCR) + (size_t)C.bid * 8192;
    bf16_t* zB = (bf16_t*)(C.ws + OFF_ZB);
    const float* cw = C.in(8) + l * 3 * 768; const float* cb = C.in(9) + l * 768; const float* skip = C.in(17) + l * 512;
    for (int task = C.bid; task < 5 * 256; task += C.nb) {
        const int pr = task >> 8, c = task & 255;
        const size_t t0 = (size_t)(2 * pr) * SEQL, t1 = t0 + SEQL;
        bf16_t* rv = zB + (size_t)(512 + c) * T_TOK; const bf16_t* rx1 = zB + (size_t)(768 + c) * T_TOK; const bf16_t* rx2 = zB + (size_t)(1024 + c) * T_TOK;
        { const float v0 = cw[c], v1 = cw[768 + c], v2 = cw[1536 + c], vb = cb[c];
#pragma unroll 1
          for (int i = C.tid; i < 8192; i += NTHR) { const f32x2 v = mk2(sconv3(rv + t0, i, v0, v1, v2, vb), sconv3(rv + t1, i, v0, v1, v2, vb));
              SCR[i] = v; X[i] = v; X[i + 8192] = mk2(0.f, 0.f); } }
        __syncthreads();
        fft_fwd<14>(X, TW, C.tid);
        { const f32x2* K0 = KS + (size_t)c * 16384;
#pragma unroll 2
          for (int i = C.tid; i < 16384; i += NTHR) { const f32x2 x = X[i], k = K0[i]; X[i] = mk2(x.x * k.x - x.y * k.y, x.x * k.y + x.y * k.x); } }
        __syncthreads();
        fft_inv<14>(X, TW, C.tid);
        { const float a0 = cw[256 + c], a1 = cw[768 + 256 + c], a2 = cw[1536 + 256 + c], abi = cb[256 + c], sk0 = skip[c];
#pragma unroll 1
          for (int i = C.tid; i < 8192; i += NTHR) { const f32x2 cv = X[i], v = SCR[i];
              const float xa = sconv3(rx1 + t0, i, a0, a1, a2, abi), xb = sconv3(rx1 + t1, i, a0, a1, a2, abi);
              const f32x2 y1 = mk2(xa * (cv.x * (1.0f / 16384.0f) + v.x * sk0), xb * (cv.y * (1.0f / 16384.0f) + v.y * sk0));
              SCR[i] = y1; X[i] = y1; }
#pragma unroll 1
          for (int i = C.tid; i < 8192; i += NTHR) X[i + 8192] = mk2(0.f, 0.f); }
        __syncthreads();
        fft_fwd<14>(X, TW, C.tid);
        { const f32x2* K1 = KS + (size_t)(256 + c) * 16384;
#pragma unroll 2
          for (int i = C.tid; i < 16384; i += NTHR) { const f32x2 x = X[i], k = K1[i]; X[i] = mk2(x.x * k.x - x.y * k.y, x.x * k.y + x.y * k.x); } }
        __syncthreads();
        fft_inv<14>(X, TW, C.tid);
        { const float b0 = cw[512 + c], b1 = cw[768 + 512 + c], b2 = cw[1536 + 512 + c], bbi = cb[512 + c], sk1 = skip[256 + c];
#pragma unroll 1
          for (int i = C.tid; i < 8192; i += NTHR) { const f32x2 cv = X[i], y1 = SCR[i];
              const float xa = sconv3(rx2 + t0, i, b0, b1, b2, bbi), xb = sconv3(rx2 + t1, i, b0, b1, b2, bbi);
              rv[t0 + i] = f2bf(xa * (cv.x * (1.0f / 16384.0f) + y1.x * sk1));
              rv[t1 + i] = f2bf(xb * (cv.y * (1.0f / 16384.0f) + y1.y * sk1)); } }
        __syncthreads();
    }
}

__device__ __forceinline__ void phase_fnet(const Ctx& C) {
    LAS f32x2* X = (LAS f32x2*)C.lds;
    const f32x2* TW = (const f32x2*)(C.ws + OFF_TW);
    bf16_t* zB = (bf16_t*)(C.ws + OFF_ZB);
    for (int task = C.bid; task < NSEQ * 256; task += C.nb) {
        const int b = task >> 8, r = task & 255;
        bf16_t* rp = zB + (size_t)r * T_TOK + (size_t)b * SEQL; const bf16_t* rq = zB + (size_t)(256 + r) * T_TOK + (size_t)b * SEQL;
        for (int i = C.tid; i < 8192; i += NTHR) X[i] = mk2(bf2f(rp[i]), bf2f(rq[i]));
        __syncthreads();
        fft_fwd<13>(X, TW, C.tid);
        for (int k = C.tid; k < 8192; k += NTHR) rp[k] = f2bf(X[__brev((unsigned)k) >> 19].x);
        __syncthreads();
    }
}

__device__ __forceinline__ void phase_headnorm_cm(const Ctx& C) {
    LAS float* S = (LAS float*)C.lds;
    const bf16_t* zB = (const bf16_t*)(C.ws + OFF_ZB);
    bf16_t* XB = (bf16_t*)(C.ws + OFF_XB);
    for (int task = C.bid; task < T_TOK / 64; task += C.nb) {
        const size_t tok0 = (size_t)task * 64;
        for (int e = C.tid; e < 512 * 8; e += NTHR) { const int ch = e >> 3, part = e & 7; const int row = ch < 256 ? ch : ch + 256;
            const u32x4 w = *(const u32x4*)(zB + (size_t)row * T_TOK + tok0 + part * 8);
            LAS float* d = S + ch * 65 + part * 8;
            d[0] = __uint_as_float(w.x << 16); d[1] = __uint_as_float(w.x & 0xffff0000u); d[2] = __uint_as_float(w.y << 16); d[3] = __uint_as_float(w.y & 0xffff0000u);
            d[4] = __uint_as_float(w.z << 16); d[5] = __uint_as_float(w.z & 0xffff0000u); d[6] = __uint_as_float(w.w << 16); d[7] = __uint_as_float(w.w & 0xffff0000u); }
        __syncthreads();
        const int tok = C.tid & 63, head = C.tid >> 6;
        float ss = 0.f;
        for (int c = 0; c < 64; ++c) { const float v = S[(head * 64 + c) * 65 + tok]; ss += v * v; }
        const float rstd = rsqrtf(ss * (1.0f / 64.0f) + EPSF);
        bf16_t* dst = XB + (tok0 + tok) * DM + 256 + head * 64;
#pragma unroll 2
        for (int c8 = 0; c8 < 8; ++c8) { u32x4 w; const LAS float* sp = S + (head * 64 + c8 * 8) * 65 + tok;
            w.x = pack2bf(sp[0] * rstd, sp[65] * rstd); w.y = pack2bf(sp[130] * rstd, sp[195] * rstd); w.z = pack2bf(sp[260] * rstd, sp[325] * rstd); w.w = pack2bf(sp[390] * rstd, sp[455] * rstd);
            *(u32x4*)(dst + c8 * 8) = w; }
        __syncthreads();
    }
}

__device__ __forceinline__ void phase_na(const Ctx& C, int l) {
    LAS unsigned char* Ks = C.lds;
    LAS unsigned char* Vs = C.lds + 8 * 64 * 144;
    LAS float* Ps = (LAS float*)(C.lds + 8 * 64 * 144 + 8 * 64 * 128);
    LAS float* Bs = Ps + 8 * 128;
    const bf16_t* zA = (const bf16_t*)(C.ws + OFF_Z);
    bf16_t* XB = (bf16_t*)(C.ws + OFF_XB);
    const float* rpb = C.in(6) + l * 4 * 15 * 31;
    const int lane = C.lane, w = C.wid;
    for (int task = C.bid; task < NSEQ * 128 * 4; task += C.nb) {
        const int h = task & 3, r = (task >> 2) & 127, b = task >> 9;
        const int kr0 = min(max(r - 4, 0), 120);
        for (int e = C.tid; e < 4096; e += NTHR) { const int krow = e >> 9, col = (e >> 3) & 63, part = e & 7;
            const bf16_t* src = zA + ((size_t)b * SEQL + (kr0 + krow) * 64 + col) * ZA_LD + 64 * h + part * 8;
            *(LAS u32x4*)(Ks + (krow * 64 + col) * 144 + part * 16) = *(const u32x4*)(src + 256);
            *(LAS u32x4*)(Vs + (krow * 64 + col) * 128 + part * 16) = *(const u32x4*)(src + 512); }
        for (int e = C.tid; e < 15 * 31; e += NTHR) Bs[e] = rpb[h * 465 + e];
        __syncthreads();
        for (int qi = 0; qi < 8; ++qi) {
            const int c = w + 8 * qi;
            const size_t tokq = (size_t)b * SEQL + r * 64 + c;
            const int cs = min(max(c - 8, 0), 48);
            float qf[64];
            { const u32x4* qp = (const u32x4*)(zA + tokq * ZA_LD + 64 * h);
#pragma unroll
              for (int i = 0; i < 8; ++i) { const u32x4 qv = qp[i];
                  qf[8 * i + 0] = __uint_as_float(qv.x << 16); qf[8 * i + 1] = __uint_as_float(qv.x & 0xffff0000u); qf[8 * i + 2] = __uint_as_float(qv.y << 16); qf[8 * i + 3] = __uint_as_float(qv.y & 0xffff0000u);
                  qf[8 * i + 4] = __uint_as_float(qv.z << 16); qf[8 * i + 5] = __uint_as_float(qv.z & 0xffff0000u); qf[8 * i + 6] = __uint_as_float(qv.w << 16); qf[8 * i + 7] = __uint_as_float(qv.w & 0xffff0000u); } }
            float sc[2];
#pragma unroll
            for (int hf = 0; hf < 2; ++hf) { const int key = lane + 64 * hf, krow = key >> 4, kc = cs + (key & 15);
                const LAS u32x4* kp = (const LAS u32x4*)(Ks + (krow * 64 + kc) * 144);
                float d = 0.f;
#pragma unroll
                for (int i = 0; i < 8; ++i) { const u32x4 kv = kp[i];
                    d += qf[8 * i + 0] * __uint_as_float(kv.x << 16) + qf[8 * i + 1] * __uint_as_float(kv.x & 0xffff0000u) + qf[8 * i + 2] * __uint_as_float(kv.y << 16) + qf[8 * i + 3] * __uint_as_float(kv.y & 0xffff0000u)
                       + qf[8 * i + 4] * __uint_as_float(kv.z << 16) + qf[8 * i + 5] * __uint_as_float(kv.z & 0xffff0000u) + qf[8 * i + 6] * __uint_as_float(kv.w << 16) + qf[8 * i + 7] * __uint_as_float(kv.w & 0xffff0000u); }
                sc[hf] = d * 0.125f + Bs[(kr0 + krow - r + 7) * 31 + (kc - c + 15)]; }
            const float mx = wave_max(fmaxf(sc[0], sc[1]));
            const float e0 = __expf(sc[0] - mx), e1 = __expf(sc[1] - mx);
            const float inv = 1.0f / wave_sum(e0 + e1);
            __syncthreads();
            Ps[w * 128 + lane] = e0 * inv; Ps[w * 128 + 64 + lane] = e1 * inv;
            __syncthreads();
            const int dp = lane & 31, kh = lane >> 5;
            float acc0 = 0.f, acc1 = 0.f;
#pragma unroll 8
            for (int k = 0; k < 64; ++k) { const int key = kh * 64 + k, krow = key >> 4, kc = cs + (key & 15);
                const float p = Ps[w * 128 + key];
                const unsigned vv = *(const LAS unsigned*)(Vs + (krow * 64 + kc) * 128 + dp * 4);
                acc0 += p * __uint_as_float(vv << 16); acc1 += p * __uint_as_float(vv & 0xffff0000u); }
            acc0 += __shfl_xor(acc0, 32); acc1 += __shfl_xor(acc1, 32);
            float ss = acc0 * acc0 + acc1 * acc1;
#pragma unroll
            for (int o = 16; o >= 1; o >>= 1) ss += __shfl_xor(ss, o);
            const float rstd = rsqrtf(ss * (1.0f / 64.0f) + EPSF);
            if (lane < 32) *(unsigned*)(XB + tokq * DM + 64 * h + 2 * dp) = pack2bf(acc0 * rstd, acc1 * rstd);
        }
        __syncthreads();
    }
}

__device__ __forceinline__ void mlstm_gates(const Ctx& C, int l, int b, int h, int c, LAS float* lff, LAS float* lfb, LAS float* lif, LAS float* lib) {
    if (C.tid < 128) {
        const float* gates = (const float*)(C.ws + OFF_GATES) + ((size_t)b * SEQL + c * 128 + C.tid) * 16;
        const float* gb = C.in(18) + l * 16;
        lif[C.tid] = gates[h] + gb[h];
        lff[C.tid] = logsigmoidf_(gates[4 + h] + gb[4 + h]);
        lib[C.tid] = gates[8 + h] + gb[8 + h];
        lfb[C.tid] = logsigmoidf_(gates[12 + h] + gb[12 + h]);
    }
}
__device__ __forceinline__ void phase_mlstm_local(const Ctx& C, int l) {
    LAS float* Ks = (LAS float*)C.lds;
    LAS float* Vs = Ks + 8192;
    LAS float* sm = Vs + 8192;
    LAS float* lff = sm, *lfb = sm + 128, *lif = sm + 256, *lib = sm + 384, *af = sm + 512, *ab = sm + 640, *wf = sm + 768, *wbk = sm + 896;
    const bf16_t* zA = (const bf16_t*)(C.ws + OFF_Z);
    float* STS = (float*)(C.ws + OFF_STS); float* STN = (float*)(C.ws + OFF_STN); float* STC = (float*)(C.ws + OFF_STC);
    for (int task = C.bid; task < NSEQ * 4 * 64; task += C.nb) {
        const int c = task & 63, h = (task >> 6) & 3, b = task >> 8;
        const size_t tok0 = (size_t)b * SEQL + c * 128;
        for (int e = C.tid; e < 1024; e += NTHR) { const int s = e >> 3, part = e & 7;
            const bf16_t* src = zA + (tok0 + s) * ZA_LD + 64 * h + part * 8;
            const u32x4 kv = *(const u32x4*)(src + 1024), vv = *(const u32x4*)(src + 1280);
            LAS float* kd = Ks + s * 64 + part * 8; LAS float* vd = Vs + s * 64 + part * 8;
            kd[0] = 0.125f * __uint_as_float(kv.x << 16); kd[1] = 0.125f * __uint_as_float(kv.x & 0xffff0000u); kd[2] = 0.125f * __uint_as_float(kv.y << 16); kd[3] = 0.125f * __uint_as_float(kv.y & 0xffff0000u);
            kd[4] = 0.125f * __uint_as_float(kv.z << 16); kd[5] = 0.125f * __uint_as_float(kv.z & 0xffff0000u); kd[6] = 0.125f * __uint_as_float(kv.w << 16); kd[7] = 0.125f * __uint_as_float(kv.w & 0xffff0000u);
            vd[0] = __uint_as_float(vv.x << 16); vd[1] = __uint_as_float(vv.x & 0xffff0000u); vd[2] = __uint_as_float(vv.y << 16); vd[3] = __uint_as_float(vv.y & 0xffff0000u);
            vd[4] = __uint_as_float(vv.z << 16); vd[5] = __uint_as_float(vv.z & 0xffff0000u); vd[6] = __uint_as_float(vv.w << 16); vd[7] = __uint_as_float(vv.w & 0xffff0000u); }
        mlstm_gates(C, l, b, h, c, lff, lfb, lif, lib);
        __syncthreads();
        if (C.tid < 128) { const int s = C.tid; float bf = 0.f, bb = 0.f, gF = 0.f, gB = 0.f;
            for (int t = 0; t < 128; ++t) { const float x = lff[t], y = lfb[t]; gF += x; gB += y; if (t <= s) bf += x; if (t >= s) bb += y; }
            af[s] = gF - bf + lif[s]; ab[s] = gB - bb + lib[s];
            if (s == 0) { sm[1024] = gF; sm[1025] = gB; } }
        __syncthreads();
        float mF = -3.0e38f, mB = -3.0e38f;
        for (int t = 0; t < 128; ++t) { mF = fmaxf(mF, af[t]); mB = fmaxf(mB, ab[t]); }
        if (C.tid < 128) { wf[C.tid] = expf(af[C.tid] - mF); wbk[C.tid] = expf(ab[C.tid] - mB); }
        __syncthreads();
        const int d = C.tid >> 3, eg = C.tid & 7;
        float aF[8], aB[8], nF = 0.f, nB = 0.f;
#pragma unroll
        for (int i = 0; i < 8; ++i) { aF[i] = 0.f; aB[i] = 0.f; }
#pragma unroll 4
        for (int s = 0; s < 128; ++s) { const float k = Ks[s * 64 + d], kf = k * wf[s], kb = k * wbk[s];
            const f32x4 va = *(const LAS f32x4*)(Vs + s * 64 + 8 * eg), vb2 = *(const LAS f32x4*)(Vs + s * 64 + 8 * eg + 4);
#pragma unroll
            for (int i = 0; i < 4; ++i) { aF[i] += kf * va[i]; aF[4 + i] += kf * vb2[i]; aB[i] += kb * va[i]; aB[4 + i] += kb * vb2[i]; }
            nF += kf; nB += kb; }
        const size_t sF = (size_t)((0 * 10 + b) * 4 + h) * 64 + c, sB = (size_t)((1 * 10 + b) * 4 + h) * 64 + c;
        *(f32x4*)(STS + sF * 4096 + d * 64 + 8 * eg) = (f32x4){aF[0], aF[1], aF[2], aF[3]}; *(f32x4*)(STS + sF * 4096 + d * 64 + 8 * eg + 4) = (f32x4){aF[4], aF[5], aF[6], aF[7]};
        *(f32x4*)(STS + sB * 4096 + d * 64 + 8 * eg) = (f32x4){aB[0], aB[1], aB[2], aB[3]}; *(f32x4*)(STS + sB * 4096 + d * 64 + 8 * eg + 4) = (f32x4){aB[4], aB[5], aB[6], aB[7]};
        if (eg == 0) { STN[sF * 64 + d] = nF; STN[sB * 64 + d] = nB; }
        if (C.tid == 0) { STC[sF * 4 + 0] = mF; STC[sF * 4 + 1] = sm[1024]; STC[sB * 4 + 0] = mB; STC[sB * 4 + 1] = sm[1025]; }
        __syncthreads();
    }
}
__device__ __forceinline__ void phase_mlstm_scan(const Ctx& C) {
    float* STS = (float*)(C.ws + OFF_STS); float* STN = (float*)(C.ws + OFF_STN); float* STC = (float*)(C.ws + OFF_STC);
    for (int idx = C.bid * NTHR + C.tid; idx < 80 * 4160; idx += C.nb * NTHR) {
        const int scan = idx / 4160, e = idx - scan * 4160, dir = scan / 40;
        float* base; int stride;
        if (e < 4096) { base = STS + (size_t)scan * 64 * 4096 + e; stride = 4096; } else { base = STN + (size_t)scan * 64 * 64 + (e - 4096); stride = 64; }
        float* sc = STC + (size_t)scan * 64 * 4;
        float st = 0.f, m = 0.f;
#pragma unroll 1
        for (int s0 = 0; s0 < 64; s0 += 8) {
            float loc[8], ml[8], gg[8];
#pragma unroll
            for (int u = 0; u < 8; ++u) { const int c = dir ? 63 - (s0 + u) : s0 + u; loc[u] = base[(size_t)c * stride]; ml[u] = sc[c * 4 + 0]; gg[u] = sc[c * 4 + 1]; }
#pragma unroll
            for (int u = 0; u < 8; ++u) { const int c = dir ? 63 - (s0 + u) : s0 + u;
                base[(size_t)c * stride] = st; if (e == 0) sc[c * 4 + 2] = m;
                const float mn = fmaxf(gg[u] + m, ml[u]); const float dold = expf(gg[u] + m - mn), dnew = expf(ml[u] - mn);
                st = dold * st + dnew * loc[u]; m = mn; }
        }
    }
}
__device__ __forceinline__ void phase_mlstm_out(const Ctx& C, int l) {
    LAS float* QT = (LAS float*)C.lds;
    LAS float* KT = QT + 8192;
    LAS float* Vs = KT + 8192;
    LAS float* S0f = Vs + 8192;
    LAS float* S0b = S0f + 4096;
    LAS float* sm = S0b + 4096;
    LAS float* PT = QT;
    LAS float* lff = sm, *lfb = sm + 128, *lif = sm + 256, *lib = sm + 384, *bfw = sm + 512, *bbw = sm + 640, *cF = sm + 768, *cB = sm + 896,
             *mtF = sm + 1024, *mtB = sm + 1152, *wiF = sm + 1280, *wiB = sm + 1408, *qnF = sm + 1536, *qnB = sm + 1664, *n0f = sm + 1792, *n0b = sm + 1856;
    const bf16_t* zA = (const bf16_t*)(C.ws + OFF_Z);
    bf16_t* XB = (bf16_t*)(C.ws + OFF_XB);
    const float* STS = (const float*)(C.ws + OFF_STS); const float* STN = (const float*)(C.ws + OFF_STN); const float* STC = (const float*)(C.ws + OFF_STC);
    const int jb = C.tid >> 4, sb = C.tid & 15, eb = sb;
    for (int task = C.bid; task < NSEQ * 4 * 64; task += C.nb) {
        const int c = task & 63, h = (task >> 6) & 3, b = task >> 8;
        const size_t tok0 = (size_t)b * SEQL + c * 128;
        const size_t sF = (size_t)((0 * 10 + b) * 4 + h) * 64 + c, sB = (size_t)((1 * 10 + b) * 4 + h) * 64 + c;
        for (int e = C.tid; e < 1024; e += NTHR) { const int s = e >> 3, part = e & 7;
            const bf16_t* src = zA + (tok0 + s) * ZA_LD + 64 * h + part * 8;
            const u32x4 qv = *(const u32x4*)(src + 768), kv = *(const u32x4*)(src + 1024), vv = *(const u32x4*)(src + 1280);
            const unsigned qa[4] = {qv.x, qv.y, qv.z, qv.w}, ka[4] = {kv.x, kv.y, kv.z, kv.w};
#pragma unroll
            for (int i = 0; i < 4; ++i) { const int d0 = part * 8 + 2 * i;
                QT[d0 * 128 + s] = __uint_as_float(qa[i] << 16); QT[(d0 + 1) * 128 + s] = __uint_as_float(qa[i] & 0xffff0000u);
                KT[d0 * 128 + s] = 0.125f * __uint_as_float(ka[i] << 16); KT[(d0 + 1) * 128 + s] = 0.125f * __uint_as_float(ka[i] & 0xffff0000u); }
            LAS float* vd = Vs + s * 64 + part * 8;
            vd[0] = __uint_as_float(vv.x << 16); vd[1] = __uint_as_float(vv.x & 0xffff0000u); vd[2] = __uint_as_float(vv.y << 16); vd[3] = __uint_as_float(vv.y & 0xffff0000u);
            vd[4] = __uint_as_float(vv.z << 16); vd[5] = __uint_as_float(vv.z & 0xffff0000u); vd[6] = __uint_as_float(vv.w << 16); vd[7] = __uint_as_float(vv.w & 0xffff0000u); }
        for (int e = C.tid; e < 1024; e += NTHR) { *(LAS f32x4*)(S0f + 4 * e) = *(const f32x4*)(STS + sF * 4096 + 4 * e); *(LAS f32x4*)(S0b + 4 * e) = *(const f32x4*)(STS + sB * 4096 + 4 * e); }
        if (C.tid < 64) n0f[C.tid] = STN[sF * 64 + C.tid]; else if (C.tid < 128) n0b[C.tid - 64] = STN[sB * 64 + C.tid - 64];
        mlstm_gates(C, l, b, h, c, lff, lfb, lif, lib);
        const float m0f = STC[sF * 4 + 2], m0b = STC[sB * 4 + 2];
        __syncthreads();
        if (C.tid < 128) { const int s = C.tid; float bf = 0.f, bb = 0.f;
            for (int t = 0; t < 128; ++t) { if (t <= s) bf += lff[t]; if (t >= s) bb += lfb[t]; }
            bfw[s] = bf; bbw[s] = bb; cF[s] = lif[s] - bf; cB[s] = lib[s] - bb; }
        __syncthreads();
        if (C.tid < 128) { const int j = C.tid; float cmF = -3.0e38f, cmB = -3.0e38f;
            for (int t = 0; t < 128; ++t) { if (t <= j) cmF = fmaxf(cmF, cF[t]); if (t >= j) cmB = fmaxf(cmB, cB[t]); }
            const float mf = bfw[j] + fmaxf(m0f, cmF), mb = bbw[j] + fmaxf(m0b, cmB);
            mtF[j] = mf; mtB[j] = mb; wiF[j] = expf(bfw[j] + m0f - mf); wiB[j] = expf(bbw[j] + m0b - mb);
            float a = 0.f, a2 = 0.f;
            for (int d = 0; d < 64; ++d) { const float q = QT[d * 128 + j]; a += q * n0f[d]; a2 += q * n0b[d]; }
            qnF[j] = a; qnB[j] = a2; }
        __syncthreads();
        float iF[4][4], iB[4][4];
#pragma unroll
        for (int a = 0; a < 4; ++a)
#pragma unroll
            for (int e = 0; e < 4; ++e) { iF[a][e] = 0.f; iB[a][e] = 0.f; }
#pragma unroll 2
        for (int d = 0; d < 64; ++d) { const f32x4 q4 = *(const LAS f32x4*)(QT + d * 128 + 4 * jb), f4 = *(const LAS f32x4*)(S0f + d * 64 + 4 * eb), b4 = *(const LAS f32x4*)(S0b + d * 64 + 4 * eb);
#pragma unroll
            for (int a = 0; a < 4; ++a)
#pragma unroll
                for (int e = 0; e < 4; ++e) { iF[a][e] += q4[a] * f4[e]; iB[a][e] += q4[a] * b4[e]; } }
        float S[4][8];
#pragma unroll
        for (int a = 0; a < 4; ++a)
#pragma unroll
            for (int e = 0; e < 8; ++e) S[a][e] = 0.f;
#pragma unroll 2
        for (int d = 0; d < 64; ++d) { const f32x4 q4 = *(const LAS f32x4*)(QT + d * 128 + 4 * jb), k0 = *(const LAS f32x4*)(KT + d * 128 + 8 * sb), k1 = *(const LAS f32x4*)(KT + d * 128 + 8 * sb + 4);
#pragma unroll
            for (int a = 0; a < 4; ++a)
#pragma unroll
                for (int e = 0; e < 4; ++e) { S[a][e] += q4[a] * k0[e]; S[a][4 + e] += q4[a] * k1[e]; } }
        float acc[4][4];
        {
            float pf[4][8], pb[4][8], rF[4], rB[4];
#pragma unroll
            for (int a = 0; a < 4; ++a) { const int j = 4 * jb + a; const float ef = bfw[j] - mtF[j], ebk = bbw[j] - mtB[j]; float rsf = 0.f, rsb = 0.f;
#pragma unroll
                for (int e = 0; e < 8; ++e) { const int s = 8 * sb + e;
                    pf[a][e] = (s <= j) ? expf(ef + cF[s]) * S[a][e] : 0.f; pb[a][e] = (s >= j) ? expf(ebk + cB[s]) * S[a][e] : 0.f;
                    rsf += pf[a][e]; rsb += pb[a][e]; }
#pragma unroll
                for (int o = 8; o >= 1; o >>= 1) { rsf += __shfl_xor(rsf, o); rsb += __shfl_xor(rsb, o); }
                const float denF = wiF[j] * qnF[j] + rsf, denB = wiB[j] * qnB[j] + rsb;
                rF[a] = 1.0f / fmaxf(fabsf(denF), expf(-mtF[j])); rB[a] = 1.0f / fmaxf(fabsf(denB), expf(-mtB[j]));
                const float sF2 = wiF[j] * rF[a], sB2 = wiB[j] * rB[a];
#pragma unroll
                for (int e = 0; e < 4; ++e) acc[a][e] = iF[a][e] * sF2 + iB[a][e] * sB2; }
            __syncthreads();
#pragma unroll
            for (int e = 0; e < 8; ++e) { f32x4 pc;
#pragma unroll
                for (int a = 0; a < 4; ++a) pc[a] = pf[a][e] * rF[a] + pb[a][e] * rB[a];
                *(LAS f32x4*)(PT + (8 * sb + e) * 128 + 4 * jb) = pc; }
        }
        __syncthreads();
#pragma unroll 2
        for (int s = 0; s < 128; ++s) { const f32x4 p4 = *(const LAS f32x4*)(PT + s * 128 + 4 * jb), v4 = *(const LAS f32x4*)(Vs + s * 64 + 4 * eb);
#pragma unroll
            for (int a = 0; a < 4; ++a)
#pragma unroll
                for (int e = 0; e < 4; ++e) acc[a][e] += p4[a] * v4[e]; }
#pragma unroll
        for (int a = 0; a < 4; ++a) { const size_t tok = tok0 + 4 * jb + a;
            const u32x2 ow = *(const u32x2*)(zA + tok * ZA_LD + 1536 + 64 * h + 4 * eb);
            float v[4]; v[0] = sigmoidf_(__uint_as_float(ow.x << 16)) * acc[a][0]; v[1] = sigmoidf_(__uint_as_float(ow.x & 0xffff0000u)) * acc[a][1];
            v[2] = sigmoidf_(__uint_as_float(ow.y << 16)) * acc[a][2]; v[3] = sigmoidf_(__uint_as_float(ow.y & 0xffff0000u)) * acc[a][3];
            float ss = v[0] * v[0] + v[1] * v[1] + v[2] * v[2] + v[3] * v[3];
#pragma unroll
            for (int o = 8; o >= 1; o >>= 1) ss += __shfl_xor(ss, o);
            const float rstd = rsqrtf(ss * (1.0f / 64.0f) + EPSF);
            u32x2 w; w.x = pack2bf(v[0] * rstd, v[1] * rstd); w.y = pack2bf(v[2] * rstd, v[3] * rstd);
            *(u32x2*)(XB + tok * DM + 768 + 64 * h + 4 * eb) = w; }
        __syncthreads();
    }
}

#ifndef NO_MIXERS
#define NO_MIXERS 0
#endif
__global__ void __launch_bounds__(NTHR, 2) mk_fwd(Params P) {
    extern __shared__ __attribute__((aligned(16))) unsigned char lds_raw[];
    cg::grid_group grid = cg::this_grid();
    Ctx C; C.tid = threadIdx.x; C.lane = C.tid & 63; C.wid = __builtin_amdgcn_readfirstlane(C.tid >> 6); C.bid = blockIdx.x; C.nb = gridDim.x; C.lds = (LAS unsigned char*)lds_raw;
    if (C.tid == 0) { LAS unsigned long long* sp = (LAS unsigned long long*)(C.lds + PARAM_OFF);
#pragma unroll
        for (int i = 0; i < 29; ++i) sp[i] = (unsigned long long)P.in[i];
        sp[29] = (unsigned long long)P.out; sp[30] = (unsigned long long)P.ws; }
    __syncthreads();
    unsigned char* ws = C.gptr(30); C.ws = ws;
    bf16_t* XB = (bf16_t*)(ws + OFF_XB);
    bf16_t* zA = (bf16_t*)(ws + OFF_Z);
    bf16_t* zB = (bf16_t*)(ws + OFF_ZB);
    bf16_t* ACT = (bf16_t*)(ws + OFF_Z);
    bf16_t* PROJ = (bf16_t*)(ws + OFF_Z);
    bf16_t* PB = (bf16_t*)(ws + OFF_PB);
    float* out = (float*)C.gptr(29);

    phase_prep0a(C);
    phase_norm(C.in(0), C.in(1), C, C.in(5), C.in(4));
    grid.sync();
    phase_weights(C);
#if !NO_MIXERS
    phase_kspec(C, 0);
#endif
    grid.sync();

#define FRESH() do { asm volatile("" : "+s"(l)); { LAS unsigned char* lp_ = (LAS unsigned char*)lds_raw; asm volatile("" : "+s"(lp_)); C.lds = lp_; } asm volatile("" : "+v"(C.tid)); C.lane = C.tid & 63; C.wid = __builtin_amdgcn_readfirstlane(C.tid >> 6); asm volatile("" : "+s"(C.bid), "+s"(C.nb)); ws = C.gptr(30); C.ws = ws; \
        XB = (bf16_t*)(ws + OFF_XB); zA = (bf16_t*)(ws + OFF_Z); zB = (bf16_t*)(ws + OFF_ZB); ACT = zA; PROJ = zA; PB = (bf16_t*)(ws + OFF_PB); out = (float*)C.gptr(29); wb = ws + OFF_W + (size_t)l * W_LAYER; } while (0)
    for (int l = 0; l < 2; ++l) {
        unsigned char* wb = ws + OFF_W + (size_t)l * W_LAYER;
        __syncthreads(); FRESH();
        { pg8::Gemm g{XB, (const bf16_t*)(wb + W_INA), T_TOK, ZA_LD, DM}; pg8::StaticOrder S; S.init(T_TOK, ZA_LD, C.nb, C.bid);
          pg8::EpiBf16<0> E{zA, ZA_LD, nullptr, 0, 0}; pg8::gemm_phase<pg8::EpiBf16<0>, pg8::StaticOrder>(C.lds, g, S, E, nullptr); }
        __syncthreads(); FRESH();
        { pg8::Gemm g{(const bf16_t*)(wb + W_INB), XB, ZB_ROWS, T_TOK, DM}; pg8::StaticOrder S; S.init(ZB_ROWS, T_TOK, C.nb, C.bid);
          pg8::EpiBf16<0> E{zB, T_TOK, nullptr, 0, 0}; pg8::gemm_phase<pg8::EpiBf16<0>, pg8::StaticOrder>(C.lds, g, S, E, nullptr); }
        __syncthreads();
#if !NO_MIXERS
        FRESH(); if (l == 1) phase_kspec(C, 1);
#endif
        grid.sync();
#if !NO_MIXERS
        FRESH(); phase_mlstm_local(C, l);
        FRESH(); phase_hyena(C, l);
        grid.sync();
        FRESH(); phase_mlstm_scan(C);
        FRESH(); phase_fnet(C);
        FRESH(); phase_na(C, l);
        grid.sync();
        FRESH(); phase_mlstm_out(C, l);
        FRESH(); phase_headnorm_cm(C);
        grid.sync();
#else
        for (size_t i = (size_t)C.bid * NTHR + C.tid; i < (size_t)T_TOK * DM / 8; i += (size_t)C.nb * NTHR) ((u32x4*)XB)[i] = (u32x4){0u, 0u, 0u, 0u};
        grid.sync();
#endif
        __syncthreads(); FRESH();
        { pg8::Gemm g{XB, (const bf16_t*)(wb + W_OUT), T_TOK, DM, DM}; pg8::StaticOrder S; S.init(T_TOK, DM, C.nb, C.bid);
          EpiResF32 E{l == 0 ? C.in(0) : out, l == 0 ? C.in(1) : out + (size_t)T_PROMPT * DM, out}; pg8::gemm_phase<EpiResF32, pg8::StaticOrder>(C.lds, g, S, E, nullptr); }
        grid.sync();
        FRESH(); phase_norm(out, out + (size_t)T_PROMPT * DM, C, nullptr, nullptr);
        FRESH(); phase_pconv(C.in(2) + (size_t)l * T_PROMPT * 256, C.in(3) + (size_t)l * (T_TOK - T_PROMPT) * 256, C);
        grid.sync();
        __syncthreads(); FRESH();
        { pg8::Gemm g{XB, (const bf16_t*)(wb + W_GU), T_TOK, 2 * DFF, DM}; pg8::StaticOrder S; S.init(T_TOK, 2 * DFF, C.nb, C.bid);
          EpiSwiGLU E{ACT}; pg8::gemm_phase<EpiSwiGLU, pg8::StaticOrder>(C.lds, g, S, E, nullptr); }
        grid.sync();
        __syncthreads(); FRESH();
        { pg8::Gemm g{ACT, (const bf16_t*)(wb + W_DOWN), T_TOK, DM, DFF}; pg8::StaticOrder S; S.init(T_TOK, DM, C.nb, C.bid);
          EpiResF32 E{out, out + (size_t)T_PROMPT * DM, out}; pg8::gemm_phase<EpiResF32, pg8::StaticOrder>(C.lds, g, S, E, nullptr); }
        grid.sync();
        FRESH(); phase_norm(out, out + (size_t)T_PROMPT * DM, C, nullptr, nullptr);
        __syncthreads(); FRESH();
        { pg8::Gemm g{PB, (const bf16_t*)(wb + W_PP), T_TOK, DM, 256}; pg8::StaticOrder S; S.init(T_TOK, DM, C.nb, C.bid);
          pg8::EpiBf16<0> E{PROJ, DM, nullptr, 0, 0}; pg8::gemm_phase<pg8::EpiBf16<0>, pg8::StaticOrder>(C.lds, g, S, E, nullptr); }
        grid.sync();
        __syncthreads(); FRESH();
        { pg8::Gemm g{XB, (const bf16_t*)(wb + W_PG), T_TOK, DM, DM}; pg8::StaticOrder S; S.init(T_TOK, DM, C.nb, C.bid);
          EpiPle E{out, PROJ}; pg8::gemm_phase<EpiPle, pg8::StaticOrder>(C.lds, g, S, E, nullptr); }
        grid.sync();
        FRESH();
        if (l == 0) { phase_norm(out, out + (size_t)T_PROMPT * DM, C, C.in(5) + (size_t)DM * NIN, C.in(4) + DM); grid.sync(); }
        else phase_final_norm(out, C.in(28), C);
    }
}

extern "C" void kernel_launch(void* const* d_in, const int* in_sizes, int n_in, void* d_out, int out_size, void* d_ws, size_t ws_size, hipStream_t stream) {
    static int grid_blocks = 0;
    if (grid_blocks == 0) {
        if (n_in != 29 || ws_size < WS_END) { fprintf(stderr, "kernel_launch: unexpected n_in %d or workspace %zu < %zu\n", n_in, ws_size, (size_t)WS_END); grid_blocks = -1; return; }
        int dev = 0, cus = 0, per_cu = 0;
        hipGetDevice(&dev);
        hipDeviceGetAttribute(&cus, hipDeviceAttributeMultiprocessorCount, dev);
        if (hipFuncSetAttribute((const void*)mk_fwd, hipFuncAttributeMaxDynamicSharedMemorySize, LDS_BYTES) != hipSuccess) { fprintf(stderr, "kernel_launch: hipFuncSetAttribute failed\n"); grid_blocks = -1; return; }
        if (hipOccupancyMaxActiveBlocksPerMultiprocessor(&per_cu, (const void*)mk_fwd, NTHR, LDS_BYTES) != hipSuccess || per_cu < 1) { fprintf(stderr, "kernel_launch: occupancy query says %d\n", per_cu); per_cu = 1; }
        (void)hipGetLastError();
        grid_blocks = cus * per_cu;
    }
    if (grid_blocks < 0) return;
    Params p{};
    for (int i = 0; i < 29; ++i) p.in[i] = (const float*)d_in[i];
    p.out = (float*)d_out; p.ws = (unsigned char*)d_ws;
    void* args[] = {&p};
    hipError_t e = hipLaunchCooperativeKernel((const void*)mk_fwd, dim3(grid_blocks), dim3(NTHR), args, LDS_BYTES, stream);
    if (e != hipSuccess) fprintf(stderr, "cooperative launch failed: %s (grid %d)\n", hipGetErrorString(e), grid_blocks);
}
```

```cpp
#include <hip/hip_runtime.h>
#include <hip/hip_cooperative_groups.h>
#include <cstdio>
namespace cg = cooperative_groups;
namespace pg8 {
#define PG8_LAS __attribute__((address_space(3)))
typedef unsigned short bf16_t;
typedef short bf16x8 __attribute__((ext_vector_type(8)));
typedef float f32x4 __attribute__((ext_vector_type(4)));
typedef unsigned u32x4 __attribute__((ext_vector_type(4)));
constexpr int BM = 256, BK = 64, HALF = 128, HTB = HALF * BK * 2  , STAGE_BYTES = 8 * HTB, NXCD = 8, WGM = 8;

__host__ __device__ __forceinline__ int lds_byte(int r, int c) { const int st = (r >> 4) * 2 + (c >> 5), rr = r & 15, cc = c & 31, ob = rr * 64 + cc * 2; return st * 1024 + (ob ^ (((ob >> 9) & 1) << 5)); }
__host__ __device__ __forceinline__ void stage_rc(int b, int& R, int& C) { const int st = b / 1024, sb = b % 1024, swz = sb ^ (((sb >> 9) & 1) << 5); R = (st >> 1) * 16 + swz / 64; C = (st & 1) * 32 + (swz % 64) / 2; }
__host__ __device__ __forceinline__ int perm32(int rho) { const int n = rho >> 4, i = rho & 15; return 8 * (i >> 2) + 4 * n + (i & 3); }

struct Unit { int pm, pn; };
struct Gemm { const bf16_t* A; const bf16_t* Bt; int M, N, K; };

struct StaticOrder {
    int nM, nN, nwg, G, c;
    __host__ __device__ void init(int M, int N, int G_, int c_) { nM = M / BM; nN = N / BM; nwg = nM * nN; G = G_; c = c_; }
    __host__ __device__ bool next(int i, Unit& u) const {
        const long L = (long)i * G + c; if (L >= nwg) return false;
        int wgid = (int)L; { const int q = nwg / NXCD, r = nwg % NXCD, xcd = wgid % NXCD, off = wgid / NXCD; wgid = (xcd < r ? xcd * (q + 1) : r * (q + 1) + (xcd - r) * q) + off; }
        const int nig = WGM * nN, gid = wgid / nig, fm = gid * WGM, gsz = (nM - fm) < WGM ? (nM - fm) : WGM;
        u.pm = fm + ((wgid % nig) % gsz); u.pn = (wgid % nig) / gsz; return true;
    }
    __device__ __forceinline__ void a_ready(const Unit&) const {}
    __device__ __forceinline__ void done(const Unit&) const {}
};
struct CountedOrder : StaticOrder {
    const unsigned* ready; unsigned need; unsigned* tmo;
    __device__ __forceinline__ void a_ready(const Unit& u) const {
        if (threadIdx.x < 64) {
            const unsigned long long t0 = __builtin_amdgcn_s_memrealtime(); unsigned polls = 0;
            while ((unsigned)__builtin_amdgcn_readfirstlane(__hip_atomic_load(ready + 64 * u.pm, __ATOMIC_RELAXED, __HIP_MEMORY_SCOPE_AGENT)) < need) {
                if ((++polls & 255u) == 0u && __builtin_amdgcn_readfirstlane(__hip_atomic_load(tmo, __ATOMIC_RELAXED, __HIP_MEMORY_SCOPE_AGENT)) != 0u) break;
                if (__builtin_amdgcn_s_memrealtime() - t0 > 2000000ull) {
                    if (threadIdx.x == 0) { unsigned expect = 0u; __hip_atomic_compare_exchange_strong(tmo + 1, &expect, 0x600u | (unsigned)(u.pm & 0xff), __ATOMIC_RELAXED, __ATOMIC_RELAXED, __HIP_MEMORY_SCOPE_AGENT); __hip_atomic_store(tmo, 1u, __ATOMIC_RELAXED, __HIP_MEMORY_SCOPE_AGENT); }
                    break; }
                __builtin_amdgcn_s_sleep(2); }
            __builtin_amdgcn_fence(__ATOMIC_ACQUIRE, "agent");
            asm volatile("s_waitcnt vmcnt(0)" ::: "memory");
        }
#if !defined(BROKEN_HOOK_NO_BARRIER)
        asm volatile("" ::: "memory"); __builtin_amdgcn_s_barrier(); asm volatile("" ::: "memory");
#endif
    }
};

__device__ __forceinline__ unsigned cvt_pk_bf16(float lo, float hi) { unsigned r; asm volatile("v_cvt_pk_bf16_f32 %0, %1, %2" : "=v"(r) : "v"(lo), "v"(hi)); return r; }
typedef float f32x2 __attribute__((ext_vector_type(2)));
__device__ __forceinline__ f32x2 gelu_pk(f32x2 v) {
    const f32x2 av = __builtin_elementwise_abs(v), d = av * 0.2316418882f + 1.0f;
    f32x2 t; t.x = __builtin_amdgcn_rcpf(d.x); t.y = __builtin_amdgcn_rcpf(d.y);
    f32x2 q = t * 0.5307027145f + (-0.7265760135f); q = q * t + 0.7107068705f; q = q * t + (-0.142248368f); q = q * t + 0.127414796f; q = q * t;
    const f32x2 s = (v * v) * (-0.72134752044f);
    f32x2 e; e.x = __builtin_amdgcn_exp2f(s.x); e.y = __builtin_amdgcn_exp2f(s.y);
    const f32x2 m = v * (q * e), r = v - m;
    f32x2 o; o.x = v.x < 0.f ? m.x : r.x; o.y = v.y < 0.f ? m.y : r.y; return o;
}

struct EpiF32 {
    static constexpr bool PERM = false, AFTER_DRAIN = false;
    float* C; int ldc; const float* bias;
    __device__ __forceinline__ void operator()(const f32x4 (&acc)[2][2][4][2], const Unit& u, int wr, int wc, int fr, int fq) const {
        const int row0 = u.pm * BM + wr * 64 + fr, col0 = u.pn * BM + wc * 32 + 4 * fq;
        f32x4 bv[2][2];
#pragma unroll
        for (int bj = 0; bj < 2; ++bj)
#pragma unroll
            for (int n = 0; n < 2; ++n) bv[bj][n] = bias ? *(const f32x4*)(bias + col0 + bj * HALF + n * 16) : (f32x4){0.f, 0.f, 0.f, 0.f};
#pragma unroll
        for (int ai = 0; ai < 2; ++ai)
#pragma unroll
            for (int m = 0; m < 4; ++m) { float* rowp = C + (size_t)(row0 + ai * HALF + m * 16) * ldc + col0;
#pragma unroll
                for (int bj = 0; bj < 2; ++bj)
#pragma unroll
                    for (int n = 0; n < 2; ++n) *(f32x4*)(rowp + bj * HALF + n * 16) = acc[ai][bj][m][n] + bv[bj][n]; }
    }
};
template <int ACT  > struct EpiBf16 {
    static constexpr bool PERM = true, AFTER_DRAIN = false;
    bf16_t* O; int ldc; const float* bias; int split_cols; size_t split_stride;
    __device__ __forceinline__ void operator()(const f32x4 (&acc)[2][2][4][2], const Unit& u, int wr, int wc, int fr, int fq) const {
        const int row0 = u.pm * BM + wr * 64 + fr; int colt = u.pn * BM; bf16_t* base = O;
        if (split_cols) { const int t = colt / split_cols; base += (size_t)t * split_stride; colt -= t * split_cols; }
        const int col0 = colt + wc * 32 + 8 * fq, bcol0 = u.pn * BM + wc * 32 + 8 * fq;
        f32x4 bv[2][2];
#pragma unroll
        for (int bj = 0; bj < 2; ++bj)
#pragma unroll
            for (int n = 0; n < 2; ++n) bv[bj][n] = bias ? *(const f32x4*)(bias + bcol0 + bj * HALF + 4 * n) : (f32x4){0.f, 0.f, 0.f, 0.f};
#pragma unroll
        for (int ai = 0; ai < 2; ++ai)
#pragma unroll
            for (int m = 0; m < 4; ++m) { bf16_t* rowp = base + (size_t)(row0 + ai * HALF + m * 16) * ldc + col0;
#pragma unroll
                for (int bj = 0; bj < 2; ++bj) { f32x4 v0 = acc[ai][bj][m][0] + bv[bj][0], v1 = acc[ai][bj][m][1] + bv[bj][1];
                    if (ACT == 1) { f32x2 a = gelu_pk((f32x2){v0[0], v0[1]}), b = gelu_pk((f32x2){v0[2], v0[3]}), c = gelu_pk((f32x2){v1[0], v1[1]}), d = gelu_pk((f32x2){v1[2], v1[3]});
                        v0 = (f32x4){a.x, a.y, b.x, b.y}; v1 = (f32x4){c.x, c.y, d.x, d.y}; }
                    if (ACT == 2) {
#pragma unroll
                        for (int j = 0; j < 4; ++j) { v0[j] = 0.5f * v0[j] * (1.0f + erff(v0[j] * 0.70710678f)); v1[j] = 0.5f * v1[j] * (1.0f + erff(v1[j] * 0.70710678f)); } }
                    u32x4 w; w.x = cvt_pk_bf16(v0[0], v0[1]); w.y = cvt_pk_bf16(v0[2], v0[3]); w.z = cvt_pk_bf16(v1[0], v1[1]); w.w = cvt_pk_bf16(v1[2], v1[3]);
                    *(u32x4*)(rowp + bj * HALF) = w; } }
    }
};
template <class Epi, class Sched, bool STAMP = false>
__device__ __forceinline__ void gemm_phase(PG8_LAS unsigned char* lds, const Gemm g, const Sched& S, const Epi& E, unsigned long long* stamps) {
    int tid_ = threadIdx.x; asm volatile("" : "+v"(tid_)); const int tid = tid_, wid = __builtin_amdgcn_readfirstlane(tid >> 6), lane = tid & 63, wr = wid >> 2, wc = wid & 3, fr = lane & 15, fq = lane >> 4;
    const int K = g.K, nt = K / BK;
    int ts_lo = 0, ts_hi = 0, nts = 0; const unsigned long long rt_entry = STAMP ? (unsigned long long)wall_clock64() : 0ull;
#define PG8_STAMP() do { if (STAMP && wid == 0 && nts < 64) { const unsigned long long _c = (unsigned long long)clock64(); \
        ts_lo = (lane == nts) ? (int)(unsigned)_c : ts_lo; ts_hi = (lane == nts) ? (int)(unsigned)(_c >> 32) : ts_hi; ++nts; } } while (0)
    PG8_STAMP();
    unsigned voffA[2], voffB[2];
#pragma unroll
    for (int i = 0; i < 2; ++i) { int R, C; stage_rc(tid * 16 + i * 8192, R, C); const int Rb = Epi::PERM ? ((R & ~31) + perm32(R & 31)) : R;
        voffA[i] = (unsigned)(R * K + C) * 2u; voffB[i] = (unsigned)(Rb * K + C) * 2u; }
    const size_t kstep = (size_t)(BK * 2);
    const size_t hstep = (size_t)HALF * K * 2;
    const size_t tstep = 2 * hstep;
    const unsigned ldsw = (unsigned)wid * 1024u;
    const int aoff = lds_byte(wr * 64 + fr, fq * 8), boff = lds_byte(wc * 32 + fr, fq * 8);
#define PG8_SA(b, h) (((b) * 2 + (h)) * HTB)
#define PG8_SB(b, h) ((4 + (b) * 2 + (h)) * HTB)
#define PG8_STAGE(bufoff, gbase, voff) do { _Pragma("unroll") for (int _i = 0; _i < 2; ++_i) \
        __builtin_amdgcn_global_load_lds((const unsigned*)((const char*)(gbase) + (voff)[_i]), (PG8_LAS unsigned*)(lds + (bufoff) + ldsw + _i * 8192), 16, 0, 0); } while (0)
#define PG8_LDA(dst, b, h) do { _Pragma("unroll") for (int m = 0; m < 4; ++m) _Pragma("unroll") for (int k = 0; k < 2; ++k) dst[m][k] = *(const PG8_LAS bf16x8*)(lds + PG8_SA(b, h) + aoff + m * 2048 + k * 1024); } while (0)
#define PG8_LDB(dst, b, h) do { _Pragma("unroll") for (int n = 0; n < 2; ++n) _Pragma("unroll") for (int k = 0; k < 2; ++k) dst[n][k] = *(const PG8_LAS bf16x8*)(lds + PG8_SB(b, h) + boff + n * 2048 + k * 1024); } while (0)
#define PG8_MMA(ai, bj, At, Bt) do { __builtin_amdgcn_s_setprio(1); _Pragma("unroll") for (int m = 0; m < 4; ++m) _Pragma("unroll") for (int n = 0; n < 2; ++n) _Pragma("unroll") for (int k = 0; k < 2; ++k) \
        acc[ai][bj][m][n] = __builtin_amdgcn_mfma_f32_16x16x32_bf16(Bt[n][k], At[m][k], acc[ai][bj][m][n], 0, 0, 0); __builtin_amdgcn_s_setprio(0); } while (0)
#define PG8_WAIT_V(n) asm volatile("s_waitcnt vmcnt(" #n ")" ::: "memory")
#define PG8_WAIT_L(n) asm volatile("s_waitcnt lgkmcnt(" #n ")" ::: "memory")
#define PG8_BAR __builtin_amdgcn_s_barrier()
#define PG8_SCHED __builtin_amdgcn_sched_barrier(0)
    Unit cur, nxt; int ui = 0;
    if (!S.next(0, cur)) return;
    f32x4 acc[2][2][4][2];
#pragma unroll
    for (int a = 0; a < 2; ++a)
#pragma unroll
        for (int b = 0; b < 2; ++b)
#pragma unroll
            for (int m = 0; m < 4; ++m)
#pragma unroll
                for (int n = 0; n < 2; ++n) acc[a][b][m][n] = (f32x4){0.f, 0.f, 0.f, 0.f};
    bf16x8 At[4][2], B0[2][2], B1[2][2];
    const char* cA = (const char*)g.A + (size_t)cur.pm * tstep; const char* cB = (const char*)g.Bt + (size_t)cur.pn * tstep;
    S.a_ready(cur);
    PG8_STAGE(PG8_SB(0, 0), cB, voffB); PG8_STAGE(PG8_SA(0, 0), cA, voffA); PG8_STAGE(PG8_SB(0, 1), cB + hstep, voffB); PG8_STAGE(PG8_SA(0, 1), cA + hstep, voffA);
    if (wr == 1) PG8_BAR;
    PG8_WAIT_V(4); PG8_BAR;
    PG8_STAGE(PG8_SB(1, 0), cB + kstep, voffB); PG8_STAGE(PG8_SA(1, 0), cA + kstep, voffA); PG8_STAGE(PG8_SB(1, 1), cB + hstep + kstep, voffB);
    PG8_WAIT_V(6); PG8_BAR;
    PG8_STAMP();
    for (;;) {
        const bool has_next = S.next(ui + 1, nxt);
        const char* nA = has_next ? (const char*)g.A + (size_t)nxt.pm * tstep : cA; const char* nB = has_next ? (const char*)g.Bt + (size_t)nxt.pn * tstep : cB;
        for (int t = 0; t < nt; t += 2) {
            const bool last = (t == nt - 2);
            const char* a1 = cA + (size_t)(t + 1) * kstep;
            const char* a2 = last ? nA : cA + (size_t)(t + 2) * kstep; const char* b2 = last ? nB : cB + (size_t)(t + 2) * kstep;
            const char* a3 = a2 + kstep; const char* b3 = b2 + kstep;
            if (last && has_next) S.a_ready(nxt);
            PG8_LDB(B0, 0, 0); PG8_SCHED; PG8_LDA(At, 0, 0); PG8_STAGE(PG8_SA(1, 1), a1 + hstep, voffA);
            PG8_WAIT_L(8); PG8_BAR; PG8_WAIT_L(0); PG8_MMA(0, 0, At, B0); PG8_BAR; PG8_SCHED;
            PG8_LDB(B1, 0, 1); PG8_STAGE(PG8_SB(0, 0), b2, voffB);
            PG8_BAR; PG8_WAIT_L(0); PG8_MMA(0, 1, At, B1); PG8_BAR;
            PG8_LDA(At, 0, 1); PG8_STAGE(PG8_SA(0, 0), a2, voffA);
            PG8_BAR; PG8_WAIT_L(0); PG8_MMA(1, 0, At, B0); PG8_BAR; PG8_SCHED;
            PG8_STAGE(PG8_SB(0, 1), b2 + hstep, voffB);
            PG8_WAIT_V(6); PG8_BAR; PG8_MMA(1, 1, At, B1); PG8_BAR;
            PG8_LDB(B0, 1, 0); PG8_SCHED; PG8_LDA(At, 1, 0); PG8_STAGE(PG8_SA(0, 1), a2 + hstep, voffA);
            PG8_WAIT_L(8); PG8_BAR; PG8_WAIT_L(0); PG8_MMA(0, 0, At, B0); PG8_BAR; PG8_SCHED;
            PG8_LDB(B1, 1, 1); PG8_STAGE(PG8_SB(1, 0), b3, voffB);
            PG8_BAR; PG8_WAIT_L(0); PG8_MMA(0, 1, At, B1); PG8_BAR;
            PG8_LDA(At, 1, 1); PG8_STAGE(PG8_SA(1, 0), a3, voffA);
            PG8_BAR; PG8_WAIT_L(0); PG8_MMA(1, 0, At, B0); PG8_BAR; PG8_SCHED;
            PG8_STAGE(PG8_SB(1, 1), b3 + hstep, voffB);
            PG8_WAIT_V(6); PG8_BAR; PG8_MMA(1, 1, At, B1); PG8_BAR;
        }
        PG8_STAMP();
        if constexpr (!Epi::AFTER_DRAIN) { E(acc, cur, wr, wc, fr, fq); S.done(cur); }
        PG8_STAMP();
        if (!has_next) break;
#pragma unroll
        for (int a = 0; a < 2; ++a)
#pragma unroll
            for (int b = 0; b < 2; ++b)
#pragma unroll
                for (int m = 0; m < 4; ++m)
#pragma unroll
                    for (int n = 0; n < 2; ++n) acc[a][b][m][n] = (f32x4){0.f, 0.f, 0.f, 0.f};
        cur = nxt; cA = nA; cB = nB; ++ui;
    }
    PG8_WAIT_V(0);
    if (wr == 0) PG8_BAR;
    PG8_BAR;
    if constexpr (Epi::AFTER_DRAIN) { E.fused(acc, cur, wr, wc, fr, fq, lds, wid, lane); S.done(cur); }
    PG8_STAMP();
    if (STAMP && wid == 0) { stamps[lane] = lane < nts ? (((unsigned long long)(unsigned)ts_hi << 32) | (unsigned)ts_lo) : 0ull;
        if (lane == 62) stamps[62] = rt_entry; if (lane == 63) stamps[63] = (unsigned long long)wall_clock64(); }
#undef PG8_STAMP
#undef PG8_SA
#undef PG8_SB
#undef PG8_STAGE
#undef PG8_LDA
#undef PG8_LDB
#undef PG8_MMA
#undef PG8_WAIT_V
#undef PG8_WAIT_L
#undef PG8_BAR
#undef PG8_SCHED
}
}

typedef unsigned short bf16_t;
typedef float f32x4 __attribute__((ext_vector_type(4)));
typedef unsigned u32x4 __attribute__((ext_vector_type(4)));
typedef unsigned u32x2 __attribute__((ext_vector_type(2)));
#define LAS __attribute__((address_space(3)))

constexpr int T_TOK = 81920, T_PROMPT = 16384, SEQL = 8192, NSEQ = 10, DM = 1024, DFF = 2816, NIN = 2832;
constexpr int ZA_LD = 1792;
constexpr int ZB_ROWS = 1280;
constexpr float EPSF = 1e-6f;
constexpr int NTHR = 512;
constexpr int LDS_BYTES = 152 * 1024;

constexpr size_t al256(size_t x) { return (x + 255) & ~(size_t)255; }
constexpr size_t OFF_TW = 0;
constexpr size_t OFF_H2 = OFF_TW + 8192 * 8;
constexpr size_t OFF_FAB = OFF_H2 + (size_t)2 * 8192 * 64 * 4;
constexpr size_t OFF_W = OFF_FAB + (size_t)2 * 4 * 2 * 4096 * 4;
constexpr size_t W_INA = 0;
constexpr size_t W_INB = W_INA + (size_t)1792 * 1024 * 2;
constexpr size_t W_OUT = W_INB + (size_t)1280 * 1024 * 2;
constexpr size_t W_GU = W_OUT + (size_t)1024 * 1024 * 2;
constexpr size_t W_DOWN = W_GU + (size_t)5632 * 1024 * 2;
constexpr size_t W_PG = W_DOWN + (size_t)1024 * 2816 * 2;
constexpr size_t W_PP = W_PG + (size_t)1024 * 1024 * 2;
constexpr size_t W_LAYER = W_PP + (size_t)1024 * 256 * 2;
constexpr size_t OFF_KS = OFF_W + 2 * W_LAYER;
constexpr size_t OFF_XB = OFF_KS + (size_t)2 * 256 * 16384 * 8;
constexpr size_t OFF_GATES = OFF_XB + (size_t)T_TOK * 1024 * 2;
constexpr size_t OFF_PB = OFF_GATES + (size_t)T_TOK * 16 * 4;
constexpr size_t OFF_STS = OFF_PB + (size_t)T_TOK * 256 * 2;
constexpr size_t OFF_STN = OFF_STS + (size_t)80 * 64 * 4096 * 4;
constexpr size_t OFF_STC = OFF_STN + (size_t)80 * 64 * 64 * 4;
constexpr size_t OFF_Z = al256(OFF_STC + (size_t)80 * 64 * 4 * 4);
constexpr size_t OFF_ZB = OFF_Z + (size_t)T_TOK * ZA_LD * 2;
constexpr size_t OFF_SCR = OFF_ZB + (size_t)ZB_ROWS * T_TOK * 2;
constexpr size_t OFF_BAR = OFF_SCR + (size_t)256 * 8192 * 8;
constexpr size_t WS_END = OFF_BAR + 256;

struct Params { const float* in[29]; float* out; unsigned char* ws; };

__device__ __forceinline__ bf16_t f2bf(float f) { unsigned u = __float_as_uint(f); u += 0x7FFFu + ((u >> 16) & 1u); return (bf16_t)(u >> 16); }
__device__ __forceinline__ float bf2f(bf16_t b) { return __uint_as_float(((unsigned)b) << 16); }
__device__ __forceinline__ unsigned pack2bf(float lo, float hi) { unsigned r; asm("v_cvt_pk_bf16_f32 %0, %1, %2" : "=v"(r) : "v"(lo), "v"(hi)); return r; }
__device__ __forceinline__ float wave_sum(float v) {
#pragma unroll
    for (int o = 32; o >= 1; o >>= 1) v += __shfl_xor(v, o);
    return v;
}
__device__ __forceinline__ float wave_max(float v) {
#pragma unroll
    for (int o = 32; o >= 1; o >>= 1) v = fmaxf(v, __shfl_xor(v, o));
    return v;
}
__device__ __forceinline__ float sigmoidf_(float x) { return __builtin_amdgcn_rcpf(1.0f + __expf(-x)); }
__device__ __forceinline__ float logsigmoidf_(float x) { return x >= 0.f ? -log1pf(expf(-x)) : x - log1pf(expf(x)); }
__device__ __forceinline__ const float* xrow_ptr(const float* x0, const float* x1, int row) { return row < T_PROMPT ? x0 + (size_t)row * DM : x1 + (size_t)(row - T_PROMPT) * DM; }

struct EpiResF32 {
    static constexpr bool PERM = true, AFTER_DRAIN = false;
    const float* b0; const float* b1; float* out;
    __device__ __forceinline__ void operator()(const pg8::f32x4 (&acc)[2][2][4][2], const pg8::Unit& u, int wr, int wc, int fr, int fq) const {
        const int row0 = u.pm * 256 + wr * 64 + fr, col0 = u.pn * 256 + wc * 32 + 8 * fq;
        const float* base = (u.pm * 256 < T_PROMPT) ? b0 : b1 - (size_t)T_PROMPT * DM;
        f32x4 bs[4][4];
#define ERF_LOAD(g) do { const unsigned off_ = (unsigned)(row0 + ((g) >> 2) * 128 + ((g) & 3) * 16) * DM + col0; \
        bs[(g) % 4][0] = *(const f32x4*)(base + off_); bs[(g) % 4][1] = *(const f32x4*)(base + off_ + 4); bs[(g) % 4][2] = *(const f32x4*)(base + off_ + 128); bs[(g) % 4][3] = *(const f32x4*)(base + off_ + 132); } while (0)
        ERF_LOAD(0); asm volatile("" ::: "memory"); ERF_LOAD(1); asm volatile("" ::: "memory"); ERF_LOAD(2); asm volatile("" ::: "memory");
#pragma unroll
        for (int g = 0; g < 8; ++g) { const int ai = g >> 2, m = g & 3;
            if (g + 3 < 8) { ERF_LOAD(g + 3); }
            asm volatile("" ::: "memory");
            const unsigned off = (unsigned)(row0 + ai * 128 + m * 16) * DM + col0;
            *(f32x4*)(out + off) = bs[g % 4][0] + acc[ai][0][m][0]; *(f32x4*)(out + off + 4) = bs[g % 4][1] + acc[ai][0][m][1];
            *(f32x4*)(out + off + 128) = bs[g % 4][2] + acc[ai][1][m][0]; *(f32x4*)(out + off + 132) = bs[g % 4][3] + acc[ai][1][m][1];
            asm volatile("" ::: "memory"); }
#undef ERF_LOAD
    }
};
struct EpiSwiGLU {
    static constexpr bool PERM = true, AFTER_DRAIN = false;
    bf16_t* O;
    __device__ __forceinline__ void operator()(const pg8::f32x4 (&acc)[2][2][4][2], const pg8::Unit& u, int wr, int wc, int fr, int fq) const {
        const int row0 = u.pm * 256 + wr * 64 + fr, col0 = u.pn * 128 + wc * 32 + 8 * fq;
#pragma unroll
        for (int ai = 0; ai < 2; ++ai)
#pragma unroll
            for (int m = 0; m < 4; ++m) { float r[8];
#pragma unroll
                for (int n = 0; n < 2; ++n) { const f32x4 g = acc[ai][0][m][n], up = acc[ai][1][m][n];
#pragma unroll
                    for (int j = 0; j < 4; ++j) r[4 * n + j] = g[j] * sigmoidf_(g[j]) * up[j]; }
                u32x4 w; w.x = pack2bf(r[0], r[1]); w.y = pack2bf(r[2], r[3]); w.z = pack2bf(r[4], r[5]); w.w = pack2bf(r[6], r[7]);
                *(u32x4*)(O + (size_t)(row0 + ai * 128 + m * 16) * DFF + col0) = w; }
    }
};
struct EpiPle {
    static constexpr bool PERM = true, AFTER_DRAIN = false;
    float* out; const bf16_t* proj;
    __device__ __forceinline__ void operator()(const pg8::f32x4 (&acc)[2][2][4][2], const pg8::Unit& u, int wr, int wc, int fr, int fq) const {
        const int row0 = u.pm * 256 + wr * 64 + fr, col0 = u.pn * 256 + wc * 32 + 8 * fq;
        f32x4 bs[3][4]; u32x2 pj[3][4];
#define EPL_LOAD(g) do { const unsigned off_ = (unsigned)(row0 + ((g) >> 2) * 128 + ((g) & 3) * 16) * DM + col0; \
        bs[(g) % 3][0] = *(const f32x4*)(out + off_); bs[(g) % 3][1] = *(const f32x4*)(out + off_ + 4); bs[(g) % 3][2] = *(const f32x4*)(out + off_ + 128); bs[(g) % 3][3] = *(const f32x4*)(out + off_ + 132); \
        pj[(g) % 3][0] = *(const u32x2*)(proj + off_); pj[(g) % 3][1] = *(const u32x2*)(proj + off_ + 4); pj[(g) % 3][2] = *(const u32x2*)(proj + off_ + 128); pj[(g) % 3][3] = *(const u32x2*)(proj + off_ + 132); } while (0)
        EPL_LOAD(0); asm volatile("" ::: "memory"); EPL_LOAD(1); asm volatile("" ::: "memory");
#pragma unroll
        for (int g = 0; g < 8; ++g) { const int ai = g >> 2, m = g & 3;
            if (g + 2 < 8) { EPL_LOAD(g + 2); }
            asm volatile("" ::: "memory");
            const unsigned off = (unsigned)(row0 + ai * 128 + m * 16) * DM + col0;
#pragma unroll
            for (int q = 0; q < 4; ++q) { const f32x4 a = acc[ai][q >> 1][m][q & 1], b = bs[g % 3][q]; const u32x2 pw = pj[g % 3][q]; f32x4 r;
                r[0] = b[0] + sigmoidf_(a[0]) * __uint_as_float(pw.x << 16); r[1] = b[1] + sigmoidf_(a[1]) * __uint_as_float(pw.x & 0xffff0000u);
                r[2] = b[2] + sigmoidf_(a[2]) * __uint_as_float(pw.y << 16); r[3] = b[3] + sigmoidf_(a[3]) * __uint_as_float(pw.y & 0xffff0000u);
                *(f32x4*)(out + off + (q >> 1) * 128 + (q & 1) * 4) = r; }
            asm volatile("" ::: "memory"); }
#undef EPL_LOAD
    }
};

constexpr int PARAM_OFF = LDS_BYTES - 512;
struct Ctx { int tid, lane, wid, bid, nb; unsigned char* ws; LAS unsigned char* lds;
    __device__ __forceinline__ unsigned long long raw(int i) const { const unsigned long long v = ((const LAS unsigned long long*)(lds + PARAM_OFF))[i];
        const unsigned lo = __builtin_amdgcn_readfirstlane((unsigned)v), hi = __builtin_amdgcn_readfirstlane((unsigned)(v >> 32)); return ((unsigned long long)hi << 32) | lo; }
    __device__ __forceinline__ const float* in(int i) const { return (const float*)(const __attribute__((address_space(1))) float*)raw(i); }
    __device__ __forceinline__ unsigned char* gptr(int i) const { return (unsigned char*)(__attribute__((address_space(1))) unsigned char*)raw(i); }
};

__device__ __forceinline__ void phase_prep0a(const Ctx& C) {
    const int gt = C.bid * NTHR + C.tid, gn = C.nb * NTHR;
    typedef float f32x2_ __attribute__((ext_vector_type(2))); f32x2_* TW = (f32x2_*)(C.ws + OFF_TW);
    for (int k = gt; k < 8192; k += gn) { float s, c; sincospif((float)k * (1.0f / 8192.0f), &s, &c); { f32x2_ tv; tv.x = c; tv.y = -s; TW[k] = tv; } }
    float* FAB = (float*)(C.ws + OFF_FAB);
    for (int i = gt; i < 2 * 4 * 2 * 4096; i += gn) {
        const int d = i & 63, c = (i >> 6) & 63, ab = (i >> 12) & 1, g = (i >> 13) & 3, l = i >> 15;
        const float* w = C.in(7) + (size_t)((l * 4 + g) * 64) * 64;
        float acc = 0.f;
        for (int dp = 0; dp < 64; ++dp) { float s, cc; sincospif((float)((dp * c) & 63) * (1.0f / 32.0f), &s, &cc); acc += (ab ? s : cc) * w[dp * 64 + d]; }
        const float sc = 1.0f / sqrtf(64.0f * 8192.0f);
        FAB[i] = ab ? -acc * sc : acc * sc;
    }
    float* H2 = (float*)(C.ws + OFF_H2);
    const int gw = C.bid * 8 + C.wid, lane = C.lane;
#pragma unroll 1
    for (int l = 0; l < 2; ++l) {
        const float* w1 = C.in(10) + l * 33 * 64; const float* w2 = C.in(13) + l * 4096;
        const float b1 = C.in(11)[l * 64 + lane], b2 = C.in(14)[l * 64 + lane], fq0 = C.in(12)[l * 128 + lane], fq1 = C.in(12)[l * 128 + 64 + lane];
        float w1c[33], w2c[64];
#pragma unroll
        for (int i = 0; i < 33; ++i) w1c[i] = w1[i * 64 + lane];
#pragma unroll
        for (int i = 0; i < 64; ++i) w2c[i] = w2[i * 64 + lane];
#pragma unroll 1
        for (int s = gw; s < 8192; s += C.nb * 8) {
            const float t = (float)s / 8191.0f;
            const float ang = (float)(2.0 * 3.14159265358979323846 / 8192.0) * (float)s;
            float feat = 0.f;
            if (lane == 0) feat = t;
            else if (lane <= 32) { const int bi = (lane - 1) & 15; const float band = 1e-4f + (float)bi * ((15.0f - 1e-4f) / 15.0f); const float fb = ang * band; feat = lane <= 16 ? cosf(fb) : -sinf(fb); }
            float a = b1;
#pragma unroll
            for (int i = 0; i < 33; ++i) a += __shfl(feat, i) * w1c[i];
            const float h1 = sinf(fq0 * a);
            float a2 = b2;
#pragma unroll
            for (int i = 0; i < 64; ++i) a2 += __shfl(h1, i) * w2c[i];
            H2[(size_t)(l * 8192 + s) * 64 + lane] = sinf(fq1 * a2);
        }
    }
}

template <class ColF>
__device__ __forceinline__ void wtranspose(ColF colp, int ldw, int NOUT, int K, const float* gain, bf16_t* dst, const Ctx& C) {
    LAS float* tile = (LAS float*)C.lds;
    const int ntn = NOUT / 64, ntk = K / 64;
    for (int t = C.bid; t < ntn * ntk; t += C.nb) {
        const int tn = t % ntn, tk = t / ntn;
#pragma unroll
        for (int i = 0; i < 8; ++i) { const int e = C.tid + NTHR * i, jj = e & 63, ii = e >> 6, k = tk * 64 + ii;
            float v = colp(tn * 64 + jj)[(size_t)k * ldw]; if (gain) v *= gain[k]; tile[ii * 65 + jj] = v; }
        __syncthreads();
#pragma unroll
        for (int i = 0; i < 8; ++i) { const int e = C.tid + NTHR * i, ii = e & 63, jj = e >> 6; dst[(size_t)(tn * 64 + jj) * K + tk * 64 + ii] = f2bf(tile[ii * 65 + jj]); }
        __syncthreads();
    }
}
__device__ __forceinline__ void phase_weights(const Ctx& C) {
    for (int l = 0; l < 2; ++l) {
        unsigned char* wb = C.ws + OFF_W + (size_t)l * W_LAYER;
        const float* w_in = C.in(5) + (size_t)l * DM * NIN;
        const float* g_mix = C.in(4) + l * DM;
        wtranspose([=](int n) { return w_in + (n < 768 ? n : n + 1024); }, NIN, 1792, DM, g_mix, (bf16_t*)(wb + W_INA), C);
        wtranspose([=](int n) { return w_in + 1024 + n; }, NIN, 768, DM, g_mix, (bf16_t*)(wb + W_INB) + (size_t)512 * DM, C);
        const float* w_out = C.in(20) + (size_t)l * DM * DM;
        wtranspose([=](int n) { return w_out + n; }, DM, DM, DM, C.in(19) + l * DM, (bf16_t*)(wb + W_OUT), C);
        const float* w_g = C.in(22) + (size_t)l * DM * DFF; const float* w_u = C.in(23) + (size_t)l * DM * DFF;
        const long long gu_delta = (long long)(w_u - w_g);
        wtranspose([=](int r) { return w_g + ((r & 128) ? gu_delta : 0ll) + 128 * (r >> 8) + (r & 127); }, DFF, 2 * DFF, DM, C.in(21) + l * DM, (bf16_t*)(wb + W_GU), C);
        const float* w_d = C.in(24) + (size_t)l * DFF * DM;
        wtranspose([=](int n) { return w_d + n; }, DM, DM, DFF, nullptr, (bf16_t*)(wb + W_DOWN), C);
        const float* w_pg = C.in(26) + (size_t)l * DM * DM;
        wtranspose([=](int n) { return w_pg + n; }, DM, DM, DM, C.in(25) + l * DM, (bf16_t*)(wb + W_PG), C);
        const float* w_pp = C.in(27) + (size_t)l * 256 * DM;
        wtranspose([=](int n) { return w_pp + n; }, DM, DM, 256, nullptr, (bf16_t*)(wb + W_PP), C);
    }
    LAS float* wt = (LAS float*)C.lds; LAS float* fa = wt + 64 * 65; LAS float* fb = fa + 4096;
    const float* FAB = (const float*)(C.ws + OFF_FAB);
    for (int t = C.bid; t < 2 * 4 * 16; t += C.nb) {
        const int tk = t & 15, g = (t >> 4) & 3, l = t >> 6;
        const float* w_in = C.in(5) + (size_t)l * DM * NIN; const float* g_mix = C.in(4) + l * DM;
#pragma unroll
        for (int i = 0; i < 8; ++i) { const int e = C.tid + NTHR * i, cc = e & 63, ii = e >> 6, k = tk * 64 + ii;
            wt[ii * 65 + cc] = w_in[(size_t)k * NIN + 768 + 64 * g + cc] * g_mix[k];
            fa[e] = FAB[((l * 4 + g) * 2 + 0) * 4096 + e]; fb[e] = FAB[((l * 4 + g) * 2 + 1) * 4096 + e]; }
        __syncthreads();
        const int k = C.tid & 63, dg = C.tid >> 6;
        float ap[8], aq[8];
#pragma unroll
        for (int i = 0; i < 8; ++i) { ap[i] = 0.f; aq[i] = 0.f; }
        for (int c = 0; c < 64; ++c) { const float w = wt[k * 65 + c];
#pragma unroll
            for (int i = 0; i < 8; ++i) { ap[i] += w * fa[c * 64 + dg * 8 + i]; aq[i] += w * fb[c * 64 + dg * 8 + i]; } }
        bf16_t* wB = (bf16_t*)(C.ws + OFF_W + (size_t)l * W_LAYER + W_INB);
#pragma unroll
        for (int i = 0; i < 8; ++i) { const int d = dg * 8 + i; wB[(size_t)(64 * g + d) * DM + tk * 64 + k] = f2bf(ap[i]); wB[(size_t)(256 + 64 * g + d) * DM + tk * 64 + k] = f2bf(aq[i]); }
        __syncthreads();
    }
}

__device__ __forceinline__ void phase_norm(const float* x0, const float* x1, const Ctx& C, const float* gate_w  , const float* gate_gain) {
    bf16_t* XB = (bf16_t*)(C.ws + OFF_XB);
    float* gates = (float*)(C.ws + OFF_GATES);
    LAS float* wg = (LAS float*)C.lds;
    if (gate_w) {
        for (int e = C.tid; e < 16 * 1024; e += NTHR) { const int j = e & 15, k = e >> 4; wg[j * 1024 + k] = gate_w[(size_t)k * NIN + 2816 + j] * gate_gain[k]; }
        __syncthreads();
    }
    const int lane = C.lane;
    const int rstep = C.nb * 8;
    f32x4 nx[4], ny[4];
    { const int row = C.bid * 8 + C.wid; if (row < T_TOK) { const float* xr = xrow_ptr(x0, x1, row);
#pragma unroll
        for (int j = 0; j < 4; ++j) nx[j] = __builtin_nontemporal_load((const f32x4*)(xr + 4 * lane + 256 * j)); }
      if (row + rstep < T_TOK) { const float* xr = xrow_ptr(x0, x1, row + rstep);
#pragma unroll
        for (int j = 0; j < 4; ++j) ny[j] = __builtin_nontemporal_load((const f32x4*)(xr + 4 * lane + 256 * j)); } }
    for (int row = C.bid * 8 + C.wid; row < T_TOK; row += rstep) {
        f32x4 v[4]; float ss = 0.f;
#pragma unroll
        for (int j = 0; j < 4; ++j) { v[j] = nx[j]; nx[j] = ny[j]; }
        if (row + 2 * rstep < T_TOK) { const float* xn = xrow_ptr(x0, x1, row + 2 * rstep);
#pragma unroll
            for (int j = 0; j < 4; ++j) ny[j] = __builtin_nontemporal_load((const f32x4*)(xn + 4 * lane + 256 * j)); }
#pragma unroll
        for (int j = 0; j < 4; ++j) ss += v[j][0] * v[j][0] + v[j][1] * v[j][1] + v[j][2] * v[j][2] + v[j][3] * v[j][3];
        ss = wave_sum(ss);
        const float rstd = rsqrtf(ss * (1.0f / 1024.0f) + EPSF);
#pragma unroll
        for (int j = 0; j < 4; ++j) { u32x2 w; w.x = pack2bf(v[j][0] * rstd, v[j][1] * rstd); w.y = pack2bf(v[j][2] * rstd, v[j][3] * rstd); *(u32x2*)(XB + (size_t)row * DM + 4 * lane + 256 * j) = w; }
        if (gate_w) {
            float p[16];
#pragma unroll
            for (int jg = 0; jg < 16; ++jg) { float a = 0.f;
#pragma unroll
                for (int j = 0; j < 4; ++j) { const f32x4 w4 = *(const LAS f32x4*)(wg + jg * 1024 + 4 * lane + 256 * j); a += v[j][0] * w4[0] + v[j][1] * w4[1] + v[j][2] * w4[2] + v[j][3] * w4[3]; }
                p[jg] = a; asm volatile("" ::: "memory"); }
            float q8[8], q4[4], q2[2], q1;
            { const bool hi = lane & 32;
#pragma unroll
              for (int j = 0; j < 8; ++j) { const float mine = hi ? p[j + 8] : p[j], oth = hi ? p[j] : p[j + 8]; q8[j] = mine + __shfl_xor(oth, 32); } }
            { const bool hi = lane & 16;
#pragma unroll
              for (int j = 0; j < 4; ++j) { const float mine = hi ? q8[j + 4] : q8[j], oth = hi ? q8[j] : q8[j + 4]; q4[j] = mine + __shfl_xor(oth, 16); } }
            { const bool hi = lane & 8;
#pragma unroll
              for (int j = 0; j < 2; ++j) { const float mine = hi ? q4[j + 2] : q4[j], oth = hi ? q4[j] : q4[j + 2]; q2[j] = mine + __shfl_xor(oth, 8); } }
            { const bool hi = lane & 4; const float mine = hi ? q2[1] : q2[0], oth = hi ? q2[0] : q2[1]; q1 = mine + __shfl_xor(oth, 4); }
            q1 += __shfl_xor(q1, 2); q1 += __shfl_xor(q1, 1);
            if ((lane & 3) == 0) gates[(size_t)row * 16 + (((lane >> 5) & 1) * 8 + ((lane >> 4) & 1) * 4 + ((lane >> 3) & 1) * 2 + ((lane >> 2) & 1))] = q1 * rstd;
        }
    }
    if (gate_w) __syncthreads();
}
__device__ __forceinline__ void phase_pconv(const float* p0, const float* p1, const Ctx& C) {
    bf16_t* PB = (bf16_t*)(C.ws + OFF_PB);
    const size_t n4 = (size_t)T_TOK * 256 / 4, split = (size_t)T_PROMPT * 256 / 4;
#pragma unroll 4
    for (size_t i = (size_t)C.bid * NTHR + C.tid; i < n4; i += (size_t)C.nb * NTHR) {
        const f32x4 v = __builtin_nontemporal_load(i < split ? (const f32x4*)p0 + i : (const f32x4*)p1 + (i - split));
        u32x2 w; w.x = pack2bf(v[0], v[1]); w.y = pack2bf(v[2], v[3]); ((u32x2*)PB)[i] = w;
    }
}
__device__ __forceinline__ void phase_final_norm(float* out, const float* gain, const Ctx& C) {
    const int lane = C.lane, rstep = C.nb * 8;
    f32x4 g4[4], nx[4], ny[4];
#pragma unroll
    for (int j = 0; j < 4; ++j) g4[j] = *(const f32x4*)(gain + 4 * lane + 256 * j);
    { const int row = C.bid * 8 + C.wid; if (row < T_TOK) {
#pragma unroll
        for (int j = 0; j < 4; ++j) nx[j] = __builtin_nontemporal_load((const f32x4*)(out + (size_t)row * DM + 4 * lane + 256 * j)); }
      if (row + rstep < T_TOK) {
#pragma unroll
        for (int j = 0; j < 4; ++j) ny[j] = __builtin_nontemporal_load((const f32x4*)(out + (size_t)(row + rstep) * DM + 4 * lane + 256 * j)); } }
    for (int row = C.bid * 8 + C.wid; row < T_TOK; row += rstep) {
        float* xr = out + (size_t)row * DM;
        f32x4 v[4]; float ss = 0.f;
#pragma unroll
        for (int j = 0; j < 4; ++j) { v[j] = nx[j]; nx[j] = ny[j]; }
        if (row + 2 * rstep < T_TOK) {
#pragma unroll
            for (int j = 0; j < 4; ++j) ny[j] = __builtin_nontemporal_load((const f32x4*)(out + (size_t)(row + 2 * rstep) * DM + 4 * lane + 256 * j)); }
#pragma unroll
        for (int j = 0; j < 4; ++j) ss += v[j][0] * v[j][0] + v[j][1] * v[j][1] + v[j][2] * v[j][2] + v[j][3] * v[j][3];
        ss = wave_sum(ss);
        const float rstd = rsqrtf(ss * (1.0f / 1024.0f) + EPSF);
#pragma unroll
        for (int j = 0; j < 4; ++j) __builtin_nontemporal_store(v[j] * rstd * g4[j], (f32x4*)(xr + 4 * lane + 256 * j));
    }
}

typedef float f32x2 __attribute__((ext_vector_type(2)));
__device__ __forceinline__ f32x2 mk2(float a, float b) { f32x2 r; r.x = a; r.y = b; return r; }
__device__ __forceinline__ int padi(int i) { return i + ((i >> 6) << 2); }
__device__ __forceinline__ f32x2 cmul(f32x2 a, f32x2 b) { return mk2(a.x * b.x - a.y * b.y, a.x * b.y + a.y * b.x); }
__device__ __forceinline__ f32x2 cmulc(f32x2 a, f32x2 b) { return mk2(a.x * b.x + a.y * b.y, a.y * b.x - a.x * b.y); }
template <bool CONJ> __device__ __forceinline__ f32x2 mul_w16(f32x2 a, int j) {
    const float cs[8] = {1.0f, 0.92387953251128674f, 0.70710678118654752f, 0.38268343236508977f, 0.0f, -0.38268343236508977f, -0.70710678118654752f, -0.92387953251128674f};
    const float sn[8] = {0.0f, 0.38268343236508977f, 0.70710678118654752f, 0.92387953251128674f, 1.0f, 0.92387953251128674f, 0.70710678118654752f, 0.38268343236508977f};
    if (j == 0) return a;
    if (j == 4) return CONJ ? mk2(-a.y, a.x) : mk2(a.y, -a.x);
    const f32x2 w = mk2(cs[j], sn[j]);
    return CONJ ? cmul(a, w) : cmulc(a, w);
}
constexpr int bitrev_c(int k, int R) { int r = 0; for (int b = 0; b < R; ++b) if (k & (1 << b)) r |= 1 << (R - 1 - b); return r; }
template <int LOGN, int S_HI, int R, bool INV, bool HALF = false>
__device__ __forceinline__ void fft_pass(LAS f32x2* X, const f32x2* __restrict__ TW, int tid) {
    constexpr int N = 1 << LOGN, S_LO = S_HI - R + 1, NG = N >> R, NK = 1 << R;
#pragma unroll 1
    for (int g = tid; g < NG; g += NTHR) {
        const int low = g & ((1 << S_LO) - 1), high = g >> S_LO, base = (high << (S_HI + 1)) + low;
        f32x2 pw[NK];
        if (S_LO > 0) { float f_ = (float)low * __uint_as_float((unsigned)(126 - S_HI) << 23); asm volatile("" : "+v"(f_)); pw[1] = mk2(__builtin_amdgcn_cosf(f_), -__builtin_amdgcn_sinf(f_));
#pragma unroll
            for (int e = 2; e < NK; ++e) pw[e] = (e & 1) ? cmul(pw[e - 1], pw[1]) : cmul(pw[e >> 1], pw[e >> 1]); }
        f32x2 x[NK];
#pragma unroll
        for (int k = 0; k < NK; ++k) x[k] = (HALF && !INV && k >= NK / 2) ? mk2(0.f, 0.f) : X[padi(base + (k << S_LO))];
        if (!INV) {
#pragma unroll
            for (int st = 0; st < R; ++st) { const int hk = 1 << (R - 1 - st);
#pragma unroll
                for (int k0 = 0; k0 < NK; ++k0) { if (k0 & hk) continue; const int k1 = k0 + hk;
                    const f32x2 a = x[k0], b = x[k1];
                    x[k0] = mk2(a.x + b.x, a.y + b.y);
                    x[k1] = mul_w16<false>(mk2(a.x - b.x, a.y - b.y), (k0 & (hk - 1)) * (8 / hk)); } }
            if (S_LO > 0) {
#pragma unroll
                for (int k = 1; k < NK; ++k) x[k] = cmul(x[k], pw[bitrev_c(k, R)]); }
        } else {
            if (S_LO > 0) {
#pragma unroll
                for (int k = 1; k < NK; ++k) x[k] = cmulc(x[k], pw[bitrev_c(k, R)]); }
#pragma unroll
            for (int st = R - 1; st >= 0; --st) { const int hk = 1 << (R - 1 - st);
#pragma unroll
                for (int k0 = 0; k0 < NK; ++k0) { if (k0 & hk) continue; const int k1 = k0 + hk;
                    const f32x2 a = x[k0], b = mul_w16<true>(x[k1], (k0 & (hk - 1)) * (8 / hk));
                    x[k0] = mk2(a.x + b.x, a.y + b.y);
                    x[k1] = mk2(a.x - b.x, a.y - b.y); } }
        }
#pragma unroll
        for (int k = 0; k < NK; ++k) if (!(HALF && INV && k >= NK / 2)) X[padi(base + (k << S_LO))] = x[k];
    }
    __syncthreads();
}
__device__ __forceinline__ void fft_mid_mul14(LAS f32x2* X, const f32x2* __restrict__ K, int tid) {
    f32x4 kk[8][2];
#pragma unroll
    for (int q = 0; q < 8; ++q) { const int g = tid + NTHR * q; kk[q][0] = *(const f32x4*)(K + 4 * g); kk[q][1] = *(const f32x4*)(K + 4 * g + 2); }
#pragma unroll
    for (int q = 0; q < 8; ++q) { const int g = tid + NTHR * q; LAS f32x2* xp = X + padi(4 * g);
        const f32x4 v01 = *(const LAS f32x4*)xp, v23 = *(const LAS f32x4*)(xp + 2);
        f32x2 x0 = mk2(v01[0], v01[1]), x1 = mk2(v01[2], v01[3]), x2 = mk2(v23[0], v23[1]), x3 = mk2(v23[2], v23[3]);
        { const f32x2 a = x0, b = x2; x0 = mk2(a.x + b.x, a.y + b.y); x2 = mk2(a.x - b.x, a.y - b.y); }
        { const f32x2 a = x1, b = x3; x1 = mk2(a.x + b.x, a.y + b.y); const f32x2 d = mk2(a.x - b.x, a.y - b.y); x3 = mk2(d.y, -d.x); }
        { const f32x2 a = x0, b = x1; x0 = mk2(a.x + b.x, a.y + b.y); x1 = mk2(a.x - b.x, a.y - b.y); }
        { const f32x2 a = x2, b = x3; x2 = mk2(a.x + b.x, a.y + b.y); x3 = mk2(a.x - b.x, a.y - b.y); }
        x0 = cmul(x0, mk2(kk[q][0][0], kk[q][0][1])); x1 = cmul(x1, mk2(kk[q][0][2], kk[q][0][3])); x2 = cmul(x2, mk2(kk[q][1][0], kk[q][1][1])); x3 = cmul(x3, mk2(kk[q][1][2], kk[q][1][3]));
        { const f32x2 a = x0, b = x1; x0 = mk2(a.x + b.x, a.y + b.y); x1 = mk2(a.x - b.x, a.y - b.y); }
        { const f32x2 a = x2, b = x3; x2 = mk2(a.x + b.x, a.y + b.y); x3 = mk2(a.x - b.x, a.y - b.y); }
        { const f32x2 a = x0, b = x2; x0 = mk2(a.x + b.x, a.y + b.y); x2 = mk2(a.x - b.x, a.y - b.y); }
        { const f32x2 a = x1, b = mk2(-x3.y, x3.x); x1 = mk2(a.x + b.x, a.y + b.y); x3 = mk2(a.x - b.x, a.y - b.y); }
        *(LAS f32x4*)xp = (f32x4){x0.x, x0.y, x1.x, x1.y}; *(LAS f32x4*)(xp + 2) = (f32x4){x2.x, x2.y, x3.x, x3.y}; }
    __syncthreads();
}
__device__ __forceinline__ void fft_fwd14_head(LAS f32x2* X, const f32x2* __restrict__ TW, int tid) {
    fft_pass<14, 13, 4, false, true>(X, TW, tid); fft_pass<14, 9, 4, false>(X, TW, tid); fft_pass<14, 5, 4, false>(X, TW, tid);
}
__device__ __forceinline__ void fft_inv14_tail(LAS f32x2* X, const f32x2* __restrict__ TW, int tid) {
    fft_pass<14, 5, 4, true>(X, TW, tid); fft_pass<14, 9, 4, true>(X, TW, tid); fft_pass<14, 13, 4, true, true>(X, TW, tid);
}
template <int LOGN>
__device__ __forceinline__ void fft_fwd(LAS f32x2* X, const f32x2* __restrict__ TW, int tid) {
    if (LOGN == 14) fft_pass<LOGN, 13, 4, false>(X, TW, tid); else fft_pass<LOGN, 12, 3, false>(X, TW, tid);
    fft_pass<LOGN, 9, 4, false>(X, TW, tid); fft_pass<LOGN, 5, 4, false>(X, TW, tid); fft_pass<LOGN, 1, 2, false>(X, TW, tid);
}
template <int LOGN>
__device__ __forceinline__ void fft_inv(LAS f32x2* X, const f32x2* __restrict__ TW, int tid) {
    fft_pass<LOGN, 1, 2, true>(X, TW, tid); fft_pass<LOGN, 5, 4, true>(X, TW, tid); fft_pass<LOGN, 9, 4, true>(X, TW, tid);
    if (LOGN == 14) fft_pass<LOGN, 13, 4, true>(X, TW, tid); else fft_pass<LOGN, 12, 3, true>(X, TW, tid);
}

__device__ __forceinline__ void phase_kspec(const Ctx& C, int l) {
    LAS f32x2* X = (LAS f32x2*)C.lds;
    LAS float* w3s = (LAS float*)(C.lds + 139264);
    const f32x2* TW = (const f32x2*)(C.ws + OFF_TW);
    const float* H2 = (const float*)(C.ws + OFF_H2) + (size_t)l * 8192 * 64;
    f32x2* KS = (f32x2*)(C.ws + OFF_KS);
    const float* w3 = C.in(15) + (size_t)l * 64 * 1024;
    const float* dec = C.in(16) + l * 1024;
    for (int task = C.bid; task < 512; task += C.nb) {
        const int o = task >> 8, ch = task & 255;
        if (C.tid < 128) { const int dir = C.tid >> 6, i = C.tid & 63; w3s[C.tid] = w3[i * 1024 + o * 512 + dir * 256 + ch]; }
        const float dfw = dec[o * 512 + ch], dbw = dec[o * 512 + 256 + ch];
        __syncthreads();
        for (int s = C.tid; s < 8192; s += NTHR) {
            const f32x4* h = (const f32x4*)(H2 + (size_t)s * 64);
            float af = 0.f, ab = 0.f;
            f32x4 hh[16];
#pragma unroll
            for (int i4 = 0; i4 < 16; ++i4) hh[i4] = h[i4];
#pragma unroll
            for (int i4 = 0; i4 < 16; ++i4) { const f32x4 hv = hh[i4];
                af += hv[0] * w3s[4 * i4] + hv[1] * w3s[4 * i4 + 1] + hv[2] * w3s[4 * i4 + 2] + hv[3] * w3s[4 * i4 + 3];
                ab += hv[0] * w3s[64 + 4 * i4] + hv[1] * w3s[64 + 4 * i4 + 1] + hv[2] * w3s[64 + 4 * i4 + 2] + hv[3] * w3s[64 + 4 * i4 + 3]; }
            const float t = (float)s / 8191.0f;
            af *= expf(-t * dfw); ab *= expf(-t * dbw);
            X[padi(s)] = mk2(af, 0.f);
            if (s >= 1) X[padi(16384 - s)] = mk2(ab, 0.f);
        }
        if (C.tid == 0) { float zz = 0.f; asm volatile("" : "+v"(zz)); X[padi(8192)] = mk2(zz, zz); }
        __syncthreads();
        fft_fwd<14>(X, TW, C.tid);
        f32x2* dst = KS + (size_t)(o * 256 + ch) * 16384;
        for (int i = C.tid; i < 16384; i += NTHR) dst[i] = X[padi(i)];
        __syncthreads();
    }
}

__device__ __forceinline__ void unpack8(const u32x4 w, float (&u)[10]) {
    u[1] = __uint_as_float(w.x << 16); u[2] = __uint_as_float(w.x & 0xffff0000u); u[3] = __uint_as_float(w.y << 16); u[4] = __uint_as_float(w.y & 0xffff0000u);
    u[5] = __uint_as_float(w.z << 16); u[6] = __uint_as_float(w.z & 0xffff0000u); u[7] = __uint_as_float(w.w << 16); u[8] = __uint_as_float(w.w & 0xffff0000u);
}
struct Raw8 { u32x4 w; bf16_t pm, pn; };
__device__ __forceinline__ Raw8 load_raw8(const bf16_t* row, int i8) { Raw8 r; r.w = *(const u32x4*)(row + i8); r.pm = row[i8 > 0 ? i8 - 1 : 0]; r.pn = row[i8 + 8 < SEQL ? i8 + 8 : 0]; return r; }
__device__ __forceinline__ void sconv8r(const Raw8& r, int i8, float w0, float w1, float w2, float bias, float (&o)[8]) {
    float u[10];
    unpack8(r.w, u);
    u[0] = i8 > 0 ? bf2f(r.pm) : 0.f;
    u[9] = i8 + 8 < SEQL ? bf2f(r.pn) : 0.f;
#pragma unroll
    for (int e = 0; e < 8; ++e) o[e] = u[e] * w0 + u[e + 1] * w1 + u[e + 2] * w2 + bias;
}
__device__ __forceinline__ void phase_hyena(const Ctx& C, int l) {
    LAS f32x2* X = (LAS f32x2*)C.lds;
    const f32x2* TW = (const f32x2*)(C.ws + OFF_TW);
    const f32x2* KS = (const f32x2*)(C.ws + OFF_KS);
    bf16_t* zB = (bf16_t*)(C.ws + OFF_ZB);
    const float* cw = C.in(8) + l * 3 * 768; const float* cb = C.in(9) + l * 768; const float* skip = C.in(17) + l * 512;
    for (int task = C.bid; task < 5 * 256; task += C.nb) {
        const int pr = task >> 8, c = task & 255;
        const size_t t0 = (size_t)(2 * pr) * SEQL, t1 = t0 + SEQL;
        bf16_t* rv = zB + (size_t)(512 + c) * T_TOK; const bf16_t* rx1 = zB + (size_t)(768 + c) * T_TOK; const bf16_t* rx2 = zB + (size_t)(1024 + c) * T_TOK;
        const f32x2* K0 = KS + (size_t)c * 16384; const f32x2* K1 = KS + (size_t)(256 + c) * 16384;
        f32x4 keep[2][4];
        Raw8 rx[2][2];
        { const float v0 = cw[c], v1 = cw[768 + c], v2 = cw[1536 + c], vb = cb[c];
          Raw8 rw[2][2];
#pragma unroll
          for (int q = 0; q < 2; ++q) { const int i8 = (C.tid + NTHR * q) * 8; rw[q][0] = load_raw8(rv + t0, i8); rw[q][1] = load_raw8(rv + t1, i8); }
#pragma unroll
          for (int q = 0; q < 2; ++q) { const int i8 = (C.tid + NTHR * q) * 8; float va[8], vc[8];
              sconv8r(rw[q][0], i8, v0, v1, v2, vb, va); sconv8r(rw[q][1], i8, v0, v1, v2, vb, vc);
              const int p0 = padi(i8), p1 = padi(i8 + 8192);
#pragma unroll
              for (int e = 0; e < 8; e += 2) { const f32x4 w = (f32x4){va[e], vc[e], va[e + 1], vc[e + 1]};
                  keep[q][e >> 1] = w; *(LAS f32x4*)(X + p0 + e) = w; } } }
        __syncthreads();
        fft_fwd14_head(X, TW, C.tid); fft_mid_mul14(X, K0, C.tid); fft_inv14_tail(X, TW, C.tid);
        { const float a0 = cw[256 + c], a1 = cw[768 + 256 + c], a2 = cw[1536 + 256 + c], abi = cb[256 + c], sk0 = skip[c];
#pragma unroll
          for (int q = 0; q < 2; ++q) { const int i8 = (C.tid + NTHR * q) * 8; rx[q][0] = load_raw8(rx1 + t0, i8); rx[q][1] = load_raw8(rx1 + t1, i8); }
#pragma unroll
          for (int q = 0; q < 2; ++q) { const int i8 = (C.tid + NTHR * q) * 8; float xa[8], xb[8];
              sconv8r(rx[q][0], i8, a0, a1, a2, abi, xa); sconv8r(rx[q][1], i8, a0, a1, a2, abi, xb);
              const int p0 = padi(i8), p1 = padi(i8 + 8192);
#pragma unroll
              for (int e = 0; e < 8; e += 2) { const f32x4 cv = *(const LAS f32x4*)(X + p0 + e), v = keep[q][e >> 1];
                  const f32x4 y = (f32x4){xa[e] * (cv[0] * (1.0f / 16384.0f) + v[0] * sk0), xb[e] * (cv[1] * (1.0f / 16384.0f) + v[1] * sk0),
                                          xa[e + 1] * (cv[2] * (1.0f / 16384.0f) + v[2] * sk0), xb[e + 1] * (cv[3] * (1.0f / 16384.0f) + v[3] * sk0)};
                  keep[q][e >> 1] = y; *(LAS f32x4*)(X + p0 + e) = y; } } }
        __syncthreads();
        fft_fwd14_head(X, TW, C.tid); fft_mid_mul14(X, K1, C.tid); fft_inv14_tail(X, TW, C.tid);
        { const float b0 = cw[512 + c], b1 = cw[768 + 512 + c], b2 = cw[1536 + 512 + c], bbi = cb[512 + c], sk1 = skip[256 + c];
#pragma unroll
          for (int q = 0; q < 2; ++q) { const int i8 = (C.tid + NTHR * q) * 8; rx[q][0] = load_raw8(rx2 + t0, i8); rx[q][1] = load_raw8(rx2 + t1, i8); }
#pragma unroll
          for (int q = 0; q < 2; ++q) { const int i8 = (C.tid + NTHR * q) * 8; float xa[8], xb[8], ya[8], yb[8];
              sconv8r(rx[q][0], i8, b0, b1, b2, bbi, xa); sconv8r(rx[q][1], i8, b0, b1, b2, bbi, xb);
              const int p0 = padi(i8);
#pragma unroll
              for (int e = 0; e < 8; e += 2) { const f32x4 cv = *(const LAS f32x4*)(X + p0 + e), y1 = keep[q][e >> 1];
                  ya[e] = xa[e] * (cv[0] * (1.0f / 16384.0f) + y1[0] * sk1); yb[e] = xb[e] * (cv[1] * (1.0f / 16384.0f) + y1[1] * sk1);
                  ya[e + 1] = xa[e + 1] * (cv[2] * (1.0f / 16384.0f) + y1[2] * sk1); yb[e + 1] = xb[e + 1] * (cv[3] * (1.0f / 16384.0f) + y1[3] * sk1); }
              u32x4 wa, wb; wa.x = pack2bf(ya[0], ya[1]); wa.y = pack2bf(ya[2], ya[3]); wa.z = pack2bf(ya[4], ya[5]); wa.w = pack2bf(ya[6], ya[7]);
              wb.x = pack2bf(yb[0], yb[1]); wb.y = pack2bf(yb[2], yb[3]); wb.z = pack2bf(yb[4], yb[5]); wb.w = pack2bf(yb[6], yb[7]);
              *(u32x4*)(rv + t0 + i8) = wa; *(u32x4*)(rv + t1 + i8) = wb; } }
        __syncthreads();
    }
}

__device__ __forceinline__ void phase_fnet(const Ctx& C) {
    LAS f32x2* X = (LAS f32x2*)C.lds;
    const f32x2* TW = (const f32x2*)(C.ws + OFF_TW);
    bf16_t* zB = (bf16_t*)(C.ws + OFF_ZB);
    for (int task = C.bid; task < NSEQ * 256; task += C.nb) {
        const int b = task >> 8, r = task & 255;
        bf16_t* rp = zB + (size_t)r * T_TOK + (size_t)b * SEQL; const bf16_t* rq = zB + (size_t)(256 + r) * T_TOK + (size_t)b * SEQL;
#pragma unroll 2
        for (int q = 0; q < 2; ++q) { const int i8 = (C.tid + NTHR * q) * 8; float up[10], uq[10];
            unpack8(*(const u32x4*)(rp + i8), up); unpack8(*(const u32x4*)(rq + i8), uq);
            const int p0 = padi(i8);
#pragma unroll
            for (int e = 0; e < 8; e += 2) *(LAS f32x4*)(X + p0 + e) = (f32x4){up[e + 1], uq[e + 1], up[e + 2], uq[e + 2]}; }
        __syncthreads();
        fft_fwd<13>(X, TW, C.tid);
#pragma unroll 1
        for (int q = 0; q < 2; ++q) { const int k8 = (C.tid + NTHR * q) * 8; float y[8];
#pragma unroll
            for (int e = 0; e < 8; ++e) y[e] = X[padi((int)(__brev((unsigned)(k8 + e)) >> 19))].x;
            u32x4 w; w.x = pack2bf(y[0], y[1]); w.y = pack2bf(y[2], y[3]); w.z = pack2bf(y[4], y[5]); w.w = pack2bf(y[6], y[7]);
            *(u32x4*)(rp + k8) = w; }
        __syncthreads();
    }
}

__device__ __forceinline__ void phase_headnorm_cm(const Ctx& C) {
    LAS float* S = (LAS float*)C.lds;
    const bf16_t* zB = (const bf16_t*)(C.ws + OFF_ZB);
    bf16_t* XB = (bf16_t*)(C.ws + OFF_XB);
    for (int task = C.bid; task < T_TOK / 64; task += C.nb) {
        const size_t tok0 = (size_t)task * 64;
#pragma unroll 8
        for (int e = C.tid; e < 512 * 8; e += NTHR) { const int ch = e >> 3, part = e & 7; const int row = ch < 256 ? ch : ch + 256;
            const u32x4 w = *(const u32x4*)(zB + (size_t)row * T_TOK + tok0 + part * 8);
            LAS float* d = S + ch * 68 + part * 8;
            *(LAS f32x4*)d = (f32x4){__uint_as_float(w.x << 16), __uint_as_float(w.x & 0xffff0000u), __uint_as_float(w.y << 16), __uint_as_float(w.y & 0xffff0000u)};
            *(LAS f32x4*)(d + 4) = (f32x4){__uint_as_float(w.z << 16), __uint_as_float(w.z & 0xffff0000u), __uint_as_float(w.w << 16), __uint_as_float(w.w & 0xffff0000u)}; }
        __syncthreads();
        const int tok = C.tid & 63, head = C.tid >> 6;
        float ss = 0.f;
        for (int c = 0; c < 64; ++c) { const float v = S[(head * 64 + c) * 68 + tok]; ss += v * v; }
        const float rstd = rsqrtf(ss * (1.0f / 64.0f) + EPSF);
        bf16_t* dst = XB + (tok0 + tok) * DM + 256 + head * 64;
#pragma unroll 2
        for (int c8 = 0; c8 < 8; ++c8) { u32x4 w; const LAS float* sp = S + (head * 64 + c8 * 8) * 68 + tok;
            w.x = pack2bf(sp[0] * rstd, sp[68] * rstd); w.y = pack2bf(sp[136] * rstd, sp[204] * rstd); w.z = pack2bf(sp[272] * rstd, sp[340] * rstd); w.w = pack2bf(sp[408] * rstd, sp[476] * rstd);
            *(u32x4*)(dst + c8 * 8) = w; }
        __syncthreads();
    }
}

typedef short bf16x8_n __attribute__((ext_vector_type(8)));
__device__ __forceinline__ void phase_na(const Ctx& C, int l) {
    LAS unsigned char* Kb = C.lds;
    LAS unsigned char* VT = C.lds + 65536;
    LAS unsigned char* Qb = C.lds + 131072;
    LAS unsigned char* Pw = Qb + 9216;
    LAS float* Bs = (LAS float*)(Pw + 4 * 2304);
    const bf16_t* zA = (const bf16_t*)(C.ws + OFF_Z);
    bf16_t* XB = (bf16_t*)(C.ws + OFF_XB);
    const float* rpb = C.in(6) + l * 4 * 15 * 31;
    const int lane = C.lane, w = C.wid, jl = lane & 15, quad = lane >> 4;
    const int scol = C.tid >> 3, spart = C.tid & 7;
    for (int task = C.bid; task < NSEQ * 4 * 32; task += C.nb) {
        const int h = task & 3, strip = (task >> 2) & 31, b = task >> 7;
        const bf16_t* zrow = zA + (size_t)b * SEQL * ZA_LD + 64 * h + spart * 8;
        { const int r = 4 * strip, kr0 = min(max(r - 4, 0), 120);
          u32x4 kreg[8], vreg[8];
#pragma unroll
          for (int i = 0; i < 8; ++i) { const bf16_t* src = zrow + (size_t)((kr0 + i) * 64 + scol) * ZA_LD; kreg[i] = *(const u32x4*)(src + 256); vreg[i] = *(const u32x4*)(src + 512); }
          const u32x4 qreg = *(const u32x4*)(zrow + (size_t)(r * 64 + scol) * ZA_LD);
          __syncthreads();
          for (int e = C.tid; e < 15 * 31; e += NTHR) Bs[e] = rpb[h * 465 + e];
          for (int e = C.tid; e < 4 * 2304 / 16; e += NTHR) *(LAS u32x4*)(Pw + e * 16) = (u32x4){0u, 0u, 0u, 0u};
#pragma unroll
          for (int i = 0; i < 8; ++i) { const int slot = (kr0 + i) & 7;
              *(LAS u32x4*)(Kb + slot * 8192 + scol * 128 + ((spart ^ (scol & 7)) * 16)) = kreg[i];
              const unsigned va[4] = {vreg[i].x, vreg[i].y, vreg[i].z, vreg[i].w};
#pragma unroll
              for (int t = 0; t < 8; ++t) { const unsigned hv = (t & 1) ? (va[t >> 1] >> 16) : (va[t >> 1] & 0xffffu);
                  *(LAS bf16_t*)(VT + slot * 8192 + (spart * 8 + t) * 128 + (((scol >> 3) ^ t ^ spart) * 16) + (scol & 7) * 2) = (bf16_t)hv; } }
          *(LAS u32x4*)(Qb + scol * 144 + spart * 16) = qreg; }
#pragma unroll 1
        for (int rr = 0; rr < 4; ++rr) {
            const int r = 4 * strip + rr, kr0 = min(max(r - 4, 0), 120);
            const int krn = min(max(r + 1 - 4, 0), 120); const bool more = rr < 3, newrow = more && (krn != kr0);
            u32x4 nk = (u32x4){0u, 0u, 0u, 0u}, nv = nk, nq = nk;
            if (more) nq = *(const u32x4*)(zrow + (size_t)((r + 1) * 64 + scol) * ZA_LD);
            if (newrow) { const bf16_t* src = zrow + (size_t)((krn + 7) * 64 + scol) * ZA_LD; nk = *(const u32x4*)(src + 256); nv = *(const u32x4*)(src + 512); }
            __syncthreads();
            if (w < 4) {
                const int jt = w, c = 16 * jt + jl, cs = min(max(c - 8, 0), 48);
                const int ct_lo = jt < 2 ? 0 : jt - 1, nct = (jt == 0 || jt == 3) ? 2 : 3;
                bf16x8_n qf[2];
#pragma unroll
                for (int kk = 0; kk < 2; ++kk) qf[kk] = *(const LAS bf16x8_n*)(Qb + c * 144 + kk * 64 + quad * 16);
                f32x4 S[8][3]; float mx = -3.0e38f;
#pragma unroll
                for (int krow = 0; krow < 8; ++krow) { const int slot = (kr0 + krow) & 7; const int brow = (kr0 + krow - r + 7) * 31 - c + 15;
#pragma unroll
                    for (int t = 0; t < 3; ++t) { S[krow][t] = (f32x4){-3.0e38f, -3.0e38f, -3.0e38f, -3.0e38f};
                        if (t < nct) { const int ct = ct_lo + t; f32x4 sa = (f32x4){0.f, 0.f, 0.f, 0.f};
#pragma unroll
                            for (int kk = 0; kk < 2; ++kk) { const bf16x8_n ak = *(const LAS bf16x8_n*)(Kb + slot * 8192 + (16 * ct + jl) * 128 + (((kk * 4 + quad) ^ (jl & 7)) * 16));
                                sa = __builtin_amdgcn_mfma_f32_16x16x32_bf16(ak, qf[kk], sa, 0, 0, 0); }
#pragma unroll
                            for (int i = 0; i < 4; ++i) { const int kc = 16 * ct + 4 * quad + i; const bool valid = (kc >= cs) && (kc < cs + 16);
                                const float bias = Bs[valid ? brow + kc : 0];
                                const float sc = valid ? sa[i] * 0.125f + bias : -3.0e38f; S[krow][t][i] = sc; mx = fmaxf(mx, sc); } } } }
                mx = fmaxf(mx, __shfl_xor(mx, 16)); mx = fmaxf(mx, __shfl_xor(mx, 32));
                float sum = 0.f;
#pragma unroll
                for (int krow = 0; krow < 8; ++krow)
#pragma unroll
                    for (int t = 0; t < 3; ++t)
#pragma unroll
                        for (int i = 0; i < 4; ++i) { const float p = __expf(S[krow][t][i] - mx); S[krow][t][i] = p; sum += p; }
                sum += __shfl_xor(sum, 16); sum += __shfl_xor(sum, 32);
                const float inv = __builtin_amdgcn_rcpf(sum);
                f32x4 oacc[4];
#pragma unroll
                for (int et = 0; et < 4; ++et) oacc[et] = (f32x4){0.f, 0.f, 0.f, 0.f};
                LAS unsigned char* pw = Pw + w * 2304 + jl * 144;
#pragma unroll
                for (int krow = 0; krow < 8; ++krow) { const int slot = (kr0 + krow) & 7;
#pragma unroll
                    for (int t = 0; t < 3; ++t) if (t < nct) { const f32x4 p = S[krow][t] * inv; u32x2 pk; pk.x = pack2bf(p[0], p[1]); pk.y = pack2bf(p[2], p[3]);
                        *(LAS u32x2*)(pw + (16 * (ct_lo + t) + 4 * quad) * 2) = pk; }
                    asm volatile("s_waitcnt lgkmcnt(0)" ::: "memory");
#pragma unroll
                    for (int step = 0; step < 2; ++step) if ((step == 0 && jt != 3) || (step == 1 && jt != 0)) {
                        const bf16x8_n bp = *(const LAS bf16x8_n*)(pw + step * 64 + quad * 16);
#pragma unroll
                        for (int et = 0; et < 4; ++et) { const bf16x8_n av = *(const LAS bf16x8_n*)(VT + slot * 8192 + (16 * et + jl) * 128 + (((step * 4 + quad) ^ (jl & 7) ^ ((2 * et + (jl >> 3)) & 7)) * 16));
                            oacc[et] = __builtin_amdgcn_mfma_f32_16x16x32_bf16(av, bp, oacc[et], 0, 0, 0); } }
                    asm volatile("s_waitcnt lgkmcnt(0)" ::: "memory"); }
                float ss = 0.f;
#pragma unroll
                for (int et = 0; et < 4; ++et) ss += oacc[et][0] * oacc[et][0] + oacc[et][1] * oacc[et][1] + oacc[et][2] * oacc[et][2] + oacc[et][3] * oacc[et][3];
                ss += __shfl_xor(ss, 16); ss += __shfl_xor(ss, 32);
                const float rstd = rsqrtf(ss * (1.0f / 64.0f) + EPSF);
                const size_t tokq = (size_t)b * SEQL + r * 64 + c;
#pragma unroll
                for (int et = 0; et < 4; ++et) { u32x2 ww; ww.x = pack2bf(oacc[et][0] * rstd, oacc[et][1] * rstd); ww.y = pack2bf(oacc[et][2] * rstd, oacc[et][3] * rstd);
                    *(u32x2*)(XB + tokq * DM + 64 * h + 16 * et + 4 * quad) = ww; }
            }
            __syncthreads();
            if (more) *(LAS u32x4*)(Qb + scol * 144 + spart * 16) = nq;
            if (newrow) { const int slot = (krn + 7) & 7;
                *(LAS u32x4*)(Kb + slot * 8192 + scol * 128 + ((spart ^ (scol & 7)) * 16)) = nk;
                const unsigned va[4] = {nv.x, nv.y, nv.z, nv.w};
#pragma unroll
                for (int t = 0; t < 8; ++t) { const unsigned hv = (t & 1) ? (va[t >> 1] >> 16) : (va[t >> 1] & 0xffffu);
                    *(LAS bf16_t*)(VT + slot * 8192 + (spart * 8 + t) * 128 + (((scol >> 3) ^ t ^ spart) * 16) + (scol & 7) * 2) = (bf16_t)hv; } }
        }
    }
    __syncthreads();
}

typedef short bf16x8_t __attribute__((ext_vector_type(8)));
__device__ __forceinline__ float wave_incl_sum(float v, int lane) {
#pragma unroll
    for (int o = 1; o < 64; o <<= 1) { const float t = __shfl_up(v, o); if (lane >= o) v += t; }
    return v;
}
__device__ __forceinline__ float wave_incl_max_up(float v, int lane) {
#pragma unroll
    for (int o = 1; o < 64; o <<= 1) { const float t = __shfl_up(v, o); if (lane >= o) v = fmaxf(v, t); }
    return v;
}
__device__ __forceinline__ float wave_incl_max_down(float v, int lane) {
#pragma unroll
    for (int o = 1; o < 64; o <<= 1) { const float t = __shfl_down(v, o); if (lane + o < 64) v = fmaxf(v, t); }
    return v;
}
__device__ __forceinline__ void mlstm_gates(const Ctx& C, int l, int b, int h, int c, LAS float* lff, LAS float* lfb, LAS float* lif, LAS float* lib) {
    if (C.tid < 128) {
        const float* gates = (const float*)(C.ws + OFF_GATES) + ((size_t)b * SEQL + c * 128 + C.tid) * 16;
        const float* gb = C.in(18) + l * 16;
        lif[C.tid] = gates[h] + gb[h];
        lff[C.tid] = logsigmoidf_(gates[4 + h] + gb[4 + h]);
        lib[C.tid] = gates[8 + h] + gb[8 + h];
        lfb[C.tid] = logsigmoidf_(gates[12 + h] + gb[12 + h]);
    }
}
__device__ __forceinline__ void phase_mlstm_local(const Ctx& C, int l) {
    typedef short bf16x8_l __attribute__((ext_vector_type(8)));
    constexpr int VS = 136;
    LAS bf16_t* VT = (LAS bf16_t*)C.lds;
    LAS bf16_t* KfT = VT + 80 * VS;
    LAS bf16_t* KbT = KfT + 64 * VS;
    LAS float* sm = (LAS float*)(KbT + 64 * VS);
    LAS float* lff = sm, *lfb = sm + 128, *lif = sm + 256, *lib = sm + 384, *wf = sm + 512, *wbk = sm + 640;
    const bf16_t* zA = (const bf16_t*)(C.ws + OFF_Z);
    float* STS = (float*)(C.ws + OFF_STS); float* STN = (float*)(C.ws + OFF_STN); float* STC = (float*)(C.ws + OFF_STC);
    const int lane = C.lane, w = C.wid, jl = lane & 15, quad = lane >> 4;
    for (int task = C.bid; task < NSEQ * 4 * 64; task += C.nb) {
        const int c = task & 63, h = (task >> 6) & 3, b = task >> 8;
        const size_t tok0 = (size_t)b * SEQL + c * 128;
        const size_t sF = (size_t)((0 * 10 + b) * 4 + h) * 64 + c, sB = (size_t)((1 * 10 + b) * 4 + h) * 64 + c;
        mlstm_gates(C, l, b, h, c, lff, lfb, lif, lib);
        for (int e = C.tid; e < 16 * VS; e += NTHR) VT[64 * VS + e] = (e < 128) ? (bf16_t)0x3f80 : (bf16_t)0;
        __syncthreads();
        if (w == 0) { const float a0 = lff[2 * lane], a1 = lff[2 * lane + 1]; const float inc = wave_incl_sum(a0 + a1, lane); const float g = __shfl(inc, 63);
            const float x0 = g - (inc - a1) + lif[2 * lane], x1 = g - inc + lif[2 * lane + 1];
            const float m = wave_max(fmaxf(x0, x1));
            wf[2 * lane] = 0.125f * __expf(x0 - m); wf[2 * lane + 1] = 0.125f * __expf(x1 - m);
            if (lane == 0) { STC[sF * 4 + 0] = m; STC[sF * 4 + 1] = g; } }
        if (w == 1) { const float a0 = lfb[2 * lane], a1 = lfb[2 * lane + 1]; const float inc = wave_incl_sum(a0 + a1, lane); const float g = __shfl(inc, 63);
            const float b0 = g - (inc - a0 - a1), b1 = g - (inc - a1);
            const float x0 = g - b0 + lib[2 * lane], x1 = g - b1 + lib[2 * lane + 1];
            const float m = wave_max(fmaxf(x0, x1));
            wbk[2 * lane] = 0.125f * __expf(x0 - m); wbk[2 * lane + 1] = 0.125f * __expf(x1 - m);
            if (lane == 0) { STC[sB * 4 + 0] = m; STC[sB * 4 + 1] = g; } }
        __syncthreads();
#pragma unroll 2
        for (int e = C.tid; e < 1024; e += NTHR) { const int s = e & 127, part = e >> 7;
            const bf16_t* src = zA + (tok0 + s) * ZA_LD + 64 * h + part * 8;
            const u32x4 kv = *(const u32x4*)(src + 1024), vv = *(const u32x4*)(src + 1280);
            const unsigned ka[4] = {kv.x, kv.y, kv.z, kv.w}, va[4] = {vv.x, vv.y, vv.z, vv.w};
            const float wfs = wf[s], wbs = wbk[s];
#pragma unroll
            for (int i = 0; i < 4; ++i) { const int d0 = part * 8 + 2 * i; const float k0 = __uint_as_float(ka[i] << 16), k1 = __uint_as_float(ka[i] & 0xffff0000u);
                KfT[d0 * VS + s] = f2bf(k0 * wfs); KfT[(d0 + 1) * VS + s] = f2bf(k1 * wfs); KbT[d0 * VS + s] = f2bf(k0 * wbs); KbT[(d0 + 1) * VS + s] = f2bf(k1 * wbs);
                VT[d0 * VS + s] = (bf16_t)(va[i] & 0xffffu); VT[(d0 + 1) * VS + s] = (bf16_t)(va[i] >> 16); } }
        __syncthreads();
        { const int dir = w >> 2, dt = w & 3; const LAS bf16_t* KT = dir ? KbT : KfT; const size_t sD = dir ? sB : sF;
          bf16x8_l kf[4];
#pragma unroll
          for (int kk = 0; kk < 4; ++kk) kf[kk] = *(const LAS bf16x8_l*)(KT + (16 * dt + jl) * VS + kk * 32 + quad * 8);
          const int d = 16 * dt + jl;
#pragma unroll
          for (int et = 0; et < 5; ++et) { f32x4 acc = (f32x4){0.f, 0.f, 0.f, 0.f};
#pragma unroll
              for (int kk = 0; kk < 4; ++kk) { const bf16x8_l av = *(const LAS bf16x8_l*)(VT + (16 * et + jl) * VS + kk * 32 + quad * 8); acc = __builtin_amdgcn_mfma_f32_16x16x32_bf16(av, kf[kk], acc, 0, 0, 0); }
              if (et < 4) *(f32x4*)(STS + sD * 4096 + d * 64 + 16 * et + 4 * quad) = acc;
              else if (quad == 0) STN[sD * 64 + d] = acc[0]; } }
        __syncthreads();
    }
}
__device__ __forceinline__ void phase_mlstm_scan(const Ctx& C) {
    float* STS = (float*)(C.ws + OFF_STS); float* STN = (float*)(C.ws + OFF_STN); float* STC = (float*)(C.ws + OFF_STC);
    for (int idx = C.bid * NTHR + C.tid; idx < 80 * 4160; idx += C.nb * NTHR) {
        const int scan = idx / 4160, e = idx - scan * 4160, dir = scan / 40;
        float* base; int stride;
        if (e < 4096) { base = STS + (size_t)scan * 64 * 4096 + e; stride = 4096; } else { base = STN + (size_t)scan * 64 * 64 + (e - 4096); stride = 64; }
        float* sc = STC + (size_t)scan * 64 * 4;
        float st = 0.f, m = 0.f;
#pragma unroll 1
        for (int s0 = 0; s0 < 64; s0 += 8) {
            float loc[8], ml[8], gg[8];
#pragma unroll
            for (int u = 0; u < 8; ++u) { const int c = dir ? 63 - (s0 + u) : s0 + u; loc[u] = base[(size_t)c * stride]; ml[u] = sc[c * 4 + 0]; gg[u] = sc[c * 4 + 1]; }
#pragma unroll
            for (int u = 0; u < 8; ++u) { const int c = dir ? 63 - (s0 + u) : s0 + u;
                base[(size_t)c * stride] = st; if (e == 0) sc[c * 4 + 2] = m;
                const float mn = fmaxf(gg[u] + m, ml[u]); const float dold = __expf(gg[u] + m - mn), dnew = __expf(ml[u] - mn);
                st = dold * st + dnew * loc[u]; m = mn; }
        }
    }
}
__device__ __forceinline__ void phase_mlstm_out(const Ctx& C, int l) {
    constexpr int QS = 72, VS = 136;
    LAS bf16_t* Qb = (LAS bf16_t*)C.lds;
    LAS bf16_t* Kb = Qb + 128 * QS;
    LAS bf16_t* VT = Kb + 128 * QS;
    LAS bf16_t* SfT = VT + 64 * VS;
    LAS bf16_t* SbT = SfT + 64 * QS;
    LAS bf16_t* Pb = SbT + 64 * QS;
    LAS float* sm = (LAS float*)(Pb + 128 * VS);
    LAS float* lff = sm, *lfb = sm + 128, *lif = sm + 256, *lib = sm + 384, *bfw = sm + 512, *bbw = sm + 640, *cF = sm + 768, *cB = sm + 896,
             *mtF = sm + 1024, *mtB = sm + 1152, *wiF = sm + 1280, *wiB = sm + 1408, *qnF = sm + 1536, *qnB = sm + 1664, *n0f = sm + 1792, *n0b = sm + 1856;
    const bf16_t* zA = (const bf16_t*)(C.ws + OFF_Z);
    bf16_t* XB = (bf16_t*)(C.ws + OFF_XB);
    const float* STS = (const float*)(C.ws + OFF_STS); const float* STN = (const float*)(C.ws + OFF_STN); const float* STC = (const float*)(C.ws + OFF_STC);
    const int lane = C.lane, w = C.wid, jl = lane & 15, quad = lane >> 4;
    for (int task = C.bid; task < NSEQ * 4 * 64; task += C.nb) {
        const int c = task & 63, h = (task >> 6) & 3, b = task >> 8;
        const size_t tok0 = (size_t)b * SEQL + c * 128;
        const size_t sF = (size_t)((0 * 10 + b) * 4 + h) * 64 + c, sB = (size_t)((1 * 10 + b) * 4 + h) * 64 + c;
#pragma unroll 2
        for (int e = C.tid; e < 1024; e += NTHR) { const int s = e & 127, part = e >> 7;
            const bf16_t* src = zA + (tok0 + s) * ZA_LD + 64 * h + part * 8;
            const u32x4 qv = *(const u32x4*)(src + 768), kv = *(const u32x4*)(src + 1024), vv = *(const u32x4*)(src + 1280);
            *(LAS u32x4*)(Qb + s * QS + part * 8) = qv; *(LAS u32x4*)(Kb + s * QS + part * 8) = kv;
            const unsigned va[4] = {vv.x, vv.y, vv.z, vv.w};
#pragma unroll
            for (int i = 0; i < 4; ++i) { VT[(part * 8 + 2 * i) * VS + s] = (bf16_t)(va[i] & 0xffffu); VT[(part * 8 + 2 * i + 1) * VS + s] = (bf16_t)(va[i] >> 16); } }
#pragma unroll 2
        for (int e = C.tid; e < 1024; e += NTHR) { const int d = e & 63, e4 = (e >> 6) * 4;
            const f32x4 f = *(const f32x4*)(STS + sF * 4096 + d * 64 + e4), g = *(const f32x4*)(STS + sB * 4096 + d * 64 + e4);
#pragma unroll
            for (int i = 0; i < 4; ++i) { SfT[(e4 + i) * QS + d] = f2bf(f[i]); SbT[(e4 + i) * QS + d] = f2bf(g[i]); } }
        if (C.tid < 64) n0f[C.tid] = STN[sF * 64 + C.tid]; else if (C.tid < 128) n0b[C.tid - 64] = STN[sB * 64 + C.tid - 64];
        mlstm_gates(C, l, b, h, c, lff, lfb, lif, lib);
        const float m0f = STC[sF * 4 + 2], m0b = STC[sB * 4 + 2];
        __syncthreads();
        if (w == 0) { const float a0 = lff[2 * lane], a1 = lff[2 * lane + 1]; const float inc = wave_incl_sum(a0 + a1, lane);
            const float b0 = inc - a1, b1 = inc; bfw[2 * lane] = b0; bfw[2 * lane + 1] = b1;
            const float c0 = lif[2 * lane] - b0, c1 = lif[2 * lane + 1] - b1; cF[2 * lane] = c0; cF[2 * lane + 1] = c1;
            const float pm = wave_incl_max_up(fmaxf(c0, c1), lane); float pprev = __shfl_up(pm, 1); if (lane == 0) pprev = -3.0e38f;
            const float cm0 = fmaxf(pprev, c0), cm1 = pm;
            const float mf0 = b0 + fmaxf(m0f, cm0), mf1 = b1 + fmaxf(m0f, cm1);
            mtF[2 * lane] = mf0; mtF[2 * lane + 1] = mf1; wiF[2 * lane] = __expf(b0 + m0f - mf0); wiF[2 * lane + 1] = __expf(b1 + m0f - mf1); }
        if (w == 1) { const float a0 = lfb[2 * lane], a1 = lfb[2 * lane + 1]; const float inc = wave_incl_sum(a0 + a1, lane); const float tot = __shfl(inc, 63);
            const float b0 = tot - (inc - a0 - a1), b1 = tot - (inc - a1); bbw[2 * lane] = b0; bbw[2 * lane + 1] = b1;
            const float c0 = lib[2 * lane] - b0, c1 = lib[2 * lane + 1] - b1; cB[2 * lane] = c0; cB[2 * lane + 1] = c1;
            const float pm = wave_incl_max_down(fmaxf(c0, c1), lane); float pnext = __shfl_down(pm, 1); if (lane == 63) pnext = -3.0e38f;
            const float cm0 = pm, cm1 = fmaxf(pnext, c1);
            const float mb0 = b0 + fmaxf(m0b, cm0), mb1 = b1 + fmaxf(m0b, cm1);
            mtB[2 * lane] = mb0; mtB[2 * lane + 1] = mb1; wiB[2 * lane] = __expf(b0 + m0b - mb0); wiB[2 * lane + 1] = __expf(b1 + m0b - mb1); }
        { const int j = C.tid >> 2, part = C.tid & 3; float a = 0.f, a2 = 0.f;
#pragma unroll
          for (int i = 0; i < 16; i += 2) { const unsigned qq = *(const LAS unsigned*)(Qb + j * QS + part * 16 + i);
              const float q0 = __uint_as_float(qq << 16), q1 = __uint_as_float(qq & 0xffff0000u);
              a += q0 * n0f[part * 16 + i] + q1 * n0f[part * 16 + i + 1]; a2 += q0 * n0b[part * 16 + i] + q1 * n0b[part * 16 + i + 1]; }
          a += __shfl_xor(a, 1); a += __shfl_xor(a, 2); a2 += __shfl_xor(a2, 1); a2 += __shfl_xor(a2, 2);
          if (part == 0) { qnF[j] = a; qnB[j] = a2; } }
        __syncthreads();
        const int j = 16 * w + jl;
        bf16x8_t qf[2];
#pragma unroll
        for (int kk = 0; kk < 2; ++kk) qf[kk] = *(const LAS bf16x8_t*)(Qb + j * QS + kk * 32 + quad * 8);
        u32x2 ogate[4];
#pragma unroll
        for (int et = 0; et < 4; ++et) ogate[et] = *(const u32x2*)(zA + (tok0 + j) * ZA_LD + 1536 + 64 * h + 16 * et + 4 * quad);
        f32x4 accF[4], accB[4];
#pragma unroll
        for (int et = 0; et < 4; ++et) { accF[et] = (f32x4){0.f, 0.f, 0.f, 0.f}; accB[et] = (f32x4){0.f, 0.f, 0.f, 0.f};
#pragma unroll
            for (int kk = 0; kk < 2; ++kk) { const bf16x8_t af = *(const LAS bf16x8_t*)(SfT + (16 * et + jl) * QS + kk * 32 + quad * 8), ab = *(const LAS bf16x8_t*)(SbT + (16 * et + jl) * QS + kk * 32 + quad * 8);
                accF[et] = __builtin_amdgcn_mfma_f32_16x16x32_bf16(af, qf[kk], accF[et], 0, 0, 0); accB[et] = __builtin_amdgcn_mfma_f32_16x16x32_bf16(ab, qf[kk], accB[et], 0, 0, 0); } }
        const float ef = bfw[j] - mtF[j], ebk = bbw[j] - mtB[j];
        f32x4 pf[8], pb[8]; float rsf = 0.f, rsb = 0.f;
#pragma unroll
        for (int st = 0; st < 8; ++st) { f32x4 sa = (f32x4){0.f, 0.f, 0.f, 0.f};
#pragma unroll
            for (int kk = 0; kk < 2; ++kk) { const bf16x8_t ak = *(const LAS bf16x8_t*)(Kb + (16 * st + jl) * QS + kk * 32 + quad * 8); sa = __builtin_amdgcn_mfma_f32_16x16x32_bf16(ak, qf[kk], sa, 0, 0, 0); }
            const int s0 = 16 * st + 4 * quad;
            const f32x4 cf4 = *(const LAS f32x4*)(cF + s0), cb4 = *(const LAS f32x4*)(cB + s0);
#pragma unroll
            for (int i = 0; i < 4; ++i) { const int s = s0 + i; const float sv = sa[i] * 0.125f;
                const float x = (s <= j) ? __expf(ef + cf4[i]) * sv : 0.f, y = (s >= j) ? __expf(ebk + cb4[i]) * sv : 0.f;
                pf[st][i] = x; pb[st][i] = y; rsf += x; rsb += y; } }
        rsf += __shfl_xor(rsf, 16); rsf += __shfl_xor(rsf, 32); rsb += __shfl_xor(rsb, 16); rsb += __shfl_xor(rsb, 32);
        const float denF = wiF[j] * qnF[j] + rsf, denB = wiB[j] * qnB[j] + rsb;
        const float rF = __builtin_amdgcn_rcpf(fmaxf(fabsf(denF), __expf(-mtF[j]))), rB = __builtin_amdgcn_rcpf(fmaxf(fabsf(denB), __expf(-mtB[j])));
        const float aF = wiF[j] * rF, aB = wiB[j] * rB;
#pragma unroll
        for (int st = 0; st < 8; ++st) { const f32x4 pc = pf[st] * rF + pb[st] * rB; u32x2 pw; pw.x = pack2bf(pc[0], pc[1]); pw.y = pack2bf(pc[2], pc[3]);
            *(LAS u32x2*)(Pb + j * VS + 16 * st + 4 * quad) = pw; }
        asm volatile("s_waitcnt lgkmcnt(0)" ::: "memory");
        f32x4 oacc[4];
#pragma unroll
        for (int et = 0; et < 4; ++et) { oacc[et] = accF[et] * aF + accB[et] * aB;
#pragma unroll
            for (int kk = 0; kk < 4; ++kk) { const bf16x8_t av = *(const LAS bf16x8_t*)(VT + (16 * et + jl) * VS + kk * 32 + quad * 8), bp = *(const LAS bf16x8_t*)(Pb + j * VS + kk * 32 + quad * 8);
                oacc[et] = __builtin_amdgcn_mfma_f32_16x16x32_bf16(av, bp, oacc[et], 0, 0, 0); } }
        { const size_t tok = tok0 + j; float ss = 0.f; f32x4 val[4];
#pragma unroll
          for (int et = 0; et < 4; ++et) { const u32x2 ow = ogate[et];
              val[et][0] = sigmoidf_(__uint_as_float(ow.x << 16)) * oacc[et][0]; val[et][1] = sigmoidf_(__uint_as_float(ow.x & 0xffff0000u)) * oacc[et][1];
              val[et][2] = sigmoidf_(__uint_as_float(ow.y << 16)) * oacc[et][2]; val[et][3] = sigmoidf_(__uint_as_float(ow.y & 0xffff0000u)) * oacc[et][3];
              ss += val[et][0] * val[et][0] + val[et][1] * val[et][1] + val[et][2] * val[et][2] + val[et][3] * val[et][3]; }
          ss += __shfl_xor(ss, 16); ss += __shfl_xor(ss, 32);
          const float rstd = rsqrtf(ss * (1.0f / 64.0f) + EPSF);
#pragma unroll
          for (int et = 0; et < 4; ++et) { u32x2 ww; ww.x = pack2bf(val[et][0] * rstd, val[et][1] * rstd); ww.y = pack2bf(val[et][2] * rstd, val[et][3] * rstd);
              *(u32x2*)(XB + tok * DM + 768 + 64 * h + 16 * et + 4 * quad) = ww; } }
        __syncthreads();
    }
}

#ifndef NO_MIXERS
#define NO_MIXERS 0
#endif
__device__ __forceinline__ void grid_barrier(unsigned* bar, unsigned target) {
    __syncthreads();
    if (threadIdx.x == 0) {
        __threadfence();
        __hip_atomic_fetch_add(bar, 1u, __ATOMIC_RELAXED, __HIP_MEMORY_SCOPE_AGENT);
        while (__hip_atomic_load(bar, __ATOMIC_RELAXED, __HIP_MEMORY_SCOPE_AGENT) < target) __builtin_amdgcn_s_sleep(1);
        __threadfence();
    }
    __syncthreads();
}
__global__ void __launch_bounds__(NTHR, 2) mk_fwd(Params P) {
    extern __shared__ __attribute__((aligned(16))) unsigned char lds_raw[];
    cg::grid_group grid = cg::this_grid();
    Ctx C; C.tid = threadIdx.x; C.lane = C.tid & 63; C.wid = __builtin_amdgcn_readfirstlane(C.tid >> 6); C.bid = blockIdx.x; C.nb = gridDim.x; C.lds = (LAS unsigned char*)lds_raw;
    if (C.tid == 0) { LAS unsigned long long* sp = (LAS unsigned long long*)(C.lds + PARAM_OFF);
#pragma unroll
        for (int i = 0; i < 29; ++i) sp[i] = (unsigned long long)P.in[i];
        sp[29] = (unsigned long long)P.out; sp[30] = (unsigned long long)P.ws; }
    __syncthreads();
    unsigned char* ws = C.gptr(30); C.ws = ws;
    bf16_t* XB = (bf16_t*)(ws + OFF_XB);
    bf16_t* zA = (bf16_t*)(ws + OFF_Z);
    bf16_t* zB = (bf16_t*)(ws + OFF_ZB);
    bf16_t* ACT = (bf16_t*)(ws + OFF_Z);
    bf16_t* PROJ = (bf16_t*)(ws + OFF_Z);
    bf16_t* PB = (bf16_t*)(ws + OFF_PB);
    float* out = (float*)C.gptr(29);
#ifndef PROBE_GROUP
#define PROBE_GROUP 0
#endif
    unsigned long long tacc = 0ull, tbeg = 0ull;
#define TB(g) do { if (PROBE_GROUP & (1 << (g))) tbeg = __builtin_amdgcn_s_memrealtime(); } while (0)
#define TE(g) do { if (PROBE_GROUP & (1 << (g))) tacc += __builtin_amdgcn_s_memrealtime() - tbeg; } while (0)

    unsigned* gbar = (unsigned*)(ws + OFF_BAR); unsigned gcount = 0;
    if (C.bid == 0 && C.tid == 0) __hip_atomic_store(gbar, 0u, __ATOMIC_RELAXED, __HIP_MEMORY_SCOPE_AGENT);
#define GSYNC() do { gcount += (unsigned)C.nb; grid_barrier((unsigned*)(C.gptr(30) + OFF_BAR), gcount); } while (0)
    TB(10); phase_prep0a(C);
    phase_norm(C.in(0), C.in(1), C, C.in(5), C.in(4));
    grid.sync();
    phase_weights(C);
#if !NO_MIXERS
    phase_kspec(C, 0);
#endif
    GSYNC(); TE(10);

#define FRESH() do { asm volatile("" : "+s"(l)); { LAS unsigned char* lp_ = (LAS unsigned char*)lds_raw; asm volatile("" : "+s"(lp_)); C.lds = lp_; } asm volatile("" : "+v"(C.tid)); C.lane = C.tid & 63; C.wid = __builtin_amdgcn_readfirstlane(C.tid >> 6); asm volatile("" : "+s"(C.bid), "+s"(C.nb)); ws = C.gptr(30); C.ws = ws; \
        XB = (bf16_t*)(ws + OFF_XB); zA = (bf16_t*)(ws + OFF_Z); zB = (bf16_t*)(ws + OFF_ZB); ACT = zA; PROJ = zA; PB = (bf16_t*)(ws + OFF_PB); out = (float*)C.gptr(29); wb = ws + OFF_W + (size_t)l * W_LAYER; } while (0)
    for (int l = 0; l < 2; ++l) {
        unsigned char* wb = ws + OFF_W + (size_t)l * W_LAYER;
        TB(1); __syncthreads(); FRESH();
        { pg8::Gemm g{XB, (const bf16_t*)(wb + W_INA), T_TOK, ZA_LD, DM}; pg8::StaticOrder S; S.init(T_TOK, ZA_LD, C.nb, C.bid);
          pg8::EpiBf16<0> E{zA, ZA_LD, nullptr, 0, 0}; pg8::gemm_phase<pg8::EpiBf16<0>, pg8::StaticOrder>(C.lds, g, S, E, nullptr); }
        __syncthreads(); FRESH();
        { pg8::Gemm g{(const bf16_t*)(wb + W_INB), XB, ZB_ROWS, T_TOK, DM}; pg8::StaticOrder S; S.init(ZB_ROWS, T_TOK, C.nb, (C.bid + ((T_TOK / 256) * (ZA_LD / 256)) % C.nb) % C.nb);
          pg8::EpiBf16<0> E{zB, T_TOK, nullptr, 0, 0}; pg8::gemm_phase<pg8::EpiBf16<0>, pg8::StaticOrder>(C.lds, g, S, E, nullptr); }
        __syncthreads();
#if !NO_MIXERS
        FRESH(); if (l == 1) phase_kspec(C, 1);
#endif
        GSYNC(); TE(1);
#if !NO_MIXERS
        TB(2); TB(17); FRESH(); phase_mlstm_local(C, l); TE(17);
        TB(11); FRESH(); phase_hyena(C, l); TE(11);
        GSYNC(); TE(2);
        TB(3); TB(14); FRESH(); phase_mlstm_scan(C); TE(14);
        TB(12); FRESH(); phase_fnet(C); TE(12);
        TB(13); FRESH(); phase_na(C, l); TE(13);
        GSYNC(); TE(3);
        TB(4); TB(16); FRESH(); phase_mlstm_out(C, l); TE(16);
        TB(15); FRESH(); phase_headnorm_cm(C); TE(15);
        GSYNC(); TE(4);
#else
        for (size_t i = (size_t)C.bid * NTHR + C.tid; i < (size_t)T_TOK * DM / 8; i += (size_t)C.nb * NTHR) ((u32x4*)XB)[i] = (u32x4){0u, 0u, 0u, 0u};
        GSYNC();
#endif
        TB(5); __syncthreads(); FRESH();
        { pg8::Gemm g{XB, (const bf16_t*)(wb + W_OUT), T_TOK, DM, DM}; pg8::StaticOrder S; S.init(T_TOK, DM, C.nb, C.bid);
          EpiResF32 E{l == 0 ? C.in(0) : out, l == 0 ? C.in(1) : out + (size_t)T_PROMPT * DM, out}; pg8::gemm_phase<EpiResF32, pg8::StaticOrder>(C.lds, g, S, E, nullptr); }
        GSYNC(); TE(5);
        TB(6); FRESH(); phase_pconv(C.in(2) + (size_t)l * T_PROMPT * 256, C.in(3) + (size_t)l * (T_TOK - T_PROMPT) * 256, C);
        FRESH(); phase_norm(out, out + (size_t)T_PROMPT * DM, C, nullptr, nullptr);
        GSYNC(); TE(6);
        TB(7); __syncthreads(); FRESH();
        { pg8::Gemm g{XB, (const bf16_t*)(wb + W_GU), T_TOK, 2 * DFF, DM}; pg8::StaticOrder S; S.init(T_TOK, 2 * DFF, C.nb, C.bid);
          EpiSwiGLU E{ACT}; pg8::gemm_phase<EpiSwiGLU, pg8::StaticOrder>(C.lds, g, S, E, nullptr); }
        GSYNC(); TE(7);
        TB(8); __syncthreads(); FRESH();
        { pg8::Gemm g{ACT, (const bf16_t*)(wb + W_DOWN), T_TOK, DM, DFF}; pg8::StaticOrder S; S.init(T_TOK, DM, C.nb, C.bid);
          EpiResF32 E{out, out + (size_t)T_PROMPT * DM, out}; pg8::gemm_phase<EpiResF32, pg8::StaticOrder>(C.lds, g, S, E, nullptr); }
        GSYNC(); TE(8);
        TB(9); __syncthreads(); FRESH();
        { pg8::Gemm g{PB, (const bf16_t*)(wb + W_PP), T_TOK, DM, 256}; pg8::StaticOrder S; S.init(T_TOK, DM, C.nb, C.bid);
          pg8::EpiBf16<0> E{PROJ, DM, nullptr, 0, 0}; pg8::gemm_phase<pg8::EpiBf16<0>, pg8::StaticOrder>(C.lds, g, S, E, nullptr); }
        TB(6); FRESH(); phase_norm(out, out + (size_t)T_PROMPT * DM, C, nullptr, nullptr); TE(6);
        GSYNC();
        __syncthreads(); FRESH();
        { pg8::Gemm g{XB, (const bf16_t*)(wb + W_PG), T_TOK, DM, DM}; pg8::StaticOrder S; S.init(T_TOK, DM, C.nb, C.bid);
          EpiPle E{out, PROJ}; pg8::gemm_phase<EpiPle, pg8::StaticOrder>(C.lds, g, S, E, nullptr); }
        GSYNC(); TE(9);
        TB(6); FRESH();
        if (l == 0) { phase_norm(out, out + (size_t)T_PROMPT * DM, C, C.in(5) + (size_t)DM * NIN, C.in(4) + DM); GSYNC(); }
        else phase_final_norm(out, C.in(28), C);
        TE(6);
    }
#if PROBE_GROUP
    if (C.bid == 0) { if (C.tid == 0) { const unsigned long long t0 = __builtin_amdgcn_s_memrealtime(); while (__builtin_amdgcn_s_memrealtime() - t0 < tacc) __builtin_amdgcn_s_sleep(8); } __syncthreads(); }
#endif
}

extern "C" void kernel_launch(void* const* d_in, const int* in_sizes, int n_in, void* d_out, int out_size, void* d_ws, size_t ws_size, hipStream_t stream) {
    static int grid_blocks = 0;
    if (grid_blocks == 0) {
        if (n_in != 29 || ws_size < WS_END) { fprintf(stderr, "kernel_launch: unexpected n_in %d or workspace %zu < %zu\n", n_in, ws_size, (size_t)WS_END); grid_blocks = -1; return; }
        int dev = 0, cus = 0, per_cu = 0;
        hipGetDevice(&dev);
        hipDeviceGetAttribute(&cus, hipDeviceAttributeMultiprocessorCount, dev);
        if (hipFuncSetAttribute((const void*)mk_fwd, hipFuncAttributeMaxDynamicSharedMemorySize, LDS_BYTES) != hipSuccess) { fprintf(stderr, "kernel_launch: hipFuncSetAttribute failed\n"); grid_blocks = -1; return; }
        if (hipOccupancyMaxActiveBlocksPerMultiprocessor(&per_cu, (const void*)mk_fwd, NTHR, LDS_BYTES) != hipSuccess || per_cu < 1) { fprintf(stderr, "kernel_launch: occupancy query says %d\n", per_cu); per_cu = 1; }
        (void)hipGetLastError();
        grid_blocks = cus * per_cu;
    }
    if (grid_blocks < 0) return;
    Params p{};
    for (int i = 0; i < 29; ++i) p.in[i] = (const float*)d_in[i];
    p.out = (float*)d_out; p.ws = (unsigned char*)d_ws;
    void* args[] = {&p};
    hipError_t e = hipLaunchCooperativeKernel((const void*)mk_fwd, dim3(grid_blocks), dim3(NTHR), args, LDS_BYTES, stream);
    if (e != hipSuccess) fprintf(stderr, "cooperative launch failed: %s (grid %d)\n", hipGetErrorString(e), grid_blocks);
}
```

```cpp
#include <hip/hip_runtime.h>
#include <hip/hip_cooperative_groups.h>
#include <cstdio>
namespace cg = cooperative_groups;
namespace pg8 {
#define PG8_LAS __attribute__((address_space(3)))
typedef unsigned short bf16_t;
typedef short bf16x8 __attribute__((ext_vector_type(8)));
typedef float f32x4 __attribute__((ext_vector_type(4)));
typedef unsigned u32x4 __attribute__((ext_vector_type(4)));
constexpr int BM = 256, BK = 64, HALF = 128, HTB = HALF * BK * 2  , STAGE_BYTES = 8 * HTB, NXCD = 8, WGM = 8;

__host__ __device__ __forceinline__ int lds_byte(int r, int c) { const int st = (r >> 4) * 2 + (c >> 5), rr = r & 15, cc = c & 31, ob = rr * 64 + cc * 2; return st * 1024 + (ob ^ (((ob >> 9) & 1) << 5)); }
__host__ __device__ __forceinline__ void stage_rc(int b, int& R, int& C) { const int st = b / 1024, sb = b % 1024, swz = sb ^ (((sb >> 9) & 1) << 5); R = (st >> 1) * 16 + swz / 64; C = (st & 1) * 32 + (swz % 64) / 2; }
__host__ __device__ __forceinline__ int perm32(int rho) { const int n = rho >> 4, i = rho & 15; return 8 * (i >> 2) + 4 * n + (i & 3); }

struct Unit { int pm, pn; };
struct Gemm { const bf16_t* A; const bf16_t* Bt; int M, N, K; };

struct StaticOrder {
    int nM, nN, nwg, G, c;
    __host__ __device__ void init(int M, int N, int G_, int c_) { nM = M / BM; nN = N / BM; nwg = nM * nN; G = G_; c = c_; }
    __host__ __device__ bool next(int i, Unit& u) const {
        const long L = (long)i * G + c; if (L >= nwg) return false;
        int wgid = (int)L; { const int q = nwg / NXCD, r = nwg % NXCD, xcd = wgid % NXCD, off = wgid / NXCD; wgid = (xcd < r ? xcd * (q + 1) : r * (q + 1) + (xcd - r) * q) + off; }
        const int nig = WGM * nN, gid = wgid / nig, fm = gid * WGM, gsz = (nM - fm) < WGM ? (nM - fm) : WGM;
        u.pm = fm + ((wgid % nig) % gsz); u.pn = (wgid % nig) / gsz; return true;
    }
    __device__ __forceinline__ void a_ready(const Unit&) const {}
    __device__ __forceinline__ void done(const Unit&) const {}
};
struct CountedOrder : StaticOrder {
    const unsigned* ready; unsigned need; unsigned* tmo;
    __device__ __forceinline__ void a_ready(const Unit& u) const {
        if (threadIdx.x < 64) {
            const unsigned long long t0 = __builtin_amdgcn_s_memrealtime(); unsigned polls = 0;
            while ((unsigned)__builtin_amdgcn_readfirstlane(__hip_atomic_load(ready + 64 * u.pm, __ATOMIC_RELAXED, __HIP_MEMORY_SCOPE_AGENT)) < need) {
                if ((++polls & 255u) == 0u && __builtin_amdgcn_readfirstlane(__hip_atomic_load(tmo, __ATOMIC_RELAXED, __HIP_MEMORY_SCOPE_AGENT)) != 0u) break;
                if (__builtin_amdgcn_s_memrealtime() - t0 > 2000000ull) {
                    if (threadIdx.x == 0) { unsigned expect = 0u; __hip_atomic_compare_exchange_strong(tmo + 1, &expect, 0x600u | (unsigned)(u.pm & 0xff), __ATOMIC_RELAXED, __ATOMIC_RELAXED, __HIP_MEMORY_SCOPE_AGENT); __hip_atomic_store(tmo, 1u, __ATOMIC_RELAXED, __HIP_MEMORY_SCOPE_AGENT); }
                    break; }
                __builtin_amdgcn_s_sleep(2); }
            __builtin_amdgcn_fence(__ATOMIC_ACQUIRE, "agent");
            asm volatile("s_waitcnt vmcnt(0)" ::: "memory");
        }
#if !defined(BROKEN_HOOK_NO_BARRIER)
        asm volatile("" ::: "memory"); __builtin_amdgcn_s_barrier(); asm volatile("" ::: "memory");
#endif
    }
};

__device__ __forceinline__ unsigned cvt_pk_bf16(float lo, float hi) { unsigned r; asm volatile("v_cvt_pk_bf16_f32 %0, %1, %2" : "=v"(r) : "v"(lo), "v"(hi)); return r; }
typedef float f32x2 __attribute__((ext_vector_type(2)));
__device__ __forceinline__ f32x2 gelu_pk(f32x2 v) {
    const f32x2 av = __builtin_elementwise_abs(v), d = av * 0.2316418882f + 1.0f;
    f32x2 t; t.x = __builtin_amdgcn_rcpf(d.x); t.y = __builtin_amdgcn_rcpf(d.y);
    f32x2 q = t * 0.5307027145f + (-0.7265760135f); q = q * t + 0.7107068705f; q = q * t + (-0.142248368f); q = q * t + 0.127414796f; q = q * t;
    const f32x2 s = (v * v) * (-0.72134752044f);
    f32x2 e; e.x = __builtin_amdgcn_exp2f(s.x); e.y = __builtin_amdgcn_exp2f(s.y);
    const f32x2 m = v * (q * e), r = v - m;
    f32x2 o; o.x = v.x < 0.f ? m.x : r.x; o.y = v.y < 0.f ? m.y : r.y; return o;
}

struct EpiF32 {
    static constexpr bool PERM = false, AFTER_DRAIN = false;
    float* C; int ldc; const float* bias;
    __device__ __forceinline__ void operator()(const f32x4 (&acc)[2][2][4][2], const Unit& u, int wr, int wc, int fr, int fq) const {
        const int row0 = u.pm * BM + wr * 64 + fr, col0 = u.pn * BM + wc * 32 + 4 * fq;
        f32x4 bv[2][2];
#pragma unroll
        for (int bj = 0; bj < 2; ++bj)
#pragma unroll
            for (int n = 0; n < 2; ++n) bv[bj][n] = bias ? *(const f32x4*)(bias + col0 + bj * HALF + n * 16) : (f32x4){0.f, 0.f, 0.f, 0.f};
#pragma unroll
        for (int ai = 0; ai < 2; ++ai)
#pragma unroll
            for (int m = 0; m < 4; ++m) { float* rowp = C + (size_t)(row0 + ai * HALF + m * 16) * ldc + col0;
#pragma unroll
                for (int bj = 0; bj < 2; ++bj)
#pragma unroll
                    for (int n = 0; n < 2; ++n) *(f32x4*)(rowp + bj * HALF + n * 16) = acc[ai][bj][m][n] + bv[bj][n]; }
    }
};
template <int ACT  > struct EpiBf16 {
    static constexpr bool PERM = true, AFTER_DRAIN = false;
    bf16_t* O; int ldc; const float* bias; int split_cols; size_t split_stride;
    __device__ __forceinline__ void operator()(const f32x4 (&acc)[2][2][4][2], const Unit& u, int wr, int wc, int fr, int fq) const {
        const int row0 = u.pm * BM + wr * 64 + fr; int colt = u.pn * BM; bf16_t* base = O;
        if (split_cols) { const int t = colt / split_cols; base += (size_t)t * split_stride; colt -= t * split_cols; }
        const int col0 = colt + wc * 32 + 8 * fq, bcol0 = u.pn * BM + wc * 32 + 8 * fq;
        f32x4 bv[2][2];
#pragma unroll
        for (int bj = 0; bj < 2; ++bj)
#pragma unroll
            for (int n = 0; n < 2; ++n) bv[bj][n] = bias ? *(const f32x4*)(bias + bcol0 + bj * HALF + 4 * n) : (f32x4){0.f, 0.f, 0.f, 0.f};
#pragma unroll
        for (int ai = 0; ai < 2; ++ai)
#pragma unroll
            for (int m = 0; m < 4; ++m) { bf16_t* rowp = base + (size_t)(row0 + ai * HALF + m * 16) * ldc + col0;
#pragma unroll
                for (int bj = 0; bj < 2; ++bj) { f32x4 v0 = acc[ai][bj][m][0] + bv[bj][0], v1 = acc[ai][bj][m][1] + bv[bj][1];
                    if (ACT == 1) { f32x2 a = gelu_pk((f32x2){v0[0], v0[1]}), b = gelu_pk((f32x2){v0[2], v0[3]}), c = gelu_pk((f32x2){v1[0], v1[1]}), d = gelu_pk((f32x2){v1[2], v1[3]});
                        v0 = (f32x4){a.x, a.y, b.x, b.y}; v1 = (f32x4){c.x, c.y, d.x, d.y}; }
                    if (ACT == 2) {
#pragma unroll
                        for (int j = 0; j < 4; ++j) { v0[j] = 0.5f * v0[j] * (1.0f + erff(v0[j] * 0.70710678f)); v1[j] = 0.5f * v1[j] * (1.0f + erff(v1[j] * 0.70710678f)); } }
                    u32x4 w; w.x = cvt_pk_bf16(v0[0], v0[1]); w.y = cvt_pk_bf16(v0[2], v0[3]); w.z = cvt_pk_bf16(v1[0], v1[1]); w.w = cvt_pk_bf16(v1[2], v1[3]);
                    *(u32x4*)(rowp + bj * HALF) = w; } }
    }
};
template <class Epi, class Sched, bool STAMP = false>
__device__ __forceinline__ void gemm_phase(PG8_LAS unsigned char* lds, const Gemm g, const Sched& S, const Epi& E, unsigned long long* stamps) {
    int tid_ = threadIdx.x; asm volatile("" : "+v"(tid_)); const int tid = tid_, wid = __builtin_amdgcn_readfirstlane(tid >> 6), lane = tid & 63, wr = wid >> 2, wc = wid & 3, fr = lane & 15, fq = lane >> 4;
    const int K = g.K, nt = K / BK;
    int ts_lo = 0, ts_hi = 0, nts = 0; const unsigned long long rt_entry = STAMP ? (unsigned long long)wall_clock64() : 0ull;
#define PG8_STAMP() do { if (STAMP && wid == 0 && nts < 64) { const unsigned long long _c = (unsigned long long)clock64(); \
        ts_lo = (lane == nts) ? (int)(unsigned)_c : ts_lo; ts_hi = (lane == nts) ? (int)(unsigned)(_c >> 32) : ts_hi; ++nts; } } while (0)
    PG8_STAMP();
    unsigned voffA[2], voffB[2];
#pragma unroll
    for (int i = 0; i < 2; ++i) { int R, C; stage_rc(tid * 16 + i * 8192, R, C); const int Rb = Epi::PERM ? ((R & ~31) + perm32(R & 31)) : R;
        voffA[i] = (unsigned)(R * K + C) * 2u; voffB[i] = (unsigned)(Rb * K + C) * 2u; }
    const size_t kstep = (size_t)(BK * 2);
    const size_t hstep = (size_t)HALF * K * 2;
    const size_t tstep = 2 * hstep;
    const unsigned ldsw = (unsigned)wid * 1024u;
    const int aoff = lds_byte(wr * 64 + fr, fq * 8), boff = lds_byte(wc * 32 + fr, fq * 8);
#define PG8_SA(b, h) (((b) * 2 + (h)) * HTB)
#define PG8_SB(b, h) ((4 + (b) * 2 + (h)) * HTB)
#define PG8_STAGE(bufoff, gbase, voff) do { _Pragma("unroll") for (int _i = 0; _i < 2; ++_i) \
        __builtin_amdgcn_global_load_lds((const unsigned*)((const char*)(gbase) + (voff)[_i]), (PG8_LAS unsigned*)(lds + (bufoff) + ldsw + _i * 8192), 16, 0, 0); } while (0)
#define PG8_LDA(dst, b, h) do { _Pragma("unroll") for (int m = 0; m < 4; ++m) _Pragma("unroll") for (int k = 0; k < 2; ++k) dst[m][k] = *(const PG8_LAS bf16x8*)(lds + PG8_SA(b, h) + aoff + m * 2048 + k * 1024); } while (0)
#define PG8_LDB(dst, b, h) do { _Pragma("unroll") for (int n = 0; n < 2; ++n) _Pragma("unroll") for (int k = 0; k < 2; ++k) dst[n][k] = *(const PG8_LAS bf16x8*)(lds + PG8_SB(b, h) + boff + n * 2048 + k * 1024); } while (0)
#define PG8_MMA(ai, bj, At, Bt) do { __builtin_amdgcn_s_setprio(1); _Pragma("unroll") for (int m = 0; m < 4; ++m) _Pragma("unroll") for (int n = 0; n < 2; ++n) _Pragma("unroll") for (int k = 0; k < 2; ++k) \
        acc[ai][bj][m][n] = __builtin_amdgcn_mfma_f32_16x16x32_bf16(Bt[n][k], At[m][k], acc[ai][bj][m][n], 0, 0, 0); __builtin_amdgcn_s_setprio(0); } while (0)
#define PG8_WAIT_V(n) asm volatile("s_waitcnt vmcnt(" #n ")" ::: "memory")
#define PG8_WAIT_L(n) asm volatile("s_waitcnt lgkmcnt(" #n ")" ::: "memory")
#define PG8_BAR __builtin_amdgcn_s_barrier()
#define PG8_SCHED __builtin_amdgcn_sched_barrier(0)
    Unit cur, nxt; int ui = 0;
    if (!S.next(0, cur)) return;
    f32x4 acc[2][2][4][2];
#pragma unroll
    for (int a = 0; a < 2; ++a)
#pragma unroll
        for (int b = 0; b < 2; ++b)
#pragma unroll
            for (int m = 0; m < 4; ++m)
#pragma unroll
                for (int n = 0; n < 2; ++n) acc[a][b][m][n] = (f32x4){0.f, 0.f, 0.f, 0.f};
    bf16x8 At[4][2], B0[2][2], B1[2][2];
    const char* cA = (const char*)g.A + (size_t)cur.pm * tstep; const char* cB = (const char*)g.Bt + (size_t)cur.pn * tstep;
    S.a_ready(cur);
    PG8_STAGE(PG8_SB(0, 0), cB, voffB); PG8_STAGE(PG8_SA(0, 0), cA, voffA); PG8_STAGE(PG8_SB(0, 1), cB + hstep, voffB); PG8_STAGE(PG8_SA(0, 1), cA + hstep, voffA);
    if (wr == 1) PG8_BAR;
    PG8_WAIT_V(4); PG8_BAR;
    PG8_STAGE(PG8_SB(1, 0), cB + kstep, voffB); PG8_STAGE(PG8_SA(1, 0), cA + kstep, voffA); PG8_STAGE(PG8_SB(1, 1), cB + hstep + kstep, voffB);
    PG8_WAIT_V(6); PG8_BAR;
    PG8_STAMP();
    for (;;) {
        const bool has_next = S.next(ui + 1, nxt);
        const char* nA = has_next ? (const char*)g.A + (size_t)nxt.pm * tstep : cA; const char* nB = has_next ? (const char*)g.Bt + (size_t)nxt.pn * tstep : cB;
        for (int t = 0; t < nt; t += 2) {
            const bool last = (t == nt - 2);
            const char* a1 = cA + (size_t)(t + 1) * kstep;
            const char* a2 = last ? nA : cA + (size_t)(t + 2) * kstep; const char* b2 = last ? nB : cB + (size_t)(t + 2) * kstep;
            const char* a3 = a2 + kstep; const char* b3 = b2 + kstep;
            if (last && has_next) S.a_ready(nxt);
            PG8_LDB(B0, 0, 0); PG8_SCHED; PG8_LDA(At, 0, 0); PG8_STAGE(PG8_SA(1, 1), a1 + hstep, voffA);
            PG8_WAIT_L(8); PG8_BAR; PG8_WAIT_L(0); PG8_MMA(0, 0, At, B0); PG8_BAR; PG8_SCHED;
            PG8_LDB(B1, 0, 1); PG8_STAGE(PG8_SB(0, 0), b2, voffB);
            PG8_BAR; PG8_WAIT_L(0); PG8_MMA(0, 1, At, B1); PG8_BAR;
            PG8_LDA(At, 0, 1); PG8_STAGE(PG8_SA(0, 0), a2, voffA);
            PG8_BAR; PG8_WAIT_L(0); PG8_MMA(1, 0, At, B0); PG8_BAR; PG8_SCHED;
            PG8_STAGE(PG8_SB(0, 1), b2 + hstep, voffB);
            PG8_WAIT_V(6); PG8_BAR; PG8_MMA(1, 1, At, B1); PG8_BAR;
            PG8_LDB(B0, 1, 0); PG8_SCHED; PG8_LDA(At, 1, 0); PG8_STAGE(PG8_SA(0, 1), a2 + hstep, voffA);
            PG8_WAIT_L(8); PG8_BAR; PG8_WAIT_L(0); PG8_MMA(0, 0, At, B0); PG8_BAR; PG8_SCHED;
            PG8_LDB(B1, 1, 1); PG8_STAGE(PG8_SB(1, 0), b3, voffB);
            PG8_BAR; PG8_WAIT_L(0); PG8_MMA(0, 1, At, B1); PG8_BAR;
            PG8_LDA(At, 1, 1); PG8_STAGE(PG8_SA(1, 0), a3, voffA);
            PG8_BAR; PG8_WAIT_L(0); PG8_MMA(1, 0, At, B0); PG8_BAR; PG8_SCHED;
            PG8_STAGE(PG8_SB(1, 1), b3 + hstep, voffB);
            PG8_WAIT_V(6); PG8_BAR; PG8_MMA(1, 1, At, B1); PG8_BAR;
        }
        PG8_STAMP();
        if constexpr (!Epi::AFTER_DRAIN) { E(acc, cur, wr, wc, fr, fq); S.done(cur); }
        PG8_STAMP();
        if (!has_next) break;
#pragma unroll
        for (int a = 0; a < 2; ++a)
#pragma unroll
            for (int b = 0; b < 2; ++b)
#pragma unroll
                for (int m = 0; m < 4; ++m)
#pragma unroll
                    for (int n = 0; n < 2; ++n) acc[a][b][m][n] = (f32x4){0.f, 0.f, 0.f, 0.f};
        cur = nxt; cA = nA; cB = nB; ++ui;
    }
    PG8_WAIT_V(0);
    if (wr == 0) PG8_BAR;
    PG8_BAR;
    if constexpr (Epi::AFTER_DRAIN) { E.fused(acc, cur, wr, wc, fr, fq, lds, wid, lane); S.done(cur); }
    PG8_STAMP();
    if (STAMP && wid == 0) { stamps[lane] = lane < nts ? (((unsigned long long)(unsigned)ts_hi << 32) | (unsigned)ts_lo) : 0ull;
        if (lane == 62) stamps[62] = rt_entry; if (lane == 63) stamps[63] = (unsigned long long)wall_clock64(); }
#undef PG8_STAMP
#undef PG8_SA
#undef PG8_SB
#undef PG8_STAGE
#undef PG8_LDA
#undef PG8_LDB
#undef PG8_MMA
#undef PG8_WAIT_V
#undef PG8_WAIT_L
#undef PG8_BAR
#undef PG8_SCHED
}
}

typedef unsigned short bf16_t;
typedef float f32x4 __attribute__((ext_vector_type(4)));
typedef unsigned u32x4 __attribute__((ext_vector_type(4)));
typedef unsigned u32x2 __attribute__((ext_vector_type(2)));
#define LAS __attribute__((address_space(3)))

constexpr int T_TOK = 81920, T_PROMPT = 16384, SEQL = 8192, NSEQ = 10, DM = 1024, DFF = 2816, NIN = 2832;
constexpr int ZA_LD = 1792;
constexpr int ZB_ROWS = 1280;
constexpr float EPSF = 1e-6f;
constexpr int NTHR = 512;
constexpr int LDS_BYTES = 152 * 1024;

constexpr size_t al256(size_t x) { return (x + 255) & ~(size_t)255; }
constexpr size_t OFF_TW = 0;
constexpr size_t OFF_H2 = OFF_TW + 8192 * 8;
constexpr size_t OFF_FAB = OFF_H2 + (size_t)2 * 8192 * 64 * 4;
constexpr size_t OFF_W = OFF_FAB + (size_t)2 * 4 * 2 * 4096 * 4;
constexpr size_t W_INA = 0;
constexpr size_t W_INB = W_INA + (size_t)1792 * 1024 * 2;
constexpr size_t W_OUT = W_INB + (size_t)1280 * 1024 * 2;
constexpr size_t W_GU = W_OUT + (size_t)1024 * 1024 * 2;
constexpr size_t W_DOWN = W_GU + (size_t)5632 * 1024 * 2;
constexpr size_t W_PG = W_DOWN + (size_t)1024 * 2816 * 2;
constexpr size_t W_PP = W_PG + (size_t)1024 * 1024 * 2;
constexpr size_t W_LAYER = W_PP + (size_t)1024 * 256 * 2;
constexpr size_t OFF_KS = OFF_W + 2 * W_LAYER;
constexpr size_t OFF_XB = OFF_KS + (size_t)2 * 256 * 16384 * 8;
constexpr size_t OFF_GATES = OFF_XB + (size_t)T_TOK * 1024 * 2;
constexpr size_t OFF_PB = OFF_GATES + (size_t)T_TOK * 16 * 4;
constexpr size_t OFF_STS = OFF_PB + (size_t)T_TOK * 256 * 2;
constexpr size_t OFF_STN = OFF_STS + (size_t)80 * 64 * 4096 * 4;
constexpr size_t OFF_STC = OFF_STN + (size_t)80 * 64 * 64 * 4;
constexpr size_t OFF_Z = al256(OFF_STC + (size_t)80 * 64 * 4 * 4);
constexpr size_t OFF_ZB = OFF_Z + (size_t)T_TOK * ZA_LD * 2;
constexpr size_t OFF_SCR = OFF_ZB + (size_t)ZB_ROWS * T_TOK * 2;
constexpr size_t OFF_BAR = OFF_SCR + (size_t)256 * 8192 * 8;
constexpr size_t WS_END = OFF_BAR + 256;

struct Params { const float* in[29]; float* out; unsigned char* ws; };

__device__ __forceinline__ bf16_t f2bf(float f) { unsigned u = __float_as_uint(f); u += 0x7FFFu + ((u >> 16) & 1u); return (bf16_t)(u >> 16); }
__device__ __forceinline__ float bf2f(bf16_t b) { return __uint_as_float(((unsigned)b) << 16); }
__device__ __forceinline__ unsigned pack2bf(float lo, float hi) { unsigned r; asm("v_cvt_pk_bf16_f32 %0, %1, %2" : "=v"(r) : "v"(lo), "v"(hi)); return r; }
__device__ __forceinline__ float wave_sum(float v) {
#pragma unroll
    for (int o = 32; o >= 1; o >>= 1) v += __shfl_xor(v, o);
    return v;
}
__device__ __forceinline__ float wave_max(float v) {
#pragma unroll
    for (int o = 32; o >= 1; o >>= 1) v = fmaxf(v, __shfl_xor(v, o));
    return v;
}
__device__ __forceinline__ float sigmoidf_(float x) { return __builtin_amdgcn_rcpf(1.0f + __expf(-x)); }
__device__ __forceinline__ float logsigmoidf_(float x) { return x >= 0.f ? -log1pf(expf(-x)) : x - log1pf(expf(x)); }
__device__ __forceinline__ const float* xrow_ptr(const float* x0, const float* x1, int row) { return row < T_PROMPT ? x0 + (size_t)row * DM : x1 + (size_t)(row - T_PROMPT) * DM; }

struct EpiResF32 {
    static constexpr bool PERM = true, AFTER_DRAIN = false;
    const float* b0; const float* b1; float* out;
    __device__ __forceinline__ void operator()(const pg8::f32x4 (&acc)[2][2][4][2], const pg8::Unit& u, int wr, int wc, int fr, int fq) const {
        const int row0 = u.pm * 256 + wr * 64 + fr, col0 = u.pn * 256 + wc * 32 + 8 * fq;
        const float* base = (u.pm * 256 < T_PROMPT) ? b0 : b1 - (size_t)T_PROMPT * DM;
        f32x4 bs[4][4];
#define ERF_LOAD(g) do { const unsigned off_ = (unsigned)(row0 + ((g) >> 2) * 128 + ((g) & 3) * 16) * DM + col0; \
        bs[(g) % 4][0] = *(const f32x4*)(base + off_); bs[(g) % 4][1] = *(const f32x4*)(base + off_ + 4); bs[(g) % 4][2] = *(const f32x4*)(base + off_ + 128); bs[(g) % 4][3] = *(const f32x4*)(base + off_ + 132); } while (0)
        ERF_LOAD(0); asm volatile("" ::: "memory"); ERF_LOAD(1); asm volatile("" ::: "memory"); ERF_LOAD(2); asm volatile("" ::: "memory");
#pragma unroll
        for (int g = 0; g < 8; ++g) { const int ai = g >> 2, m = g & 3;
            if (g + 3 < 8) { ERF_LOAD(g + 3); }
            asm volatile("" ::: "memory");
            const unsigned off = (unsigned)(row0 + ai * 128 + m * 16) * DM + col0;
            *(f32x4*)(out + off) = bs[g % 4][0] + acc[ai][0][m][0]; *(f32x4*)(out + off + 4) = bs[g % 4][1] + acc[ai][0][m][1];
            *(f32x4*)(out + off + 128) = bs[g % 4][2] + acc[ai][1][m][0]; *(f32x4*)(out + off + 132) = bs[g % 4][3] + acc[ai][1][m][1];
            asm volatile("" ::: "memory"); }
#undef ERF_LOAD
    }
};
struct EpiSwiGLU {
    static constexpr bool PERM = true, AFTER_DRAIN = false;
    bf16_t* O;
    __device__ __forceinline__ void operator()(const pg8::f32x4 (&acc)[2][2][4][2], const pg8::Unit& u, int wr, int wc, int fr, int fq) const {
        const int row0 = u.pm * 256 + wr * 64 + fr, col0 = u.pn * 128 + wc * 32 + 8 * fq;
#pragma unroll
        for (int ai = 0; ai < 2; ++ai)
#pragma unroll
            for (int m = 0; m < 4; ++m) { float r[8];
#pragma unroll
                for (int n = 0; n < 2; ++n) { const f32x4 g = acc[ai][0][m][n], up = acc[ai][1][m][n];
#pragma unroll
                    for (int j = 0; j < 4; ++j) r[4 * n + j] = g[j] * sigmoidf_(g[j]) * up[j]; }
                u32x4 w; w.x = pack2bf(r[0], r[1]); w.y = pack2bf(r[2], r[3]); w.z = pack2bf(r[4], r[5]); w.w = pack2bf(r[6], r[7]);
                *(u32x4*)(O + (size_t)(row0 + ai * 128 + m * 16) * DFF + col0) = w; }
    }
};
struct EpiPle {
    static constexpr bool PERM = true, AFTER_DRAIN = false;
    float* out; const bf16_t* proj;
    __device__ __forceinline__ void operator()(const pg8::f32x4 (&acc)[2][2][4][2], const pg8::Unit& u, int wr, int wc, int fr, int fq) const {
        const int row0 = u.pm * 256 + wr * 64 + fr, col0 = u.pn * 256 + wc * 32 + 8 * fq;
        f32x4 bs[3][4]; u32x2 pj[3][4];
#define EPL_LOAD(g) do { const unsigned off_ = (unsigned)(row0 + ((g) >> 2) * 128 + ((g) & 3) * 16) * DM + col0; \
        bs[(g) % 3][0] = *(const f32x4*)(out + off_); bs[(g) % 3][1] = *(const f32x4*)(out + off_ + 4); bs[(g) % 3][2] = *(const f32x4*)(out + off_ + 128); bs[(g) % 3][3] = *(const f32x4*)(out + off_ + 132); \
        pj[(g) % 3][0] = *(const u32x2*)(proj + off_); pj[(g) % 3][1] = *(const u32x2*)(proj + off_ + 4); pj[(g) % 3][2] = *(const u32x2*)(proj + off_ + 128); pj[(g) % 3][3] = *(const u32x2*)(proj + off_ + 132); } while (0)
        EPL_LOAD(0); asm volatile("" ::: "memory"); EPL_LOAD(1); asm volatile("" ::: "memory");
#pragma unroll
        for (int g = 0; g < 8; ++g) { const int ai = g >> 2, m = g & 3;
            if (g + 2 < 8) { EPL_LOAD(g + 2); }
            asm volatile("" ::: "memory");
            const unsigned off = (unsigned)(row0 + ai * 128 + m * 16) * DM + col0;
#pragma unroll
            for (int q = 0; q < 4; ++q) { const f32x4 a = acc[ai][q >> 1][m][q & 1], b = bs[g % 3][q]; const u32x2 pw = pj[g % 3][q]; f32x4 r;
                r[0] = b[0] + sigmoidf_(a[0]) * __uint_as_float(pw.x << 16); r[1] = b[1] + sigmoidf_(a[1]) * __uint_as_float(pw.x & 0xffff0000u);
                r[2] = b[2] + sigmoidf_(a[2]) * __uint_as_float(pw.y << 16); r[3] = b[3] + sigmoidf_(a[3]) * __uint_as_float(pw.y & 0xffff0000u);
                *(f32x4*)(out + off + (q >> 1) * 128 + (q & 1) * 4) = r; }
            asm volatile("" ::: "memory"); }
#undef EPL_LOAD
    }
};

constexpr int PARAM_OFF = LDS_BYTES - 512;
struct Ctx { int tid, lane, wid, bid, nb; unsigned char* ws; LAS unsigned char* lds;
    __device__ __forceinline__ unsigned long long raw(int i) const { const unsigned long long v = ((const LAS unsigned long long*)(lds + PARAM_OFF))[i];
        const unsigned lo = __builtin_amdgcn_readfirstlane((unsigned)v), hi = __builtin_amdgcn_readfirstlane((unsigned)(v >> 32)); return ((unsigned long long)hi << 32) | lo; }
    __device__ __forceinline__ const float* in(int i) const { return (const float*)(const __attribute__((address_space(1))) float*)raw(i); }
    __device__ __forceinline__ unsigned char* gptr(int i) const { return (unsigned char*)(__attribute__((address_space(1))) unsigned char*)raw(i); }
};

__device__ __forceinline__ void phase_prep0a(const Ctx& C) {
    const int gt = C.bid * NTHR + C.tid, gn = C.nb * NTHR;
    typedef float f32x2_ __attribute__((ext_vector_type(2))); f32x2_* TW = (f32x2_*)(C.ws + OFF_TW);
    for (int k = gt; k < 8192; k += gn) { float s, c; sincospif((float)k * (1.0f / 8192.0f), &s, &c); { f32x2_ tv; tv.x = c; tv.y = -s; TW[k] = tv; } }
    float* FAB = (float*)(C.ws + OFF_FAB);
    for (int i = gt; i < 2 * 4 * 2 * 4096; i += gn) {
        const int d = i & 63, c = (i >> 6) & 63, ab = (i >> 12) & 1, g = (i >> 13) & 3, l = i >> 15;
        const float* w = C.in(7) + (size_t)((l * 4 + g) * 64) * 64;
        float acc = 0.f;
        for (int dp = 0; dp < 64; ++dp) { float s, cc; sincospif((float)((dp * c) & 63) * (1.0f / 32.0f), &s, &cc); acc += (ab ? s : cc) * w[dp * 64 + d]; }
        const float sc = 1.0f / sqrtf(64.0f * 8192.0f);
        FAB[i] = ab ? -acc * sc : acc * sc;
    }
    float* H2 = (float*)(C.ws + OFF_H2);
    const int gw = C.bid * 8 + C.wid, lane = C.lane;
#pragma unroll 1
    for (int l = 0; l < 2; ++l) {
        const float* w1 = C.in(10) + l * 33 * 64; const float* w2 = C.in(13) + l * 4096;
        const float b1 = C.in(11)[l * 64 + lane], b2 = C.in(14)[l * 64 + lane], fq0 = C.in(12)[l * 128 + lane], fq1 = C.in(12)[l * 128 + 64 + lane];
        float w1c[33], w2c[64];
#pragma unroll
        for (int i = 0; i < 33; ++i) w1c[i] = w1[i * 64 + lane];
#pragma unroll
        for (int i = 0; i < 64; ++i) w2c[i] = w2[i * 64 + lane];
#pragma unroll 1
        for (int s = gw; s < 8192; s += C.nb * 8) {
            const float t = (float)s / 8191.0f;
            const float ang = (float)(2.0 * 3.14159265358979323846 / 8192.0) * (float)s;
            float feat = 0.f;
            if (lane == 0) feat = t;
            else if (lane <= 32) { const int bi = (lane - 1) & 15; const float band = 1e-4f + (float)bi * ((15.0f - 1e-4f) / 15.0f); const float fb = ang * band; feat = lane <= 16 ? cosf(fb) : -sinf(fb); }
            float a = b1;
#pragma unroll
            for (int i = 0; i < 33; ++i) a += __shfl(feat, i) * w1c[i];
            const float h1 = sinf(fq0 * a);
            float a2 = b2;
#pragma unroll
            for (int i = 0; i < 64; ++i) a2 += __shfl(h1, i) * w2c[i];
            H2[(size_t)(l * 8192 + s) * 64 + lane] = sinf(fq1 * a2);
        }
    }
}

template <class ColF>
__device__ __forceinline__ void wtranspose(ColF colp, int ldw, int NOUT, int K, const float* gain, bf16_t* dst, const Ctx& C) {
    LAS float* tile = (LAS float*)C.lds;
    const int ntn = NOUT / 64, ntk = K / 64;
    for (int t = C.bid; t < ntn * ntk; t += C.nb) {
        const int tn = t % ntn, tk = t / ntn;
#pragma unroll
        for (int i = 0; i < 8; ++i) { const int e = C.tid + NTHR * i, jj = e & 63, ii = e >> 6, k = tk * 64 + ii;
            float v = colp(tn * 64 + jj)[(size_t)k * ldw]; if (gain) v *= gain[k]; tile[ii * 65 + jj] = v; }
        __syncthreads();
#pragma unroll
        for (int i = 0; i < 8; ++i) { const int e = C.tid + NTHR * i, ii = e & 63, jj = e >> 6; dst[(size_t)(tn * 64 + jj) * K + tk * 64 + ii] = f2bf(tile[ii * 65 + jj]); }
        __syncthreads();
    }
}
__device__ __forceinline__ void phase_weights(const Ctx& C) {
    for (int l = 0; l < 2; ++l) {
        unsigned char* wb = C.ws + OFF_W + (size_t)l * W_LAYER;
        const float* w_in = C.in(5) + (size_t)l * DM * NIN;
        const float* g_mix = C.in(4) + l * DM;
        wtranspose([=](int n) { return w_in + (n < 768 ? n : n + 1024); }, NIN, 1792, DM, g_mix, (bf16_t*)(wb + W_INA), C);
        wtranspose([=](int n) { return w_in + 1024 + n; }, NIN, 768, DM, g_mix, (bf16_t*)(wb + W_INB) + (size_t)512 * DM, C);
        const float* w_out = C.in(20) + (size_t)l * DM * DM;
        wtranspose([=](int n) { return w_out + n; }, DM, DM, DM, C.in(19) + l * DM, (bf16_t*)(wb + W_OUT), C);
        const float* w_g = C.in(22) + (size_t)l * DM * DFF; const float* w_u = C.in(23) + (size_t)l * DM * DFF;
        const long long gu_delta = (long long)(w_u - w_g);
        wtranspose([=](int r) { return w_g + ((r & 128) ? gu_delta : 0ll) + 128 * (r >> 8) + (r & 127); }, DFF, 2 * DFF, DM, C.in(21) + l * DM, (bf16_t*)(wb + W_GU), C);
        const float* w_d = C.in(24) + (size_t)l * DFF * DM;
        wtranspose([=](int n) { return w_d + n; }, DM, DM, DFF, nullptr, (bf16_t*)(wb + W_DOWN), C);
        const float* w_pg = C.in(26) + (size_t)l * DM * DM;
        wtranspose([=](int n) { return w_pg + n; }, DM, DM, DM, C.in(25) + l * DM, (bf16_t*)(wb + W_PG), C);
        const float* w_pp = C.in(27) + (size_t)l * 256 * DM;
        wtranspose([=](int n) { return w_pp + n; }, DM, DM, 256, nullptr, (bf16_t*)(wb + W_PP), C);
    }
    LAS float* wt = (LAS float*)C.lds; LAS float* fa = wt + 64 * 65; LAS float* fb = fa + 4096;
    const float* FAB = (const float*)(C.ws + OFF_FAB);
    for (int t = C.bid; t < 2 * 4 * 16; t += C.nb) {
        const int tk = t & 15, g = (t >> 4) & 3, l = t >> 6;
        const float* w_in = C.in(5) + (size_t)l * DM * NIN; const float* g_mix = C.in(4) + l * DM;
#pragma unroll
        for (int i = 0; i < 8; ++i) { const int e = C.tid + NTHR * i, cc = e & 63, ii = e >> 6, k = tk * 64 + ii;
            wt[ii * 65 + cc] = w_in[(size_t)k * NIN + 768 + 64 * g + cc] * g_mix[k];
            fa[e] = FAB[((l * 4 + g) * 2 + 0) * 4096 + e]; fb[e] = FAB[((l * 4 + g) * 2 + 1) * 4096 + e]; }
        __syncthreads();
        const int k = C.tid & 63, dg = C.tid >> 6;
        float ap[8], aq[8];
#pragma unroll
        for (int i = 0; i < 8; ++i) { ap[i] = 0.f; aq[i] = 0.f; }
        for (int c = 0; c < 64; ++c) { const float w = wt[k * 65 + c];
#pragma unroll
            for (int i = 0; i < 8; ++i) { ap[i] += w * fa[c * 64 + dg * 8 + i]; aq[i] += w * fb[c * 64 + dg * 8 + i]; } }
        bf16_t* wB = (bf16_t*)(C.ws + OFF_W + (size_t)l * W_LAYER + W_INB);
#pragma unroll
        for (int i = 0; i < 8; ++i) { const int d = dg * 8 + i; wB[(size_t)(64 * g + d) * DM + tk * 64 + k] = f2bf(ap[i]); wB[(size_t)(256 + 64 * g + d) * DM + tk * 64 + k] = f2bf(aq[i]); }
        __syncthreads();
    }
}

__device__ __forceinline__ void phase_norm(const float* x0, const float* x1, const Ctx& C, const float* gate_w  , const float* gate_gain) {
    bf16_t* XB = (bf16_t*)(C.ws + OFF_XB);
    float* gates = (float*)(C.ws + OFF_GATES);
    LAS float* wg = (LAS float*)C.lds;
    if (gate_w) {
        for (int e = C.tid; e < 16 * 1024; e += NTHR) { const int j = e & 15, k = e >> 4; wg[j * 1024 + k] = gate_w[(size_t)k * NIN + 2816 + j] * gate_gain[k]; }
        __syncthreads();
    }
    const int lane = C.lane;
    const int rstep = C.nb * 8;
    f32x4 nx[4], ny[4];
    { const int row = C.bid * 8 + C.wid; if (row < T_TOK) { const float* xr = xrow_ptr(x0, x1, row);
#pragma unroll
        for (int j = 0; j < 4; ++j) nx[j] = __builtin_nontemporal_load((const f32x4*)(xr + 4 * lane + 256 * j)); }
      if (row + rstep < T_TOK) { const float* xr = xrow_ptr(x0, x1, row + rstep);
#pragma unroll
        for (int j = 0; j < 4; ++j) ny[j] = __builtin_nontemporal_load((const f32x4*)(xr + 4 * lane + 256 * j)); } }
    for (int row = C.bid * 8 + C.wid; row < T_TOK; row += rstep) {
        f32x4 v[4]; float ss = 0.f;
#pragma unroll
        for (int j = 0; j < 4; ++j) { v[j] = nx[j]; nx[j] = ny[j]; }
        if (row + 2 * rstep < T_TOK) { const float* xn = xrow_ptr(x0, x1, row + 2 * rstep);
#pragma unroll
            for (int j = 0; j < 4; ++j) ny[j] = __builtin_nontemporal_load((const f32x4*)(xn + 4 * lane + 256 * j)); }
#pragma unroll
        for (int j = 0; j < 4; ++j) ss += v[j][0] * v[j][0] + v[j][1] * v[j][1] + v[j][2] * v[j][2] + v[j][3] * v[j][3];
        ss = wave_sum(ss);
        const float rstd = rsqrtf(ss * (1.0f / 1024.0f) + EPSF);
#pragma unroll
        for (int j = 0; j < 4; ++j) { u32x2 w; w.x = pack2bf(v[j][0] * rstd, v[j][1] * rstd); w.y = pack2bf(v[j][2] * rstd, v[j][3] * rstd); *(u32x2*)(XB + (size_t)row * DM + 4 * lane + 256 * j) = w; }
        if (gate_w) {
            float p[16];
#pragma unroll
            for (int jg = 0; jg < 16; ++jg) { float a = 0.f;
#pragma unroll
                for (int j = 0; j < 4; ++j) { const f32x4 w4 = *(const LAS f32x4*)(wg + jg * 1024 + 4 * lane + 256 * j); a += v[j][0] * w4[0] + v[j][1] * w4[1] + v[j][2] * w4[2] + v[j][3] * w4[3]; }
                p[jg] = a; asm volatile("" ::: "memory"); }
            float q8[8], q4[4], q2[2], q1;
            { const bool hi = lane & 32;
#pragma unroll
              for (int j = 0; j < 8; ++j) { const float mine = hi ? p[j + 8] : p[j], oth = hi ? p[j] : p[j + 8]; q8[j] = mine + __shfl_xor(oth, 32); } }
            { const bool hi = lane & 16;
#pragma unroll
              for (int j = 0; j < 4; ++j) { const float mine = hi ? q8[j + 4] : q8[j], oth = hi ? q8[j] : q8[j + 4]; q4[j] = mine + __shfl_xor(oth, 16); } }
            { const bool hi = lane & 8;
#pragma unroll
              for (int j = 0; j < 2; ++j) { const float mine = hi ? q4[j + 2] : q4[j], oth = hi ? q4[j] : q4[j + 2]; q2[j] = mine + __shfl_xor(oth, 8); } }
            { const bool hi = lane & 4; const float mine = hi ? q2[1] : q2[0], oth = hi ? q2[0] : q2[1]; q1 = mine + __shfl_xor(oth, 4); }
            q1 += __shfl_xor(q1, 2); q1 += __shfl_xor(q1, 1);
            if ((lane & 3) == 0) gates[(size_t)row * 16 + (((lane >> 5) & 1) * 8 + ((lane >> 4) & 1) * 4 + ((lane >> 3) & 1) * 2 + ((lane >> 2) & 1))] = q1 * rstd;
        }
    }
    if (gate_w) __syncthreads();
}
__device__ __forceinline__ void phase_pconv(const float* p0, const float* p1, const Ctx& C) {
    bf16_t* PB = (bf16_t*)(C.ws + OFF_PB);
    const size_t n4 = (size_t)T_TOK * 256 / 4, split = (size_t)T_PROMPT * 256 / 4;
#pragma unroll 4
    for (size_t i = (size_t)C.bid * NTHR + C.tid; i < n4; i += (size_t)C.nb * NTHR) {
        const f32x4 v = __builtin_nontemporal_load(i < split ? (const f32x4*)p0 + i : (const f32x4*)p1 + (i - split));
        u32x2 w; w.x = pack2bf(v[0], v[1]); w.y = pack2bf(v[2], v[3]); ((u32x2*)PB)[i] = w;
    }
}
__device__ __forceinline__ void phase_final_norm(float* out, const float* gain, const Ctx& C) {
    const int lane = C.lane, rstep = C.nb * 8;
    f32x4 g4[4], nx[4], ny[4];
#pragma unroll
    for (int j = 0; j < 4; ++j) g4[j] = *(const f32x4*)(gain + 4 * lane + 256 * j);
    { const int row = C.bid * 8 + C.wid; if (row < T_TOK) {
#pragma unroll
        for (int j = 0; j < 4; ++j) nx[j] = __builtin_nontemporal_load((const f32x4*)(out + (size_t)row * DM + 4 * lane + 256 * j)); }
      if (row + rstep < T_TOK) {
#pragma unroll
        for (int j = 0; j < 4; ++j) ny[j] = __builtin_nontemporal_load((const f32x4*)(out + (size_t)(row + rstep) * DM + 4 * lane + 256 * j)); } }
    for (int row = C.bid * 8 + C.wid; row < T_TOK; row += rstep) {
        float* xr = out + (size_t)row * DM;
        f32x4 v[4]; float ss = 0.f;
#pragma unroll
        for (int j = 0; j < 4; ++j) { v[j] = nx[j]; nx[j] = ny[j]; }
        if (row + 2 * rstep < T_TOK) {
#pragma unroll
            for (int j = 0; j < 4; ++j) ny[j] = __builtin_nontemporal_load((const f32x4*)(out + (size_t)(row + 2 * rstep) * DM + 4 * lane + 256 * j)); }
#pragma unroll
        for (int j = 0; j < 4; ++j) ss += v[j][0] * v[j][0] + v[j][1] * v[j][1] + v[j][2] * v[j][2] + v[j][3] * v[j][3];
        ss = wave_sum(ss);
        const float rstd = rsqrtf(ss * (1.0f / 1024.0f) + EPSF);
#pragma unroll
        for (int j = 0; j < 4; ++j) __builtin_nontemporal_store(v[j] * rstd * g4[j], (f32x4*)(xr + 4 * lane + 256 * j));
    }
}

typedef float f32x2 __attribute__((ext_vector_type(2)));
__device__ __forceinline__ f32x2 mk2(float a, float b) { f32x2 r; r.x = a; r.y = b; return r; }
__device__ __forceinline__ int padi(int i) { return i + ((i >> 6) << 2); }
__device__ __forceinline__ f32x2 cmul(f32x2 a, f32x2 b) { return mk2(a.x * b.x - a.y * b.y, a.x * b.y + a.y * b.x); }
__device__ __forceinline__ f32x2 cmulc(f32x2 a, f32x2 b) { return mk2(a.x * b.x + a.y * b.y, a.y * b.x - a.x * b.y); }
template <bool CONJ> __device__ __forceinline__ f32x2 mul_w16(f32x2 a, int j) {
    const float cs[8] = {1.0f, 0.92387953251128674f, 0.70710678118654752f, 0.38268343236508977f, 0.0f, -0.38268343236508977f, -0.70710678118654752f, -0.92387953251128674f};
    const float sn[8] = {0.0f, 0.38268343236508977f, 0.70710678118654752f, 0.92387953251128674f, 1.0f, 0.92387953251128674f, 0.70710678118654752f, 0.38268343236508977f};
    if (j == 0) return a;
    if (j == 4) return CONJ ? mk2(-a.y, a.x) : mk2(a.y, -a.x);
    const f32x2 w = mk2(cs[j], sn[j]);
    return CONJ ? cmul(a, w) : cmulc(a, w);
}
constexpr int bitrev_c(int k, int R) { int r = 0; for (int b = 0; b < R; ++b) if (k & (1 << b)) r |= 1 << (R - 1 - b); return r; }
template <int LOGN, int S_HI, int R, bool INV, bool HALF = false>
__device__ __forceinline__ void fft_pass(LAS f32x2* X, const f32x2* __restrict__ TW, int tid) {
    constexpr int N = 1 << LOGN, S_LO = S_HI - R + 1, NG = N >> R, NK = 1 << R;
#pragma unroll 1
    for (int g = tid; g < NG; g += NTHR) {
        const int low = g & ((1 << S_LO) - 1), high = g >> S_LO, base = (high << (S_HI + 1)) + low;
        f32x2 pw[NK];
        if (S_LO > 0) { float f_ = (float)low * __uint_as_float((unsigned)(126 - S_HI) << 23); asm volatile("" : "+v"(f_)); pw[1] = mk2(__builtin_amdgcn_cosf(f_), -__builtin_amdgcn_sinf(f_));
#pragma unroll
            for (int e = 2; e < NK; ++e) pw[e] = (e & 1) ? cmul(pw[e - 1], pw[1]) : cmul(pw[e >> 1], pw[e >> 1]); }
        f32x2 x[NK];
#pragma unroll
        for (int k = 0; k < NK; ++k) x[k] = (HALF && !INV && k >= NK / 2) ? mk2(0.f, 0.f) : X[padi(base + (k << S_LO))];
        if (!INV) {
#pragma unroll
            for (int st = 0; st < R; ++st) { const int hk = 1 << (R - 1 - st);
#pragma unroll
                for (int k0 = 0; k0 < NK; ++k0) { if (k0 & hk) continue; const int k1 = k0 + hk;
                    const f32x2 a = x[k0], b = x[k1];
                    x[k0] = mk2(a.x + b.x, a.y + b.y);
                    x[k1] = mul_w16<false>(mk2(a.x - b.x, a.y - b.y), (k0 & (hk - 1)) * (8 / hk)); } }
            if (S_LO > 0) {
#pragma unroll
                for (int k = 1; k < NK; ++k) x[k] = cmul(x[k], pw[bitrev_c(k, R)]); }
        } else {
            if (S_LO > 0) {
#pragma unroll
                for (int k = 1; k < NK; ++k) x[k] = cmulc(x[k], pw[bitrev_c(k, R)]); }
#pragma unroll
            for (int st = R - 1; st >= 0; --st) { const int hk = 1 << (R - 1 - st);
#pragma unroll
                for (int k0 = 0; k0 < NK; ++k0) { if (k0 & hk) continue; const int k1 = k0 + hk;
                    const f32x2 a = x[k0], b = mul_w16<true>(x[k1], (k0 & (hk - 1)) * (8 / hk));
                    x[k0] = mk2(a.x + b.x, a.y + b.y);
                    x[k1] = mk2(a.x - b.x, a.y - b.y); } }
        }
#pragma unroll
        for (int k = 0; k < NK; ++k) if (!(HALF && INV && k >= NK / 2)) X[padi(base + (k << S_LO))] = x[k];
    }
    __syncthreads();
}
__device__ __forceinline__ void fft_mid_mul14(LAS f32x2* X, const f32x2* __restrict__ K, int tid) {
    f32x4 kk[8][2];
#pragma unroll
    for (int q = 0; q < 8; ++q) { const int g = tid + NTHR * q; kk[q][0] = *(const f32x4*)(K + 4 * g); kk[q][1] = *(const f32x4*)(K + 4 * g + 2); }
#pragma unroll
    for (int q = 0; q < 8; ++q) { const int g = tid + NTHR * q; LAS f32x2* xp = X + padi(4 * g);
        const f32x4 v01 = *(const LAS f32x4*)xp, v23 = *(const LAS f32x4*)(xp + 2);
        f32x2 x0 = mk2(v01[0], v01[1]), x1 = mk2(v01[2], v01[3]), x2 = mk2(v23[0], v23[1]), x3 = mk2(v23[2], v23[3]);
        { const f32x2 a = x0, b = x2; x0 = mk2(a.x + b.x, a.y + b.y); x2 = mk2(a.x - b.x, a.y - b.y); }
        { const f32x2 a = x1, b = x3; x1 = mk2(a.x + b.x, a.y + b.y); const f32x2 d = mk2(a.x - b.x, a.y - b.y); x3 = mk2(d.y, -d.x); }
        { const f32x2 a = x0, b = x1; x0 = mk2(a.x + b.x, a.y + b.y); x1 = mk2(a.x - b.x, a.y - b.y); }
        { const f32x2 a = x2, b = x3; x2 = mk2(a.x + b.x, a.y + b.y); x3 = mk2(a.x - b.x, a.y - b.y); }
        x0 = cmul(x0, mk2(kk[q][0][0], kk[q][0][1])); x1 = cmul(x1, mk2(kk[q][0][2], kk[q][0][3])); x2 = cmul(x2, mk2(kk[q][1][0], kk[q][1][1])); x3 = cmul(x3, mk2(kk[q][1][2], kk[q][1][3]));
        { const f32x2 a = x0, b = x1; x0 = mk2(a.x + b.x, a.y + b.y); x1 = mk2(a.x - b.x, a.y - b.y); }
        { const f32x2 a = x2, b = x3; x2 = mk2(a.x + b.x, a.y + b.y); x3 = mk2(a.x - b.x, a.y - b.y); }
        { const f32x2 a = x0, b = x2; x0 = mk2(a.x + b.x, a.y + b.y); x2 = mk2(a.x - b.x, a.y - b.y); }
        { const f32x2 a = x1, b = mk2(-x3.y, x3.x); x1 = mk2(a.x + b.x, a.y + b.y); x3 = mk2(a.x - b.x, a.y - b.y); }
        *(LAS f32x4*)xp = (f32x4){x0.x, x0.y, x1.x, x1.y}; *(LAS f32x4*)(xp + 2) = (f32x4){x2.x, x2.y, x3.x, x3.y}; }
    __syncthreads();
}
__device__ __forceinline__ void fft_fwd14_head(LAS f32x2* X, const f32x2* __restrict__ TW, int tid) {
    fft_pass<14, 13, 4, false, true>(X, TW, tid); fft_pass<14, 9, 4, false>(X, TW, tid); fft_pass<14, 5, 4, false>(X, TW, tid);
}
__device__ __forceinline__ void fft_inv14_tail(LAS f32x2* X, const f32x2* __restrict__ TW, int tid) {
    fft_pass<14, 5, 4, true>(X, TW, tid); fft_pass<14, 9, 4, true>(X, TW, tid); fft_pass<14, 13, 4, true, true>(X, TW, tid);
}
template <int LOGN>
__device__ __forceinline__ void fft_fwd(LAS f32x2* X, const f32x2* __restrict__ TW, int tid) {
    if (LOGN == 14) fft_pass<LOGN, 13, 4, false>(X, TW, tid); else fft_pass<LOGN, 12, 3, false>(X, TW, tid);
    fft_pass<LOGN, 9, 4, false>(X, TW, tid); fft_pass<LOGN, 5, 4, false>(X, TW, tid); fft_pass<LOGN, 1, 2, false>(X, TW, tid);
}
template <int LOGN>
__device__ __forceinline__ void fft_inv(LAS f32x2* X, const f32x2* __restrict__ TW, int tid) {
    fft_pass<LOGN, 1, 2, true>(X, TW, tid); fft_pass<LOGN, 5, 4, true>(X, TW, tid); fft_pass<LOGN, 9, 4, true>(X, TW, tid);
    if (LOGN == 14) fft_pass<LOGN, 13, 4, true>(X, TW, tid); else fft_pass<LOGN, 12, 3, true>(X, TW, tid);
}

__device__ __forceinline__ void phase_kspec(const Ctx& C, int l) {
    LAS f32x2* X = (LAS f32x2*)C.lds;
    LAS float* w3s = (LAS float*)(C.lds + 139264);
    const f32x2* TW = (const f32x2*)(C.ws + OFF_TW);
    const float* H2 = (const float*)(C.ws + OFF_H2) + (size_t)l * 8192 * 64;
    f32x2* KS = (f32x2*)(C.ws + OFF_KS);
    const float* w3 = C.in(15) + (size_t)l * 64 * 1024;
    const float* dec = C.in(16) + l * 1024;
    for (int task = C.bid; task < 512; task += C.nb) {
        const int o = task >> 8, ch = task & 255;
        if (C.tid < 128) { const int dir = C.tid >> 6, i = C.tid & 63; w3s[C.tid] = w3[i * 1024 + o * 512 + dir * 256 + ch]; }
        const float dfw = dec[o * 512 + ch], dbw = dec[o * 512 + 256 + ch];
        __syncthreads();
        for (int s = C.tid; s < 8192; s += NTHR) {
            const f32x4* h = (const f32x4*)(H2 + (size_t)s * 64);
            float af = 0.f, ab = 0.f;
            f32x4 hh[16];
#pragma unroll
            for (int i4 = 0; i4 < 16; ++i4) hh[i4] = h[i4];
#pragma unroll
            for (int i4 = 0; i4 < 16; ++i4) { const f32x4 hv = hh[i4];
                af += hv[0] * w3s[4 * i4] + hv[1] * w3s[4 * i4 + 1] + hv[2] * w3s[4 * i4 + 2] + hv[3] * w3s[4 * i4 + 3];
                ab += hv[0] * w3s[64 + 4 * i4] + hv[1] * w3s[64 + 4 * i4 + 1] + hv[2] * w3s[64 + 4 * i4 + 2] + hv[3] * w3s[64 + 4 * i4 + 3]; }
            const float t = (float)s / 8191.0f;
            af *= expf(-t * dfw); ab *= expf(-t * dbw);
            X[padi(s)] = mk2(af, 0.f);
            if (s >= 1) X[padi(16384 - s)] = mk2(ab, 0.f);
        }
        if (C.tid == 0) { float zz = 0.f; asm volatile("" : "+v"(zz)); X[padi(8192)] = mk2(zz, zz); }
        __syncthreads();
        fft_fwd<14>(X, TW, C.tid);
        f32x2* dst = KS + (size_t)(o * 256 + ch) * 16384;
        for (int i = C.tid; i < 16384; i += NTHR) dst[i] = X[padi(i)];
        __syncthreads();
    }
}

__device__ __forceinline__ void unpack8(const u32x4 w, float (&u)[10]) {
    u[1] = __uint_as_float(w.x << 16); u[2] = __uint_as_float(w.x & 0xffff0000u); u[3] = __uint_as_float(w.y << 16); u[4] = __uint_as_float(w.y & 0xffff0000u);
    u[5] = __uint_as_float(w.z << 16); u[6] = __uint_as_float(w.z & 0xffff0000u); u[7] = __uint_as_float(w.w << 16); u[8] = __uint_as_float(w.w & 0xffff0000u);
}
struct Raw8 { u32x4 w; bf16_t pm, pn; };
__device__ __forceinline__ Raw8 load_raw8(const bf16_t* row, int i8) { Raw8 r; r.w = *(const u32x4*)(row + i8); r.pm = row[i8 > 0 ? i8 - 1 : 0]; r.pn = row[i8 + 8 < SEQL ? i8 + 8 : 0]; return r; }
__device__ __forceinline__ void sconv8r(const Raw8& r, int i8, float w0, float w1, float w2, float bias, float (&o)[8]) {
    float u[10];
    unpack8(r.w, u);
    u[0] = i8 > 0 ? bf2f(r.pm) : 0.f;
    u[9] = i8 + 8 < SEQL ? bf2f(r.pn) : 0.f;
#pragma unroll
    for (int e = 0; e < 8; ++e) o[e] = u[e] * w0 + u[e + 1] * w1 + u[e + 2] * w2 + bias;
}
__device__ __forceinline__ void phase_hyena(const Ctx& C, int l) {
    LAS f32x2* X = (LAS f32x2*)C.lds;
    const f32x2* TW = (const f32x2*)(C.ws + OFF_TW);
    const f32x2* KS = (const f32x2*)(C.ws + OFF_KS);
    bf16_t* zB = (bf16_t*)(C.ws + OFF_ZB);
    const float* cw = C.in(8) + l * 3 * 768; const float* cb = C.in(9) + l * 768; const float* skip = C.in(17) + l * 512;
    for (int task = C.bid; task < 5 * 256; task += C.nb) {
        const int pr = task >> 8, c = task & 255;
        const size_t t0 = (size_t)(2 * pr) * SEQL, t1 = t0 + SEQL;
        bf16_t* rv = zB + (size_t)(512 + c) * T_TOK; const bf16_t* rx1 = zB + (size_t)(768 + c) * T_TOK; const bf16_t* rx2 = zB + (size_t)(1024 + c) * T_TOK;
        const f32x2* K0 = KS + (size_t)c * 16384; const f32x2* K1 = KS + (size_t)(256 + c) * 16384;
        f32x4 keep[2][4];
        Raw8 rx[2][2];
        { const float v0 = cw[c], v1 = cw[768 + c], v2 = cw[1536 + c], vb = cb[c];
          Raw8 rw[2][2];
#pragma unroll
          for (int q = 0; q < 2; ++q) { const int i8 = (C.tid + NTHR * q) * 8; rw[q][0] = load_raw8(rv + t0, i8); rw[q][1] = load_raw8(rv + t1, i8); }
#pragma unroll
          for (int q = 0; q < 2; ++q) { const int i8 = (C.tid + NTHR * q) * 8; float va[8], vc[8];
              sconv8r(rw[q][0], i8, v0, v1, v2, vb, va); sconv8r(rw[q][1], i8, v0, v1, v2, vb, vc);
              const int p0 = padi(i8), p1 = padi(i8 + 8192);
#pragma unroll
              for (int e = 0; e < 8; e += 2) { const f32x4 w = (f32x4){va[e], vc[e], va[e + 1], vc[e + 1]};
                  keep[q][e >> 1] = w; *(LAS f32x4*)(X + p0 + e) = w; } } }
        __syncthreads();
        fft_fwd14_head(X, TW, C.tid); fft_mid_mul14(X, K0, C.tid); fft_inv14_tail(X, TW, C.tid);
        { const float a0 = cw[256 + c], a1 = cw[768 + 256 + c], a2 = cw[1536 + 256 + c], abi = cb[256 + c], sk0 = skip[c];
#pragma unroll
          for (int q = 0; q < 2; ++q) { const int i8 = (C.tid + NTHR * q) * 8; rx[q][0] = load_raw8(rx1 + t0, i8); rx[q][1] = load_raw8(rx1 + t1, i8); }
#pragma unroll
          for (int q = 0; q < 2; ++q) { const int i8 = (C.tid + NTHR * q) * 8; float xa[8], xb[8];
              sconv8r(rx[q][0], i8, a0, a1, a2, abi, xa); sconv8r(rx[q][1], i8, a0, a1, a2, abi, xb);
              const int p0 = padi(i8), p1 = padi(i8 + 8192);
#pragma unroll
              for (int e = 0; e < 8; e += 2) { const f32x4 cv = *(const LAS f32x4*)(X + p0 + e), v = keep[q][e >> 1];
                  const f32x4 y = (f32x4){xa[e] * (cv[0] * (1.0f / 16384.0f) + v[0] * sk0), xb[e] * (cv[1] * (1.0f / 16384.0f) + v[1] * sk0),
                                          xa[e + 1] * (cv[2] * (1.0f / 16384.0f) + v[2] * sk0), xb[e + 1] * (cv[3] * (1.0f / 16384.0f) + v[3] * sk0)};
                  keep[q][e >> 1] = y; *(LAS f32x4*)(X + p0 + e) = y; } } }
        __syncthreads();
        fft_fwd14_head(X, TW, C.tid); fft_mid_mul14(X, K1, C.tid); fft_inv14_tail(X, TW, C.tid);
        { const float b0 = cw[512 + c], b1 = cw[768 + 512 + c], b2 = cw[1536 + 512 + c], bbi = cb[512 + c], sk1 = skip[256 + c];
#pragma unroll
          for (int q = 0; q < 2; ++q) { const int i8 = (C.tid + NTHR * q) * 8; rx[q][0] = load_raw8(rx2 + t0, i8); rx[q][1] = load_raw8(rx2 + t1, i8); }
#pragma unroll
          for (int q = 0; q < 2; ++q) { const int i8 = (C.tid + NTHR * q) * 8; float xa[8], xb[8], ya[8], yb[8];
              sconv8r(rx[q][0], i8, b0, b1, b2, bbi, xa); sconv8r(rx[q][1], i8, b0, b1, b2, bbi, xb);
              const int p0 = padi(i8);
#pragma unroll
              for (int e = 0; e < 8; e += 2) { const f32x4 cv = *(const LAS f32x4*)(X + p0 + e), y1 = keep[q][e >> 1];
                  ya[e] = xa[e] * (cv[0] * (1.0f / 16384.0f) + y1[0] * sk1); yb[e] = xb[e] * (cv[1] * (1.0f / 16384.0f) + y1[1] * sk1);
                  ya[e + 1] = xa[e + 1] * (cv[2] * (1.0f / 16384.0f) + y1[2] * sk1); yb[e + 1] = xb[e + 1] * (cv[3] * (1.0f / 16384.0f) + y1[3] * sk1); }
              u32x4 wa, wb; wa.x = pack2bf(ya[0], ya[1]); wa.y = pack2bf(ya[2], ya[3]); wa.z = pack2bf(ya[4], ya[5]); wa.w = pack2bf(ya[6], ya[7]);
              wb.x = pack2bf(yb[0], yb[1]); wb.y = pack2bf(yb[2], yb[3]); wb.z = pack2bf(yb[4], yb[5]); wb.w = pack2bf(yb[6], yb[7]);
              *(u32x4*)(rv + t0 + i8) = wa; *(u32x4*)(rv + t1 + i8) = wb; } }
        __syncthreads();
    }
}

__device__ __forceinline__ void phase_fnet(const Ctx& C) {
    LAS f32x2* X = (LAS f32x2*)C.lds;
    const f32x2* TW = (const f32x2*)(C.ws + OFF_TW);
    bf16_t* zB = (bf16_t*)(C.ws + OFF_ZB);
    for (int task = C.bid; task < NSEQ * 256; task += C.nb) {
        const int b = task >> 8, r = task & 255;
        bf16_t* rp = zB + (size_t)r * T_TOK + (size_t)b * SEQL; const bf16_t* rq = zB + (size_t)(256 + r) * T_TOK + (size_t)b * SEQL;
#pragma unroll 2
        for (int q = 0; q < 2; ++q) { const int i8 = (C.tid + NTHR * q) * 8; float up[10], uq[10];
            unpack8(*(const u32x4*)(rp + i8), up); unpack8(*(const u32x4*)(rq + i8), uq);
            const int p0 = padi(i8);
#pragma unroll
            for (int e = 0; e < 8; e += 2) *(LAS f32x4*)(X + p0 + e) = (f32x4){up[e + 1], uq[e + 1], up[e + 2], uq[e + 2]}; }
        __syncthreads();
        fft_fwd<13>(X, TW, C.tid);
#pragma unroll 1
        for (int q = 0; q < 2; ++q) { const int k8 = (C.tid + NTHR * q) * 8; float y[8];
#pragma unroll
            for (int e = 0; e < 8; ++e) y[e] = X[padi((int)(__brev((unsigned)(k8 + e)) >> 19))].x;
            u32x4 w; w.x = pack2bf(y[0], y[1]); w.y = pack2bf(y[2], y[3]); w.z = pack2bf(y[4], y[5]); w.w = pack2bf(y[6], y[7]);
            *(u32x4*)(rp + k8) = w; }
        __syncthreads();
    }
}

__device__ __forceinline__ void phase_headnorm_cm(const Ctx& C) {
    LAS float* S = (LAS float*)C.lds;
    const bf16_t* zB = (const bf16_t*)(C.ws + OFF_ZB);
    bf16_t* XB = (bf16_t*)(C.ws + OFF_XB);
    for (int task = C.bid; task < T_TOK / 64; task += C.nb) {
        const size_t tok0 = (size_t)task * 64;
#pragma unroll 8
        for (int e = C.tid; e < 512 * 8; e += NTHR) { const int ch = e >> 3, part = e & 7; const int row = ch < 256 ? ch : ch + 256;
            const u32x4 w = *(const u32x4*)(zB + (size_t)row * T_TOK + tok0 + part * 8);
            LAS float* d = S + ch * 68 + part * 8;
            *(LAS f32x4*)d = (f32x4){__uint_as_float(w.x << 16), __uint_as_float(w.x & 0xffff0000u), __uint_as_float(w.y << 16), __uint_as_float(w.y & 0xffff0000u)};
            *(LAS f32x4*)(d + 4) = (f32x4){__uint_as_float(w.z << 16), __uint_as_float(w.z & 0xffff0000u), __uint_as_float(w.w << 16), __uint_as_float(w.w & 0xffff0000u)}; }
        __syncthreads();
        const int tok = C.tid & 63, head = C.tid >> 6;
        float ss = 0.f;
        for (int c = 0; c < 64; ++c) { const float v = S[(head * 64 + c) * 68 + tok]; ss += v * v; }
        const float rstd = rsqrtf(ss * (1.0f / 64.0f) + EPSF);
        bf16_t* dst = XB + (tok0 + tok) * DM + 256 + head * 64;
#pragma unroll 2
        for (int c8 = 0; c8 < 8; ++c8) { u32x4 w; const LAS float* sp = S + (head * 64 + c8 * 8) * 68 + tok;
            w.x = pack2bf(sp[0] * rstd, sp[68] * rstd); w.y = pack2bf(sp[136] * rstd, sp[204] * rstd); w.z = pack2bf(sp[272] * rstd, sp[340] * rstd); w.w = pack2bf(sp[408] * rstd, sp[476] * rstd);
            *(u32x4*)(dst + c8 * 8) = w; }
        __syncthreads();
    }
}

typedef short bf16x8_n __attribute__((ext_vector_type(8)));
__device__ __forceinline__ void phase_na(const Ctx& C, int l) {
    LAS unsigned char* Kb = C.lds;
    LAS unsigned char* VT = C.lds + 65536;
    LAS unsigned char* Qb = C.lds + 131072;
    LAS unsigned char* Pw = Qb + 9216;
    LAS float* Bs = (LAS float*)(Pw + 4 * 2304);
    const bf16_t* zA = (const bf16_t*)(C.ws + OFF_Z);
    bf16_t* XB = (bf16_t*)(C.ws + OFF_XB);
    const float* rpb = C.in(6) + l * 4 * 15 * 31;
    const int lane = C.lane, w = C.wid, jl = lane & 15, quad = lane >> 4;
    const int scol = C.tid >> 3, spart = C.tid & 7;
    for (int task = C.bid; task < NSEQ * 4 * 32; task += C.nb) {
        const int h = task & 3, strip = (task >> 2) & 31, b = task >> 7;
        const bf16_t* zrow = zA + (size_t)b * SEQL * ZA_LD + 64 * h + spart * 8;
        { const int r = 4 * strip, kr0 = min(max(r - 4, 0), 120);
          u32x4 kreg[8], vreg[8];
#pragma unroll
          for (int i = 0; i < 8; ++i) { const bf16_t* src = zrow + (size_t)((kr0 + i) * 64 + scol) * ZA_LD; kreg[i] = *(const u32x4*)(src + 256); vreg[i] = *(const u32x4*)(src + 512); }
          const u32x4 qreg = *(const u32x4*)(zrow + (size_t)(r * 64 + scol) * ZA_LD);
          __syncthreads();
          for (int e = C.tid; e < 15 * 31; e += NTHR) Bs[e] = rpb[h * 465 + e];
          for (int e = C.tid; e < 4 * 2304 / 16; e += NTHR) *(LAS u32x4*)(Pw + e * 16) = (u32x4){0u, 0u, 0u, 0u};
#pragma unroll
          for (int i = 0; i < 8; ++i) { const int slot = (kr0 + i) & 7;
              *(LAS u32x4*)(Kb + slot * 8192 + scol * 128 + ((spart ^ (scol & 7)) * 16)) = kreg[i];
              const unsigned va[4] = {vreg[i].x, vreg[i].y, vreg[i].z, vreg[i].w};
#pragma unroll
              for (int t = 0; t < 8; ++t) { const unsigned hv = (t & 1) ? (va[t >> 1] >> 16) : (va[t >> 1] & 0xffffu);
                  *(LAS bf16_t*)(VT + slot * 8192 + (spart * 8 + t) * 128 + (((scol >> 3) ^ t ^ spart) * 16) + (scol & 7) * 2) = (bf16_t)hv; } }
          *(LAS u32x4*)(Qb + scol * 144 + spart * 16) = qreg; }
#pragma unroll 1
        for (int rr = 0; rr < 4; ++rr) {
            const int r = 4 * strip + rr, kr0 = min(max(r - 4, 0), 120);
            const int krn = min(max(r + 1 - 4, 0), 120); const bool more = rr < 3, newrow = more && (krn != kr0);
            u32x4 nk = (u32x4){0u, 0u, 0u, 0u}, nv = nk, nq = nk;
            if (more) nq = *(const u32x4*)(zrow + (size_t)((r + 1) * 64 + scol) * ZA_LD);
            if (newrow) { const bf16_t* src = zrow + (size_t)((krn + 7) * 64 + scol) * ZA_LD; nk = *(const u32x4*)(src + 256); nv = *(const u32x4*)(src + 512); }
            __syncthreads();
            if (w < 4) {
                const int jt = w, c = 16 * jt + jl, cs = min(max(c - 8, 0), 48);
                const int ct_lo = jt < 2 ? 0 : jt - 1, nct = (jt == 0 || jt == 3) ? 2 : 3;
                bf16x8_n qf[2];
#pragma unroll
                for (int kk = 0; kk < 2; ++kk) qf[kk] = *(const LAS bf16x8_n*)(Qb + c * 144 + kk * 64 + quad * 16);
                f32x4 S[8][3]; float mx = -3.0e38f;
#pragma unroll
                for (int krow = 0; krow < 8; ++krow) { const int slot = (kr0 + krow) & 7; const int brow = (kr0 + krow - r + 7) * 31 - c + 15;
#pragma unroll
                    for (int t = 0; t < 3; ++t) { S[krow][t] = (f32x4){-3.0e38f, -3.0e38f, -3.0e38f, -3.0e38f};
                        if (t < nct) { const int ct = ct_lo + t; f32x4 sa = (f32x4){0.f, 0.f, 0.f, 0.f};
#pragma unroll
                            for (int kk = 0; kk < 2; ++kk) { const bf16x8_n ak = *(const LAS bf16x8_n*)(Kb + slot * 8192 + (16 * ct + jl) * 128 + (((kk * 4 + quad) ^ (jl & 7)) * 16));
                                sa = __builtin_amdgcn_mfma_f32_16x16x32_bf16(ak, qf[kk], sa, 0, 0, 0); }
#pragma unroll
                            for (int i = 0; i < 4; ++i) { const int kc = 16 * ct + 4 * quad + i; const bool valid = (kc >= cs) && (kc < cs + 16);
                                const float bias = Bs[valid ? brow + kc : 0];
                                const float sc = valid ? sa[i] * 0.125f + bias : -3.0e38f; S[krow][t][i] = sc; mx = fmaxf(mx, sc); } } } }
                mx = fmaxf(mx, __shfl_xor(mx, 16)); mx = fmaxf(mx, __shfl_xor(mx, 32));
                float sum = 0.f;
#pragma unroll
                for (int krow = 0; krow < 8; ++krow)
#pragma unroll
                    for (int t = 0; t < 3; ++t)
#pragma unroll
                        for (int i = 0; i < 4; ++i) { const float p = __expf(S[krow][t][i] - mx); S[krow][t][i] = p; sum += p; }
                sum += __shfl_xor(sum, 16); sum += __shfl_xor(sum, 32);
                const float inv = __builtin_amdgcn_rcpf(sum);
                f32x4 oacc[4];
#pragma unroll
                for (int et = 0; et < 4; ++et) oacc[et] = (f32x4){0.f, 0.f, 0.f, 0.f};
                LAS unsigned char* pw = Pw + w * 2304 + jl * 144;
#pragma unroll
                for (int krow = 0; krow < 8; ++krow) { const int slot = (kr0 + krow) & 7;
#pragma unroll
                    for (int t = 0; t < 3; ++t) if (t < nct) { const f32x4 p = S[krow][t] * inv; u32x2 pk; pk.x = pack2bf(p[0], p[1]); pk.y = pack2bf(p[2], p[3]);
                        *(LAS u32x2*)(pw + (16 * (ct_lo + t) + 4 * quad) * 2) = pk; }
                    asm volatile("s_waitcnt lgkmcnt(0)" ::: "memory");
#pragma unroll
                    for (int step = 0; step < 2; ++step) if ((step == 0 && jt != 3) || (step == 1 && jt != 0)) {
                        const bf16x8_n bp = *(const LAS bf16x8_n*)(pw + step * 64 + quad * 16);
#pragma unroll
                        for (int et = 0; et < 4; ++et) { const bf16x8_n av = *(const LAS bf16x8_n*)(VT + slot * 8192 + (16 * et + jl) * 128 + (((step * 4 + quad) ^ (jl & 7) ^ ((2 * et + (jl >> 3)) & 7)) * 16));
                            oacc[et] = __builtin_amdgcn_mfma_f32_16x16x32_bf16(av, bp, oacc[et], 0, 0, 0); } }
                    asm volatile("s_waitcnt lgkmcnt(0)" ::: "memory"); }
                float ss = 0.f;
#pragma unroll
                for (int et = 0; et < 4; ++et) ss += oacc[et][0] * oacc[et][0] + oacc[et][1] * oacc[et][1] + oacc[et][2] * oacc[et][2] + oacc[et][3] * oacc[et][3];
                ss += __shfl_xor(ss, 16); ss += __shfl_xor(ss, 32);
                const float rstd = rsqrtf(ss * (1.0f / 64.0f) + EPSF);
                const size_t tokq = (size_t)b * SEQL + r * 64 + c;
#pragma unroll
                for (int et = 0; et < 4; ++et) { u32x2 ww; ww.x = pack2bf(oacc[et][0] * rstd, oacc[et][1] * rstd); ww.y = pack2bf(oacc[et][2] * rstd, oacc[et][3] * rstd);
                    *(u32x2*)(XB + tokq * DM + 64 * h + 16 * et + 4 * quad) = ww; }
            }
            __syncthreads();
            if (more) *(LAS u32x4*)(Qb + scol * 144 + spart * 16) = nq;
            if (newrow) { const int slot = (krn + 7) & 7;
                *(LAS u32x4*)(Kb + slot * 8192 + scol * 128 + ((spart ^ (scol & 7)) * 16)) = nk;
                const unsigned va[4] = {nv.x, nv.y, nv.z, nv.w};
#pragma unroll
                for (int t = 0; t < 8; ++t) { const unsigned hv = (t & 1) ? (va[t >> 1] >> 16) : (va[t >> 1] & 0xffffu);
                    *(LAS bf16_t*)(VT + slot * 8192 + (spart * 8 + t) * 128 + (((scol >> 3) ^ t ^ spart) * 16) + (scol & 7) * 2) = (bf16_t)hv; } }
        }
    }
    __syncthreads();
}

typedef short bf16x8_t __attribute__((ext_vector_type(8)));
__device__ __forceinline__ float wave_incl_sum(float v, int lane) {
#pragma unroll
    for (int o = 1; o < 64; o <<= 1) { const float t = __shfl_up(v, o); if (lane >= o) v += t; }
    return v;
}
__device__ __forceinline__ float wave_incl_max_up(float v, int lane) {
#pragma unroll
    for (int o = 1; o < 64; o <<= 1) { const float t = __shfl_up(v, o); if (lane >= o) v = fmaxf(v, t); }
    return v;
}
__device__ __forceinline__ float wave_incl_max_down(float v, int lane) {
#pragma unroll
    for (int o = 1; o < 64; o <<= 1) { const float t = __shfl_down(v, o); if (lane + o < 64) v = fmaxf(v, t); }
    return v;
}
__device__ __forceinline__ void mlstm_gates(const Ctx& C, int l, int b, int h, int c, LAS float* lff, LAS float* lfb, LAS float* lif, LAS float* lib) {
    if (C.tid < 128) {
        const float* gates = (const float*)(C.ws + OFF_GATES) + ((size_t)b * SEQL + c * 128 + C.tid) * 16;
        const float* gb = C.in(18) + l * 16;
        lif[C.tid] = gates[h] + gb[h];
        lff[C.tid] = logsigmoidf_(gates[4 + h] + gb[4 + h]);
        lib[C.tid] = gates[8 + h] + gb[8 + h];
        lfb[C.tid] = logsigmoidf_(gates[12 + h] + gb[12 + h]);
    }
}
__device__ __forceinline__ void phase_mlstm_local(const Ctx& C, int l) {
    typedef short bf16x8_l __attribute__((ext_vector_type(8)));
    constexpr int VS = 136;
    LAS bf16_t* VT = (LAS bf16_t*)C.lds;
    LAS bf16_t* KfT = VT + 80 * VS;
    LAS bf16_t* KbT = KfT + 64 * VS;
    LAS float* sm = (LAS float*)(KbT + 64 * VS);
    LAS float* lff = sm, *lfb = sm + 128, *lif = sm + 256, *lib = sm + 384, *wf = sm + 512, *wbk = sm + 640;
    const bf16_t* zA = (const bf16_t*)(C.ws + OFF_Z);
    float* STS = (float*)(C.ws + OFF_STS); float* STN = (float*)(C.ws + OFF_STN); float* STC = (float*)(C.ws + OFF_STC);
    const int lane = C.lane, w = C.wid, jl = lane & 15, quad = lane >> 4;
    for (int task = C.bid; task < NSEQ * 4 * 64; task += C.nb) {
        const int c = task & 63, h = (task >> 6) & 3, b = task >> 8;
        const size_t tok0 = (size_t)b * SEQL + c * 128;
        const size_t sF = (size_t)((0 * 10 + b) * 4 + h) * 64 + c, sB = (size_t)((1 * 10 + b) * 4 + h) * 64 + c;
        mlstm_gates(C, l, b, h, c, lff, lfb, lif, lib);
        for (int e = C.tid; e < 16 * VS; e += NTHR) VT[64 * VS + e] = (e < 128) ? (bf16_t)0x3f80 : (bf16_t)0;
        __syncthreads();
        if (w == 0) { const float a0 = lff[2 * lane], a1 = lff[2 * lane + 1]; const float inc = wave_incl_sum(a0 + a1, lane); const float g = __shfl(inc, 63);
            const float x0 = g - (inc - a1) + lif[2 * lane], x1 = g - inc + lif[2 * lane + 1];
            const float m = wave_max(fmaxf(x0, x1));
            wf[2 * lane] = 0.125f * __expf(x0 - m); wf[2 * lane + 1] = 0.125f * __expf(x1 - m);
            if (lane == 0) { STC[sF * 4 + 0] = m; STC[sF * 4 + 1] = g; } }
        if (w == 1) { const float a0 = lfb[2 * lane], a1 = lfb[2 * lane + 1]; const float inc = wave_incl_sum(a0 + a1, lane); const float g = __shfl(inc, 63);
            const float b0 = g - (inc - a0 - a1), b1 = g - (inc - a1);
            const float x0 = g - b0 + lib[2 * lane], x1 = g - b1 + lib[2 * lane + 1];
            const float m = wave_max(fmaxf(x0, x1));
            wbk[2 * lane] = 0.125f * __expf(x0 - m); wbk[2 * lane + 1] = 0.125f * __expf(x1 - m);
            if (lane == 0) { STC[sB * 4 + 0] = m; STC[sB * 4 + 1] = g; } }
        __syncthreads();
#pragma unroll 2
        for (int e = C.tid; e < 1024; e += NTHR) { const int s = e & 127, part = e >> 7;
            const bf16_t* src = zA + (tok0 + s) * ZA_LD + 64 * h + part * 8;
            const u32x4 kv = *(const u32x4*)(src + 1024), vv = *(const u32x4*)(src + 1280);
            const unsigned ka[4] = {kv.x, kv.y, kv.z, kv.w}, va[4] = {vv.x, vv.y, vv.z, vv.w};
            const float wfs = wf[s], wbs = wbk[s];
#pragma unroll
            for (int i = 0; i < 4; ++i) { const int d0 = part * 8 + 2 * i; const float k0 = __uint_as_float(ka[i] << 16), k1 = __uint_as_float(ka[i] & 0xffff0000u);
                KfT[d0 * VS + s] = f2bf(k0 * wfs); KfT[(d0 + 1) * VS + s] = f2bf(k1 * wfs); KbT[d0 * VS + s] = f2bf(k0 * wbs); KbT[(d0 + 1) * VS + s] = f2bf(k1 * wbs);
                VT[d0 * VS + s] = (bf16_t)(va[i] & 0xffffu); VT[(d0 + 1) * VS + s] = (bf16_t)(va[i] >> 16); } }
        __syncthreads();
        { const int dir = w >> 2, dt = w & 3; const LAS bf16_t* KT = dir ? KbT : KfT; const size_t sD = dir ? sB : sF;
          bf16x8_l kf[4];
#pragma unroll
          for (int kk = 0; kk < 4; ++kk) kf[kk] = *(const LAS bf16x8_l*)(KT + (16 * dt + jl) * VS + kk * 32 + quad * 8);
          const int d = 16 * dt + jl;
#pragma unroll
          for (int et = 0; et < 5; ++et) { f32x4 acc = (f32x4){0.f, 0.f, 0.f, 0.f};
#pragma unroll
              for (int kk = 0; kk < 4; ++kk) { const bf16x8_l av = *(const LAS bf16x8_l*)(VT + (16 * et + jl) * VS + kk * 32 + quad * 8); acc = __builtin_amdgcn_mfma_f32_16x16x32_bf16(av, kf[kk], acc, 0, 0, 0); }
              if (et < 4) *(f32x4*)(STS + sD * 4096 + d * 64 + 16 * et + 4 * quad) = acc;
              else if (quad == 0) STN[sD * 64 + d] = acc[0]; } }
        __syncthreads();
    }
}
__device__ __forceinline__ void phase_mlstm_scan(const Ctx& C) {
    float* STS = (float*)(C.ws + OFF_STS); float* STN = (float*)(C.ws + OFF_STN); float* STC = (float*)(C.ws + OFF_STC);
    for (int idx = C.bid * NTHR + C.tid; idx < 80 * 4160; idx += C.nb * NTHR) {
        const int scan = idx / 4160, e = idx - scan * 4160, dir = scan / 40;
        float* base; int stride;
        if (e < 4096) { base = STS + (size_t)scan * 64 * 4096 + e; stride = 4096; } else { base = STN + (size_t)scan * 64 * 64 + (e - 4096); stride = 64; }
        float* sc = STC + (size_t)scan * 64 * 4;
        float st = 0.f, m = 0.f;
#pragma unroll 1
        for (int s0 = 0; s0 < 64; s0 += 8) {
            float loc[8], ml[8], gg[8];
#pragma unroll
            for (int u = 0; u < 8; ++u) { const int c = dir ? 63 - (s0 + u) : s0 + u; loc[u] = base[(size_t)c * stride]; ml[u] = sc[c * 4 + 0]; gg[u] = sc[c * 4 + 1]; }
#pragma unroll
            for (int u = 0; u < 8; ++u) { const int c = dir ? 63 - (s0 + u) : s0 + u;
                base[(size_t)c * stride] = st; if (e == 0) sc[c * 4 + 2] = m;
                const float mn = fmaxf(gg[u] + m, ml[u]); const float dold = __expf(gg[u] + m - mn), dnew = __expf(ml[u] - mn);
                st = dold * st + dnew * loc[u]; m = mn; }
        }
    }
}
__device__ __forceinline__ void phase_mlstm_out(const Ctx& C, int l) {
    constexpr int QS = 72, VS = 136;
    LAS bf16_t* Qb = (LAS bf16_t*)C.lds;
    LAS bf16_t* Kb = Qb + 128 * QS;
    LAS bf16_t* VT = Kb + 128 * QS;
    LAS bf16_t* SfT = VT + 64 * VS;
    LAS bf16_t* SbT = SfT + 64 * QS;
    LAS bf16_t* Pb = SbT + 64 * QS;
    LAS float* sm = (LAS float*)(Pb + 128 * VS);
    LAS float* lff = sm, *lfb = sm + 128, *lif = sm + 256, *lib = sm + 384, *bfw = sm + 512, *bbw = sm + 640, *cF = sm + 768, *cB = sm + 896,
             *mtF = sm + 1024, *mtB = sm + 1152, *wiF = sm + 1280, *wiB = sm + 1408, *qnF = sm + 1536, *qnB = sm + 1664, *n0f = sm + 1792, *n0b = sm + 1856;
    const bf16_t* zA = (const bf16_t*)(C.ws + OFF_Z);
    bf16_t* XB = (bf16_t*)(C.ws + OFF_XB);
    const float* STS = (const float*)(C.ws + OFF_STS); const float* STN = (const float*)(C.ws + OFF_STN); const float* STC = (const float*)(C.ws + OFF_STC);
    const int lane = C.lane, w = C.wid, jl = lane & 15, quad = lane >> 4;
    for (int task = C.bid; task < NSEQ * 4 * 64; task += C.nb) {
        const int c = task & 63, h = (task >> 6) & 3, b = task >> 8;
        const size_t tok0 = (size_t)b * SEQL + c * 128;
        const size_t sF = (size_t)((0 * 10 + b) * 4 + h) * 64 + c, sB = (size_t)((1 * 10 + b) * 4 + h) * 64 + c;
#pragma unroll 2
        for (int e = C.tid; e < 1024; e += NTHR) { const int s = e & 127, part = e >> 7;
            const bf16_t* src = zA + (tok0 + s) * ZA_LD + 64 * h + part * 8;
            const u32x4 qv = *(const u32x4*)(src + 768), kv = *(const u32x4*)(src + 1024), vv = *(const u32x4*)(src + 1280);
            *(LAS u32x4*)(Qb + s * QS + part * 8) = qv; *(LAS u32x4*)(Kb + s * QS + part * 8) = kv;
            const unsigned va[4] = {vv.x, vv.y, vv.z, vv.w};
#pragma unroll
            for (int i = 0; i < 4; ++i) { VT[(part * 8 + 2 * i) * VS + s] = (bf16_t)(va[i] & 0xffffu); VT[(part * 8 + 2 * i + 1) * VS + s] = (bf16_t)(va[i] >> 16); } }
#pragma unroll 2
        for (int e = C.tid; e < 1024; e += NTHR) { const int d = e & 63, e4 = (e >> 6) * 4;
            const f32x4 f = *(const f32x4*)(STS + sF * 4096 + d * 64 + e4), g = *(const f32x4*)(STS + sB * 4096 + d * 64 + e4);
#pragma unroll
            for (int i = 0; i < 4; ++i) { SfT[(e4 + i) * QS + d] = f2bf(f[i]); SbT[(e4 + i) * QS + d] = f2bf(g[i]); } }
        if (C.tid < 64) n0f[C.tid] = STN[sF * 64 + C.tid]; else if (C.tid < 128) n0b[C.tid - 64] = STN[sB * 64 + C.tid - 64];
        mlstm_gates(C, l, b, h, c, lff, lfb, lif, lib);
        const float m0f = STC[sF * 4 + 2], m0b = STC[sB * 4 + 2];
        __syncthreads();
        if (w == 0) { const float a0 = lff[2 * lane], a1 = lff[2 * lane + 1]; const float inc = wave_incl_sum(a0 + a1, lane);
            const float b0 = inc - a1, b1 = inc; bfw[2 * lane] = b0; bfw[2 * lane + 1] = b1;
            const float c0 = lif[2 * lane] - b0, c1 = lif[2 * lane + 1] - b1; cF[2 * lane] = c0; cF[2 * lane + 1] = c1;
            const float pm = wave_incl_max_up(fmaxf(c0, c1), lane); float pprev = __shfl_up(pm, 1); if (lane == 0) pprev = -3.0e38f;
            const float cm0 = fmaxf(pprev, c0), cm1 = pm;
            const float mf0 = b0 + fmaxf(m0f, cm0), mf1 = b1 + fmaxf(m0f, cm1);
            mtF[2 * lane] = mf0; mtF[2 * lane + 1] = mf1; wiF[2 * lane] = __expf(b0 + m0f - mf0); wiF[2 * lane + 1] = __expf(b1 + m0f - mf1); }
        if (w == 1) { const float a0 = lfb[2 * lane], a1 = lfb[2 * lane + 1]; const float inc = wave_incl_sum(a0 + a1, lane); const float tot = __shfl(inc, 63);
            const float b0 = tot - (inc - a0 - a1), b1 = tot - (inc - a1); bbw[2 * lane] = b0; bbw[2 * lane + 1] = b1;
            const float c0 = lib[2 * lane] - b0, c1 = lib[2 * lane + 1] - b1; cB[2 * lane] = c0; cB[2 * lane + 1] = c1;
            const float pm = wave_incl_max_down(fmaxf(c0, c1), lane); float pnext = __shfl_down(pm, 1); if (lane == 63) pnext = -3.0e38f;
            const float cm0 = pm, cm1 = fmaxf(pnext, c1);
            const float mb0 = b0 + fmaxf(m0b, cm0), mb1 = b1 + fmaxf(m0b, cm1);
            mtB[2 * lane] = mb0; mtB[2 * lane + 1] = mb1; wiB[2 * lane] = __expf(b0 + m0b - mb0); wiB[2 * lane + 1] = __expf(b1 + m0b - mb1); }
        { const int j = C.tid >> 2, part = C.tid & 3; float a = 0.f, a2 = 0.f;
#pragma unroll
          for (int i = 0; i < 16; i += 2) { const unsigned qq = *(const LAS unsigned*)(Qb + j * QS + part * 16 + i);
              const float q0 = __uint_as_float(qq << 16), q1 = __uint_as_float(qq & 0xffff0000u);
              a += q0 * n0f[part * 16 + i] + q1 * n0f[part * 16 + i + 1]; a2 += q0 * n0b[part * 16 + i] + q1 * n0b[part * 16 + i + 1]; }
          a += __shfl_xor(a, 1); a += __shfl_xor(a, 2); a2 += __shfl_xor(a2, 1); a2 += __shfl_xor(a2, 2);
          if (part == 0) { qnF[j] = a; qnB[j] = a2; } }
        __syncthreads();
        const int j = 16 * w + jl;
        bf16x8_t qf[2];
#pragma unroll
        for (int kk = 0; kk < 2; ++kk) qf[kk] = *(const LAS bf16x8_t*)(Qb + j * QS + kk * 32 + quad * 8);
        u32x2 ogate[4];
#pragma unroll
        for (int et = 0; et < 4; ++et) ogate[et] = *(const u32x2*)(zA + (tok0 + j) * ZA_LD + 1536 + 64 * h + 16 * et + 4 * quad);
        f32x4 accF[4], accB[4];
#pragma unroll
        for (int et = 0; et < 4; ++et) { accF[et] = (f32x4){0.f, 0.f, 0.f, 0.f}; accB[et] = (f32x4){0.f, 0.f, 0.f, 0.f};
#pragma unroll
            for (int kk = 0; kk < 2; ++kk) { const bf16x8_t af = *(const LAS bf16x8_t*)(SfT + (16 * et + jl) * QS + kk * 32 + quad * 8), ab = *(const LAS bf16x8_t*)(SbT + (16 * et + jl) * QS + kk * 32 + quad * 8);
                accF[et] = __builtin_amdgcn_mfma_f32_16x16x32_bf16(af, qf[kk], accF[et], 0, 0, 0); accB[et] = __builtin_amdgcn_mfma_f32_16x16x32_bf16(ab, qf[kk], accB[et], 0, 0, 0); } }
        const float ef = bfw[j] - mtF[j], ebk = bbw[j] - mtB[j];
        f32x4 pf[8], pb[8]; float rsf = 0.f, rsb = 0.f;
#pragma unroll
        for (int st = 0; st < 8; ++st) { f32x4 sa = (f32x4){0.f, 0.f, 0.f, 0.f};
#pragma unroll
            for (int kk = 0; kk < 2; ++kk) { const bf16x8_t ak = *(const LAS bf16x8_t*)(Kb + (16 * st + jl) * QS + kk * 32 + quad * 8); sa = __builtin_amdgcn_mfma_f32_16x16x32_bf16(ak, qf[kk], sa, 0, 0, 0); }
            const int s0 = 16 * st + 4 * quad;
            const f32x4 cf4 = *(const LAS f32x4*)(cF + s0), cb4 = *(const LAS f32x4*)(cB + s0);
#pragma unroll
            for (int i = 0; i < 4; ++i) { const int s = s0 + i; const float sv = sa[i] * 0.125f;
                const float x = (s <= j) ? __expf(ef + cf4[i]) * sv : 0.f, y = (s >= j) ? __expf(ebk + cb4[i]) * sv : 0.f;
                pf[st][i] = x; pb[st][i] = y; rsf += x; rsb += y; } }
        rsf += __shfl_xor(rsf, 16); rsf += __shfl_xor(rsf, 32); rsb += __shfl_xor(rsb, 16); rsb += __shfl_xor(rsb, 32);
        const float denF = wiF[j] * qnF[j] + rsf, denB = wiB[j] * qnB[j] + rsb;
        const float rF = __builtin_amdgcn_rcpf(fmaxf(fabsf(denF), __expf(-mtF[j]))), rB = __builtin_amdgcn_rcpf(fmaxf(fabsf(denB), __expf(-mtB[j])));
        const float aF = wiF[j] * rF, aB = wiB[j] * rB;
#pragma unroll
        for (int st = 0; st < 8; ++st) { const f32x4 pc = pf[st] * rF + pb[st] * rB; u32x2 pw; pw.x = pack2bf(pc[0], pc[1]); pw.y = pack2bf(pc[2], pc[3]);
            *(LAS u32x2*)(Pb + j * VS + 16 * st + 4 * quad) = pw; }
        asm volatile("s_waitcnt lgkmcnt(0)" ::: "memory");
        f32x4 oacc[4];
#pragma unroll
        for (int et = 0; et < 4; ++et) { oacc[et] = accF[et] * aF + accB[et] * aB;
#pragma unroll
            for (int kk = 0; kk < 4; ++kk) { const bf16x8_t av = *(const LAS bf16x8_t*)(VT + (16 * et + jl) * VS + kk * 32 + quad * 8), bp = *(const LAS bf16x8_t*)(Pb + j * VS + kk * 32 + quad * 8);
                oacc[et] = __builtin_amdgcn_mfma_f32_16x16x32_bf16(av, bp, oacc[et], 0, 0, 0); } }
        { const size_t tok = tok0 + j; float ss = 0.f; f32x4 val[4];
#pragma unroll
          for (int et = 0; et < 4; ++et) { const u32x2 ow = ogate[et];
              val[et][0] = sigmoidf_(__uint_as_float(ow.x << 16)) * oacc[et][0]; val[et][1] = sigmoidf_(__uint_as_float(ow.x & 0xffff0000u)) * oacc[et][1];
              val[et][2] = sigmoidf_(__uint_as_float(ow.y << 16)) * oacc[et][2]; val[et][3] = sigmoidf_(__uint_as_float(ow.y & 0xffff0000u)) * oacc[et][3];
              ss += val[et][0] * val[et][0] + val[et][1] * val[et][1] + val[et][2] * val[et][2] + val[et][3] * val[et][3]; }
          ss += __shfl_xor(ss, 16); ss += __shfl_xor(ss, 32);
          const float rstd = rsqrtf(ss * (1.0f / 64.0f) + EPSF);
#pragma unroll
          for (int et = 0; et < 4; ++et) { u32x2 ww; ww.x = pack2bf(val[et][0] * rstd, val[et][1] * rstd); ww.y = pack2bf(val[et][2] * rstd, val[et][3] * rstd);
              *(u32x2*)(XB + tok * DM + 768 + 64 * h + 16 * et + 4 * quad) = ww; } }
        __syncthreads();
    }
}

#ifndef NO_MIXERS
#define NO_MIXERS 0
#endif
__device__ __forceinline__ void grid_barrier(unsigned* bar, unsigned target) {
    __syncthreads();
    if (threadIdx.x == 0) {
        __threadfence();
        __hip_atomic_fetch_add(bar, 1u, __ATOMIC_RELAXED, __HIP_MEMORY_SCOPE_AGENT);
        while (__hip_atomic_load(bar, __ATOMIC_RELAXED, __HIP_MEMORY_SCOPE_AGENT) < target) { }
        __threadfence();
    }
    __syncthreads();
}
__global__ void __launch_bounds__(NTHR, 2) mk_fwd(Params P) {
    extern __shared__ __attribute__((aligned(16))) unsigned char lds_raw[];
    cg::grid_group grid = cg::this_grid();
    Ctx C; C.tid = threadIdx.x; C.lane = C.tid & 63; C.wid = __builtin_amdgcn_readfirstlane(C.tid >> 6); C.bid = blockIdx.x; C.nb = gridDim.x; C.lds = (LAS unsigned char*)lds_raw;
    if (C.tid == 0) { LAS unsigned long long* sp = (LAS unsigned long long*)(C.lds + PARAM_OFF);
#pragma unroll
        for (int i = 0; i < 29; ++i) sp[i] = (unsigned long long)P.in[i];
        sp[29] = (unsigned long long)P.out; sp[30] = (unsigned long long)P.ws; }
    __syncthreads();
    unsigned char* ws = C.gptr(30); C.ws = ws;
    bf16_t* XB = (bf16_t*)(ws + OFF_XB);
    bf16_t* zA = (bf16_t*)(ws + OFF_Z);
    bf16_t* zB = (bf16_t*)(ws + OFF_ZB);
    bf16_t* ACT = (bf16_t*)(ws + OFF_Z);
    bf16_t* PROJ = (bf16_t*)(ws + OFF_Z);
    bf16_t* PB = (bf16_t*)(ws + OFF_PB);
    float* out = (float*)C.gptr(29);
#ifndef PROBE_GROUP
#define PROBE_GROUP 0
#endif
    unsigned long long tacc = 0ull, tbeg = 0ull;
#define TB(g) do { if (PROBE_GROUP & (1 << (g))) tbeg = __builtin_amdgcn_s_memrealtime(); } while (0)
#define TE(g) do { if (PROBE_GROUP & (1 << (g))) tacc += __builtin_amdgcn_s_memrealtime() - tbeg; } while (0)

    unsigned* gbar = (unsigned*)(ws + OFF_BAR); unsigned gcount = 0;
    if (C.bid == 0 && C.tid == 0) __hip_atomic_store(gbar, 0u, __ATOMIC_RELAXED, __HIP_MEMORY_SCOPE_AGENT);
#define GSYNC() do { gcount += (unsigned)C.nb; grid_barrier((unsigned*)(C.gptr(30) + OFF_BAR), gcount); } while (0)
    TB(10); phase_prep0a(C);
    phase_norm(C.in(0), C.in(1), C, C.in(5), C.in(4));
    grid.sync();
    phase_weights(C);
#if !NO_MIXERS
    phase_kspec(C, 0);
#endif
    GSYNC(); TE(10);

#define FRESH() do { asm volatile("" : "+s"(l)); { LAS unsigned char* lp_ = (LAS unsigned char*)lds_raw; asm volatile("" : "+s"(lp_)); C.lds = lp_; } asm volatile("" : "+v"(C.tid)); C.lane = C.tid & 63; C.wid = __builtin_amdgcn_readfirstlane(C.tid >> 6); asm volatile("" : "+s"(C.bid), "+s"(C.nb)); ws = C.gptr(30); C.ws = ws; \
        XB = (bf16_t*)(ws + OFF_XB); zA = (bf16_t*)(ws + OFF_Z); zB = (bf16_t*)(ws + OFF_ZB); ACT = zA; PROJ = zA; PB = (bf16_t*)(ws + OFF_PB); out = (float*)C.gptr(29); wb = ws + OFF_W + (size_t)l * W_LAYER; } while (0)
    for (int l = 0; l < 2; ++l) {
        unsigned char* wb = ws + OFF_W + (size_t)l * W_LAYER;
        TB(1); __syncthreads(); FRESH();
        { pg8::Gemm g{XB, (const bf16_t*)(wb + W_INA), T_TOK, ZA_LD, DM}; pg8::StaticOrder S; S.init(T_TOK, ZA_LD, C.nb, C.bid);
          pg8::EpiBf16<0> E{zA, ZA_LD, nullptr, 0, 0}; pg8::gemm_phase<pg8::EpiBf16<0>, pg8::StaticOrder>(C.lds, g, S, E, nullptr); }
        __syncthreads(); FRESH();
        { pg8::Gemm g{(const bf16_t*)(wb + W_INB), XB, ZB_ROWS, T_TOK, DM}; pg8::StaticOrder S; S.init(ZB_ROWS, T_TOK, C.nb, (C.bid + ((T_TOK / 256) * (ZA_LD / 256)) % C.nb) % C.nb);
          pg8::EpiBf16<0> E{zB, T_TOK, nullptr, 0, 0}; pg8::gemm_phase<pg8::EpiBf16<0>, pg8::StaticOrder>(C.lds, g, S, E, nullptr); }
        __syncthreads();
#if !NO_MIXERS
        FRESH(); if (l == 1) phase_kspec(C, 1);
#endif
        GSYNC(); TE(1);
#if !NO_MIXERS
        TB(2); TB(17); FRESH(); phase_mlstm_local(C, l); TE(17);
        TB(11); FRESH(); phase_hyena(C, l); TE(11);
        GSYNC(); TE(2);
        TB(3); TB(14); FRESH(); phase_mlstm_scan(C); TE(14);
        TB(12); FRESH(); phase_fnet(C); TE(12);
        TB(13); FRESH(); phase_na(C, l); TE(13);
        GSYNC(); TE(3);
        TB(4); TB(16); FRESH(); phase_mlstm_out(C, l); TE(16);
        TB(15); FRESH(); phase_headnorm_cm(C); TE(15);
        GSYNC(); TE(4);
#else
        for (size_t i = (size_t)C.bid * NTHR + C.tid; i < (size_t)T_TOK * DM / 8; i += (size_t)C.nb * NTHR) ((u32x4*)XB)[i] = (u32x4){0u, 0u, 0u, 0u};
        GSYNC();
#endif
        TB(5); __syncthreads(); FRESH();
        { pg8::Gemm g{XB, (const bf16_t*)(wb + W_OUT), T_TOK, DM, DM}; pg8::StaticOrder S; S.init(T_TOK, DM, C.nb, C.bid);
          EpiResF32 E{l == 0 ? C.in(0) : out, l == 0 ? C.in(1) : out + (size_t)T_PROMPT * DM, out}; pg8::gemm_phase<EpiResF32, pg8::StaticOrder>(C.lds, g, S, E, nullptr); }
        GSYNC(); TE(5);
        TB(6); FRESH(); phase_norm(out, out + (size_t)T_PROMPT * DM, C, nullptr, nullptr);
        FRESH(); phase_pconv(C.in(2) + (size_t)l * T_PROMPT * 256, C.in(3) + (size_t)l * (T_TOK - T_PROMPT) * 256, C);
        GSYNC(); TE(6);
        TB(7); __syncthreads(); FRESH();
        { pg8::Gemm g{XB, (const bf16_t*)(wb + W_GU), T_TOK, 2 * DFF, DM}; pg8::StaticOrder S; S.init(T_TOK, 2 * DFF, C.nb, C.bid);
          EpiSwiGLU E{ACT}; pg8::gemm_phase<EpiSwiGLU, pg8::StaticOrder>(C.lds, g, S, E, nullptr); }
        GSYNC(); TE(7);
        TB(8); __syncthreads(); FRESH();
        { pg8::Gemm g{ACT, (const bf16_t*)(wb + W_DOWN), T_TOK, DM, DFF}; pg8::StaticOrder S; S.init(T_TOK, DM, C.nb, C.bid);
          EpiResF32 E{out, out + (size_t)T_PROMPT * DM, out}; pg8::gemm_phase<EpiResF32, pg8::StaticOrder>(C.lds, g, S, E, nullptr); }
        GSYNC(); TE(8);
        TB(6); FRESH(); phase_norm(out, out + (size_t)T_PROMPT * DM, C, nullptr, nullptr); TE(6);
        TB(9); __syncthreads(); FRESH();
        { pg8::Gemm g{PB, (const bf16_t*)(wb + W_PP), T_TOK, DM, 256}; pg8::StaticOrder S; S.init(T_TOK, DM, C.nb, C.bid);
          pg8::EpiBf16<0> E{PROJ, DM, nullptr, 0, 0}; pg8::gemm_phase<pg8::EpiBf16<0>, pg8::StaticOrder>(C.lds, g, S, E, nullptr); }
        GSYNC();
        __syncthreads(); FRESH();
        { pg8::Gemm g{XB, (const bf16_t*)(wb + W_PG), T_TOK, DM, DM}; pg8::StaticOrder S; S.init(T_TOK, DM, C.nb, C.bid);
          EpiPle E{out, PROJ}; pg8::gemm_phase<EpiPle, pg8::StaticOrder>(C.lds, g, S, E, nullptr); }
        GSYNC(); TE(9);
        TB(6); FRESH();
        if (l == 0) { phase_norm(out, out + (size_t)T_PROMPT * DM, C, C.in(5) + (size_t)DM * NIN, C.in(4) + DM); GSYNC(); }
        else phase_final_norm(out, C.in(28), C);
        TE(6);
    }
#if PROBE_GROUP
    if (C.bid == 0) { if (C.tid == 0) { const unsigned long long t0 = __builtin_amdgcn_s_memrealtime(); while (__builtin_amdgcn_s_memrealtime() - t0 < tacc) __builtin_amdgcn_s_sleep(8); } __syncthreads(); }
#endif
}

extern "C" void kernel_launch(void* const* d_in, const int* in_sizes, int n_in, void* d_out, int out_size, void* d_ws, size_t ws_size, hipStream_t stream) {
    static int grid_blocks = 0;
    if (grid_blocks == 0) {
        if (n_in != 29 || ws_size < WS_END) { fprintf(stderr, "kernel_launch: unexpected n_in %d or workspace %zu < %zu\n", n_in, ws_size, (size_t)WS_END); grid_blocks = -1; return; }
        int dev = 0, cus = 0, per_cu = 0;
        hipGetDevice(&dev);
        hipDeviceGetAttribute(&cus, hipDeviceAttributeMultiprocessorCount, dev);
        if (hipFuncSetAttribute((const void*)mk_fwd, hipFuncAttributeMaxDynamicSharedMemorySize, LDS_BYTES) != hipSuccess) { fprintf(stderr, "kernel_launch: hipFuncSetAttribute failed\n"); grid_blocks = -1; return; }
        if (hipOccupancyMaxActiveBlocksPerMultiprocessor(&per_cu, (const void*)mk_fwd, NTHR, LDS_BYTES) != hipSuccess || per_cu < 1) { fprintf(stderr, "kernel_launch: occupancy query says %d\n", per_cu); per_cu = 1; }
        (void)hipGetLastError();
        grid_blocks = cus * per_cu;
    }
    if (grid_blocks < 0) return;
    Params p{};
    for (int i = 0; i < 29; ++i) p.in[i] = (const float*)d_in[i];
    p.out = (float*)d_out; p.ws = (unsigned char*)d_ws;
    void* args[] = {&p};
    hipError_t e = hipLaunchCooperativeKernel((const void*)mk_fwd, dim3(grid_blocks), dim3(NTHR), args, LDS_BYTES, stream);
    if (e != hipSuccess) fprintf(stderr, "cooperative launch failed: %s (grid %d)\n", hipGetErrorString(e), grid_blocks);
}
```

```cpp
#include <hip/hip_runtime.h>
#include <hip/hip_cooperative_groups.h>
#include <cstdio>
namespace cg = cooperative_groups;
namespace pg8 {
#define PG8_LAS __attribute__((address_space(3)))
typedef unsigned short bf16_t;
typedef short bf16x8 __attribute__((ext_vector_type(8)));
typedef float f32x4 __attribute__((ext_vector_type(4)));
typedef unsigned u32x4 __attribute__((ext_vector_type(4)));
constexpr int BM = 256, BK = 64, HALF = 128, HTB = HALF * BK * 2  , STAGE_BYTES = 8 * HTB, NXCD = 8, WGM = 8;

__host__ __device__ __forceinline__ int lds_byte(int r, int c) { const int st = (r >> 4) * 2 + (c >> 5), rr = r & 15, cc = c & 31, ob = rr * 64 + cc * 2; return st * 1024 + (ob ^ (((ob >> 9) & 1) << 5)); }
__host__ __device__ __forceinline__ void stage_rc(int b, int& R, int& C) { const int st = b / 1024, sb = b % 1024, swz = sb ^ (((sb >> 9) & 1) << 5); R = (st >> 1) * 16 + swz / 64; C = (st & 1) * 32 + (swz % 64) / 2; }
__host__ __device__ __forceinline__ int perm32(int rho) { const int n = rho >> 4, i = rho & 15; return 8 * (i >> 2) + 4 * n + (i & 3); }

struct Unit { int pm, pn; };
struct Gemm { const bf16_t* A; const bf16_t* Bt; int M, N, K; };

struct StaticOrder {
    int nM, nN, nwg, G, c;
    __host__ __device__ void init(int M, int N, int G_, int c_) { nM = M / BM; nN = N / BM; nwg = nM * nN; G = G_; c = c_; }
    __host__ __device__ bool next(int i, Unit& u) const {
        const long L = (long)i * G + c; if (L >= nwg) return false;
        int wgid = (int)L; { const int q = nwg / NXCD, r = nwg % NXCD, xcd = wgid % NXCD, off = wgid / NXCD; wgid = (xcd < r ? xcd * (q + 1) : r * (q + 1) + (xcd - r) * q) + off; }
        const int nig = WGM * nN, gid = wgid / nig, fm = gid * WGM, gsz = (nM - fm) < WGM ? (nM - fm) : WGM;
        u.pm = fm + ((wgid % nig) % gsz); u.pn = (wgid % nig) / gsz; return true;
    }
    __device__ __forceinline__ void a_ready(const Unit&) const {}
    __device__ __forceinline__ void done(const Unit&) const {}
};
struct CountedOrder : StaticOrder {
    const unsigned* ready; unsigned need; unsigned* tmo;
    __device__ __forceinline__ void a_ready(const Unit& u) const {
        if (threadIdx.x < 64) {
            const unsigned long long t0 = __builtin_amdgcn_s_memrealtime(); unsigned polls = 0;
            while ((unsigned)__builtin_amdgcn_readfirstlane(__hip_atomic_load(ready + 64 * u.pm, __ATOMIC_RELAXED, __HIP_MEMORY_SCOPE_AGENT)) < need) {
                if ((++polls & 255u) == 0u && __builtin_amdgcn_readfirstlane(__hip_atomic_load(tmo, __ATOMIC_RELAXED, __HIP_MEMORY_SCOPE_AGENT)) != 0u) break;
                if (__builtin_amdgcn_s_memrealtime() - t0 > 2000000ull) {
                    if (threadIdx.x == 0) { unsigned expect = 0u; __hip_atomic_compare_exchange_strong(tmo + 1, &expect, 0x600u | (unsigned)(u.pm & 0xff), __ATOMIC_RELAXED, __ATOMIC_RELAXED, __HIP_MEMORY_SCOPE_AGENT); __hip_atomic_store(tmo, 1u, __ATOMIC_RELAXED, __HIP_MEMORY_SCOPE_AGENT); }
                    break; }
                __builtin_amdgcn_s_sleep(2); }
            __builtin_amdgcn_fence(__ATOMIC_ACQUIRE, "agent");
            asm volatile("s_waitcnt vmcnt(0)" ::: "memory");
        }
#if !defined(BROKEN_HOOK_NO_BARRIER)
        asm volatile("" ::: "memory"); __builtin_amdgcn_s_barrier(); asm volatile("" ::: "memory");
#endif
    }
};

__device__ __forceinline__ unsigned cvt_pk_bf16(float lo, float hi) { unsigned r; asm volatile("v_cvt_pk_bf16_f32 %0, %1, %2" : "=v"(r) : "v"(lo), "v"(hi)); return r; }
typedef float f32x2 __attribute__((ext_vector_type(2)));
__device__ __forceinline__ f32x2 gelu_pk(f32x2 v) {
    const f32x2 av = __builtin_elementwise_abs(v), d = av * 0.2316418882f + 1.0f;
    f32x2 t; t.x = __builtin_amdgcn_rcpf(d.x); t.y = __builtin_amdgcn_rcpf(d.y);
    f32x2 q = t * 0.5307027145f + (-0.7265760135f); q = q * t + 0.7107068705f; q = q * t + (-0.142248368f); q = q * t + 0.127414796f; q = q * t;
    const f32x2 s = (v * v) * (-0.72134752044f);
    f32x2 e; e.x = __builtin_amdgcn_exp2f(s.x); e.y = __builtin_amdgcn_exp2f(s.y);
    const f32x2 m = v * (q * e), r = v - m;
    f32x2 o; o.x = v.x < 0.f ? m.x : r.x; o.y = v.y < 0.f ? m.y : r.y; return o;
}

struct EpiF32 {
    static constexpr bool PERM = false, AFTER_DRAIN = false;
    float* C; int ldc; const float* bias;
    __device__ __forceinline__ void operator()(const f32x4 (&acc)[2][2][4][2], const Unit& u, int wr, int wc, int fr, int fq) const {
        const int row0 = u.pm * BM + wr * 64 + fr, col0 = u.pn * BM + wc * 32 + 4 * fq;
        f32x4 bv[2][2];
#pragma unroll
        for (int bj = 0; bj < 2; ++bj)
#pragma unroll
            for (int n = 0; n < 2; ++n) bv[bj][n] = bias ? *(const f32x4*)(bias + col0 + bj * HALF + n * 16) : (f32x4){0.f, 0.f, 0.f, 0.f};
#pragma unroll
        for (int ai = 0; ai < 2; ++ai)
#pragma unroll
            for (int m = 0; m < 4; ++m) { float* rowp = C + (size_t)(row0 + ai * HALF + m * 16) * ldc + col0;
#pragma unroll
                for (int bj = 0; bj < 2; ++bj)
#pragma unroll
                    for (int n = 0; n < 2; ++n) *(f32x4*)(rowp + bj * HALF + n * 16) = acc[ai][bj][m][n] + bv[bj][n]; }
    }
};
template <int ACT  > struct EpiBf16 {
    static constexpr bool PERM = true, AFTER_DRAIN = false;
    bf16_t* O; int ldc; const float* bias; int split_cols; size_t split_stride;
    __device__ __forceinline__ void operator()(const f32x4 (&acc)[2][2][4][2], const Unit& u, int wr, int wc, int fr, int fq) const {
        const int row0 = u.pm * BM + wr * 64 + fr; int colt = u.pn * BM; bf16_t* base = O;
        if (split_cols) { const int t = colt / split_cols; base += (size_t)t * split_stride; colt -= t * split_cols; }
        const int col0 = colt + wc * 32 + 8 * fq, bcol0 = u.pn * BM + wc * 32 + 8 * fq;
        f32x4 bv[2][2];
#pragma unroll
        for (int bj = 0; bj < 2; ++bj)
#pragma unroll
            for (int n = 0; n < 2; ++n) bv[bj][n] = bias ? *(const f32x4*)(bias + bcol0 + bj * HALF + 4 * n) : (f32x4){0.f, 0.f, 0.f, 0.f};
#pragma unroll
        for (int ai = 0; ai < 2; ++ai)
#pragma unroll
            for (int m = 0; m < 4; ++m) { bf16_t* rowp = base + (size_t)(row0 + ai * HALF + m * 16) * ldc + col0;
#pragma unroll
                for (int bj = 0; bj < 2; ++bj) { f32x4 v0 = acc[ai][bj][m][0] + bv[bj][0], v1 = acc[ai][bj][m][1] + bv[bj][1];
                    if (ACT == 1) { f32x2 a = gelu_pk((f32x2){v0[0], v0[1]}), b = gelu_pk((f32x2){v0[2], v0[3]}), c = gelu_pk((f32x2){v1[0], v1[1]}), d = gelu_pk((f32x2){v1[2], v1[3]});
                        v0 = (f32x4){a.x, a.y, b.x, b.y}; v1 = (f32x4){c.x, c.y, d.x, d.y}; }
                    if (ACT == 2) {
#pragma unroll
                        for (int j = 0; j < 4; ++j) { v0[j] = 0.5f * v0[j] * (1.0f + erff(v0[j] * 0.70710678f)); v1[j] = 0.5f * v1[j] * (1.0f + erff(v1[j] * 0.70710678f)); } }
                    u32x4 w; w.x = cvt_pk_bf16(v0[0], v0[1]); w.y = cvt_pk_bf16(v0[2], v0[3]); w.z = cvt_pk_bf16(v1[0], v1[1]); w.w = cvt_pk_bf16(v1[2], v1[3]);
                    *(u32x4*)(rowp + bj * HALF) = w; } }
    }
};
template <class Epi, class Sched, bool STAMP = false>
__device__ __forceinline__ void gemm_phase(PG8_LAS unsigned char* lds, const Gemm g, const Sched& S, const Epi& E, unsigned long long* stamps) {
    int tid_ = threadIdx.x; asm volatile("" : "+v"(tid_)); const int tid = tid_, wid = __builtin_amdgcn_readfirstlane(tid >> 6), lane = tid & 63, wr = wid >> 2, wc = wid & 3, fr = lane & 15, fq = lane >> 4;
    const int K = g.K, nt = K / BK;
    int ts_lo = 0, ts_hi = 0, nts = 0; const unsigned long long rt_entry = STAMP ? (unsigned long long)wall_clock64() : 0ull;
#define PG8_STAMP() do { if (STAMP && wid == 0 && nts < 64) { const unsigned long long _c = (unsigned long long)clock64(); \
        ts_lo = (lane == nts) ? (int)(unsigned)_c : ts_lo; ts_hi = (lane == nts) ? (int)(unsigned)(_c >> 32) : ts_hi; ++nts; } } while (0)
    PG8_STAMP();
    unsigned voffA[2], voffB[2];
#pragma unroll
    for (int i = 0; i < 2; ++i) { int R, C; stage_rc(tid * 16 + i * 8192, R, C); const int Rb = Epi::PERM ? ((R & ~31) + perm32(R & 31)) : R;
        voffA[i] = (unsigned)(R * K + C) * 2u; voffB[i] = (unsigned)(Rb * K + C) * 2u; }
    const size_t kstep = (size_t)(BK * 2);
    const size_t hstep = (size_t)HALF * K * 2;
    const size_t tstep = 2 * hstep;
    const unsigned ldsw = (unsigned)wid * 1024u;
    const int aoff = lds_byte(wr * 64 + fr, fq * 8), boff = lds_byte(wc * 32 + fr, fq * 8);
#define PG8_SA(b, h) (((b) * 2 + (h)) * HTB)
#define PG8_SB(b, h) ((4 + (b) * 2 + (h)) * HTB)
#define PG8_STAGE(bufoff, gbase, voff) do { _Pragma("unroll") for (int _i = 0; _i < 2; ++_i) \
        __builtin_amdgcn_global_load_lds((const unsigned*)((const char*)(gbase) + (voff)[_i]), (PG8_LAS unsigned*)(lds + (bufoff) + ldsw + _i * 8192), 16, 0, 0); } while (0)
#define PG8_LDA(dst, b, h) do { _Pragma("unroll") for (int m = 0; m < 4; ++m) _Pragma("unroll") for (int k = 0; k < 2; ++k) dst[m][k] = *(const PG8_LAS bf16x8*)(lds + PG8_SA(b, h) + aoff + m * 2048 + k * 1024); } while (0)
#define PG8_LDB(dst, b, h) do { _Pragma("unroll") for (int n = 0; n < 2; ++n) _Pragma("unroll") for (int k = 0; k < 2; ++k) dst[n][k] = *(const PG8_LAS bf16x8*)(lds + PG8_SB(b, h) + boff + n * 2048 + k * 1024); } while (0)
#define PG8_MMA(ai, bj, At, Bt) do { __builtin_amdgcn_s_setprio(1); _Pragma("unroll") for (int m = 0; m < 4; ++m) _Pragma("unroll") for (int n = 0; n < 2; ++n) _Pragma("unroll") for (int k = 0; k < 2; ++k) \
        acc[ai][bj][m][n] = __builtin_amdgcn_mfma_f32_16x16x32_bf16(Bt[n][k], At[m][k], acc[ai][bj][m][n], 0, 0, 0); __builtin_amdgcn_s_setprio(0); } while (0)
#define PG8_WAIT_V(n) asm volatile("s_waitcnt vmcnt(" #n ")" ::: "memory")
#define PG8_WAIT_L(n) asm volatile("s_waitcnt lgkmcnt(" #n ")" ::: "memory")
#define PG8_BAR __builtin_amdgcn_s_barrier()
#define PG8_SCHED __builtin_amdgcn_sched_barrier(0)
    Unit cur, nxt; int ui = 0;
    if (!S.next(0, cur)) return;
    f32x4 acc[2][2][4][2];
#pragma unroll
    for (int a = 0; a < 2; ++a)
#pragma unroll
        for (int b = 0; b < 2; ++b)
#pragma unroll
            for (int m = 0; m < 4; ++m)
#pragma unroll
                for (int n = 0; n < 2; ++n) acc[a][b][m][n] = (f32x4){0.f, 0.f, 0.f, 0.f};
    bf16x8 At[4][2], B0[2][2], B1[2][2];
    const char* cA = (const char*)g.A + (size_t)cur.pm * tstep; const char* cB = (const char*)g.Bt + (size_t)cur.pn * tstep;
    S.a_ready(cur);
    PG8_STAGE(PG8_SB(0, 0), cB, voffB); PG8_STAGE(PG8_SA(0, 0), cA, voffA); PG8_STAGE(PG8_SB(0, 1), cB + hstep, voffB); PG8_STAGE(PG8_SA(0, 1), cA + hstep, voffA);
    if (wr == 1) PG8_BAR;
    PG8_WAIT_V(4); PG8_BAR;
    PG8_STAGE(PG8_SB(1, 0), cB + kstep, voffB); PG8_STAGE(PG8_SA(1, 0), cA + kstep, voffA); PG8_STAGE(PG8_SB(1, 1), cB + hstep + kstep, voffB);
    PG8_WAIT_V(6); PG8_BAR;
    PG8_STAMP();
    for (;;) {
        const bool has_next = S.next(ui + 1, nxt);
        const char* nA = has_next ? (const char*)g.A + (size_t)nxt.pm * tstep : cA; const char* nB = has_next ? (const char*)g.Bt + (size_t)nxt.pn * tstep : cB;
        for (int t = 0; t < nt; t += 2) {
            const bool last = (t == nt - 2);
            const char* a1 = cA + (size_t)(t + 1) * kstep;
            const char* a2 = last ? nA : cA + (size_t)(t + 2) * kstep; const char* b2 = last ? nB : cB + (size_t)(t + 2) * kstep;
            const char* a3 = a2 + kstep; const char* b3 = b2 + kstep;
            if (last && has_next) S.a_ready(nxt);
            PG8_LDB(B0, 0, 0); PG8_SCHED; PG8_LDA(At, 0, 0); PG8_STAGE(PG8_SA(1, 1), a1 + hstep, voffA);
            PG8_WAIT_L(8); PG8_BAR; PG8_WAIT_L(0); PG8_MMA(0, 0, At, B0); PG8_BAR; PG8_SCHED;
            PG8_LDB(B1, 0, 1); PG8_STAGE(PG8_SB(0, 0), b2, voffB);
            PG8_BAR; PG8_WAIT_L(0); PG8_MMA(0, 1, At, B1); PG8_BAR;
            PG8_LDA(At, 0, 1); PG8_STAGE(PG8_SA(0, 0), a2, voffA);
            PG8_BAR; PG8_WAIT_L(0); PG8_MMA(1, 0, At, B0); PG8_BAR; PG8_SCHED;
            PG8_STAGE(PG8_SB(0, 1), b2 + hstep, voffB);
            PG8_WAIT_V(6); PG8_BAR; PG8_MMA(1, 1, At, B1); PG8_BAR;
            PG8_LDB(B0, 1, 0); PG8_SCHED; PG8_LDA(At, 1, 0); PG8_STAGE(PG8_SA(0, 1), a2 + hstep, voffA);
            PG8_WAIT_L(8); PG8_BAR; PG8_WAIT_L(0); PG8_MMA(0, 0, At, B0); PG8_BAR; PG8_SCHED;
            PG8_LDB(B1, 1, 1); PG8_STAGE(PG8_SB(1, 0), b3, voffB);
            PG8_BAR; PG8_WAIT_L(0); PG8_MMA(0, 1, At, B1); PG8_BAR;
            PG8_LDA(At, 1, 1); PG8_STAGE(PG8_SA(1, 0), a3, voffA);
            PG8_BAR; PG8_WAIT_L(0); PG8_MMA(1, 0, At, B0); PG8_BAR; PG8_SCHED;
            PG8_STAGE(PG8_SB(1, 1), b3 + hstep, voffB);
            PG8_WAIT_V(6); PG8_BAR; PG8_MMA(1, 1, At, B1); PG8_BAR;
        }
        PG8_STAMP();
        if constexpr (!Epi::AFTER_DRAIN) { E(acc, cur, wr, wc, fr, fq); S.done(cur); }
        PG8_STAMP();
        if (!has_next) break;
#pragma unroll
        for (int a = 0; a < 2; ++a)
#pragma unroll
            for (int b = 0; b < 2; ++b)
#pragma unroll
                for (int m = 0; m < 4; ++m)
#pragma unroll
                    for (int n = 0; n < 2; ++n) acc[a][b][m][n] = (f32x4){0.f, 0.f, 0.f, 0.f};
        cur = nxt; cA = nA; cB = nB; ++ui;
    }
    PG8_WAIT_V(0);
    if (wr == 0) PG8_BAR;
    PG8_BAR;
    if constexpr (Epi::AFTER_DRAIN) { E.fused(acc, cur, wr, wc, fr, fq, lds, wid, lane); S.done(cur); }
    PG8_STAMP();
    if (STAMP && wid == 0) { stamps[lane] = lane < nts ? (((unsigned long long)(unsigned)ts_hi << 32) | (unsigned)ts_lo) : 0ull;
        if (lane == 62) stamps[62] = rt_entry; if (lane == 63) stamps[63] = (unsigned long long)wall_clock64(); }
#undef PG8_STAMP
#undef PG8_SA
#undef PG8_SB
#undef PG8_STAGE
#undef PG8_LDA
#undef PG8_LDB
#undef PG8_MMA
#undef PG8_WAIT_V
#undef PG8_WAIT_L
#undef PG8_BAR
#undef PG8_SCHED
}
}

typedef unsigned short bf16_t;
typedef float f32x4 __attribute__((ext_vector_type(4)));
typedef unsigned u32x4 __attribute__((ext_vector_type(4)));
typedef unsigned u32x2 __attribute__((ext_vector_type(2)));
#define LAS __attribute__((address_space(3)))

constexpr int T_TOK = 81920, T_PROMPT = 16384, SEQL = 8192, NSEQ = 10, DM = 1024, DFF = 2816, NIN = 2832;
constexpr int ZA_LD = 1792;
constexpr int ZB_ROWS = 1280;
constexpr float EPSF = 1e-6f;
constexpr int NTHR = 512;
constexpr int LDS_BYTES = 152 * 1024;

constexpr size_t al256(size_t x) { return (x + 255) & ~(size_t)255; }
constexpr size_t OFF_TW = 0;
constexpr size_t OFF_H2 = OFF_TW + 8192 * 8;
constexpr size_t OFF_FAB = OFF_H2 + (size_t)2 * 8192 * 64 * 4;
constexpr size_t OFF_W = OFF_FAB + (size_t)2 * 4 * 2 * 4096 * 4;
constexpr size_t W_INA = 0;
constexpr size_t W_INB = W_INA + (size_t)1792 * 1024 * 2;
constexpr size_t W_OUT = W_INB + (size_t)1280 * 1024 * 2;
constexpr size_t W_GU = W_OUT + (size_t)1024 * 1024 * 2;
constexpr size_t W_DOWN = W_GU + (size_t)5632 * 1024 * 2;
constexpr size_t W_PG = W_DOWN + (size_t)1024 * 2816 * 2;
constexpr size_t W_PP = W_PG + (size_t)1024 * 1024 * 2;
constexpr size_t W_LAYER = W_PP + (size_t)1024 * 256 * 2;
constexpr size_t OFF_KS = OFF_W + 2 * W_LAYER;
constexpr size_t OFF_XB = OFF_KS + (size_t)2 * 256 * 16384 * 8;
constexpr size_t OFF_GATES = OFF_XB + (size_t)T_TOK * 1024 * 2;
constexpr size_t OFF_PB = OFF_GATES + (size_t)T_TOK * 16 * 4;
constexpr size_t OFF_STS = OFF_PB + (size_t)T_TOK * 256 * 2;
constexpr size_t OFF_STN = OFF_STS + (size_t)80 * 64 * 4096 * 4;
constexpr size_t OFF_STC = OFF_STN + (size_t)80 * 64 * 64 * 4;
constexpr size_t OFF_Z = al256(OFF_STC + (size_t)80 * 64 * 4 * 4);
constexpr size_t OFF_ZB = OFF_Z + (size_t)T_TOK * ZA_LD * 2;
constexpr size_t OFF_SCR = OFF_ZB + (size_t)ZB_ROWS * T_TOK * 2;
constexpr size_t OFF_BAR = OFF_SCR + (size_t)256 * 8192 * 8;
constexpr size_t WS_END = OFF_BAR + 256;

struct Params { const float* in[29]; float* out; unsigned char* ws; };

__device__ __forceinline__ bf16_t f2bf(float f) { unsigned u = __float_as_uint(f); u += 0x7FFFu + ((u >> 16) & 1u); return (bf16_t)(u >> 16); }
__device__ __forceinline__ float bf2f(bf16_t b) { return __uint_as_float(((unsigned)b) << 16); }
__device__ __forceinline__ unsigned pack2bf(float lo, float hi) { unsigned r; asm("v_cvt_pk_bf16_f32 %0, %1, %2" : "=v"(r) : "v"(lo), "v"(hi)); return r; }
__device__ __forceinline__ float wave_sum(float v) {
#pragma unroll
    for (int o = 32; o >= 1; o >>= 1) v += __shfl_xor(v, o);
    return v;
}
__device__ __forceinline__ float wave_max(float v) {
#pragma unroll
    for (int o = 32; o >= 1; o >>= 1) v = fmaxf(v, __shfl_xor(v, o));
    return v;
}
__device__ __forceinline__ float sigmoidf_(float x) { return __builtin_amdgcn_rcpf(1.0f + __expf(-x)); }
__device__ __forceinline__ float logsigmoidf_(float x) { return x >= 0.f ? -log1pf(expf(-x)) : x - log1pf(expf(x)); }
__device__ __forceinline__ const float* xrow_ptr(const float* x0, const float* x1, int row) { return row < T_PROMPT ? x0 + (size_t)row * DM : x1 + (size_t)(row - T_PROMPT) * DM; }

struct EpiResF32 {
    static constexpr bool PERM = true, AFTER_DRAIN = false;
    const float* b0; const float* b1; float* out;
    __device__ __forceinline__ void operator()(const pg8::f32x4 (&acc)[2][2][4][2], const pg8::Unit& u, int wr, int wc, int fr, int fq) const {
        const int row0 = u.pm * 256 + wr * 64 + fr, col0 = u.pn * 256 + wc * 32 + 8 * fq;
        const float* base = (u.pm * 256 < T_PROMPT) ? b0 : b1 - (size_t)T_PROMPT * DM;
        f32x4 bs[4][4];
#define ERF_LOAD(g) do { const unsigned off_ = (unsigned)(row0 + ((g) >> 2) * 128 + ((g) & 3) * 16) * DM + col0; \
        bs[(g) % 4][0] = *(const f32x4*)(base + off_); bs[(g) % 4][1] = *(const f32x4*)(base + off_ + 4); bs[(g) % 4][2] = *(const f32x4*)(base + off_ + 128); bs[(g) % 4][3] = *(const f32x4*)(base + off_ + 132); } while (0)
        ERF_LOAD(0); asm volatile("" ::: "memory"); ERF_LOAD(1); asm volatile("" ::: "memory"); ERF_LOAD(2); asm volatile("" ::: "memory");
#pragma unroll
        for (int g = 0; g < 8; ++g) { const int ai = g >> 2, m = g & 3;
            if (g + 3 < 8) { ERF_LOAD(g + 3); }
            asm volatile("" ::: "memory");
            const unsigned off = (unsigned)(row0 + ai * 128 + m * 16) * DM + col0;
            *(f32x4*)(out + off) = bs[g % 4][0] + acc[ai][0][m][0]; *(f32x4*)(out + off + 4) = bs[g % 4][1] + acc[ai][0][m][1];
            *(f32x4*)(out + off + 128) = bs[g % 4][2] + acc[ai][1][m][0]; *(f32x4*)(out + off + 132) = bs[g % 4][3] + acc[ai][1][m][1];
            asm volatile("" ::: "memory"); }
#undef ERF_LOAD
    }
};
struct EpiSwiGLU {
    static constexpr bool PERM = true, AFTER_DRAIN = false;
    bf16_t* O;
    __device__ __forceinline__ void operator()(const pg8::f32x4 (&acc)[2][2][4][2], const pg8::Unit& u, int wr, int wc, int fr, int fq) const {
        const int row0 = u.pm * 256 + wr * 64 + fr, col0 = u.pn * 128 + wc * 32 + 8 * fq;
#pragma unroll
        for (int ai = 0; ai < 2; ++ai)
#pragma unroll
            for (int m = 0; m < 4; ++m) { float r[8];
#pragma unroll
                for (int n = 0; n < 2; ++n) { const f32x4 g = acc[ai][0][m][n], up = acc[ai][1][m][n];
#pragma unroll
                    for (int j = 0; j < 4; ++j) r[4 * n + j] = g[j] * sigmoidf_(g[j]) * up[j]; }
                u32x4 w; w.x = pack2bf(r[0], r[1]); w.y = pack2bf(r[2], r[3]); w.z = pack2bf(r[4], r[5]); w.w = pack2bf(r[6], r[7]);
                *(u32x4*)(O + (size_t)(row0 + ai * 128 + m * 16) * DFF + col0) = w; }
    }
};
struct EpiPle {
    static constexpr bool PERM = true, AFTER_DRAIN = false;
    float* out; const bf16_t* proj;
    __device__ __forceinline__ void operator()(const pg8::f32x4 (&acc)[2][2][4][2], const pg8::Unit& u, int wr, int wc, int fr, int fq) const {
        const int row0 = u.pm * 256 + wr * 64 + fr, col0 = u.pn * 256 + wc * 32 + 8 * fq;
        f32x4 bs[3][4]; u32x2 pj[3][4];
#define EPL_LOAD(g) do { const unsigned off_ = (unsigned)(row0 + ((g) >> 2) * 128 + ((g) & 3) * 16) * DM + col0; \
        bs[(g) % 3][0] = *(const f32x4*)(out + off_); bs[(g) % 3][1] = *(const f32x4*)(out + off_ + 4); bs[(g) % 3][2] = *(const f32x4*)(out + off_ + 128); bs[(g) % 3][3] = *(const f32x4*)(out + off_ + 132); \
        pj[(g) % 3][0] = *(const u32x2*)(proj + off_); pj[(g) % 3][1] = *(const u32x2*)(proj + off_ + 4); pj[(g) % 3][2] = *(const u32x2*)(proj + off_ + 128); pj[(g) % 3][3] = *(const u32x2*)(proj + off_ + 132); } while (0)
        EPL_LOAD(0); asm volatile("" ::: "memory"); EPL_LOAD(1); asm volatile("" ::: "memory");
#pragma unroll
        for (int g = 0; g < 8; ++g) { const int ai = g >> 2, m = g & 3;
            if (g + 2 < 8) { EPL_LOAD(g + 2); }
            asm volatile("" ::: "memory");
            const unsigned off = (unsigned)(row0 + ai * 128 + m * 16) * DM + col0;
#pragma unroll
            for (int q = 0; q < 4; ++q) { const f32x4 a = acc[ai][q >> 1][m][q & 1], b = bs[g % 3][q]; const u32x2 pw = pj[g % 3][q]; f32x4 r;
                r[0] = b[0] + sigmoidf_(a[0]) * __uint_as_float(pw.x << 16); r[1] = b[1] + sigmoidf_(a[1]) * __uint_as_float(pw.x & 0xffff0000u);
                r[2] = b[2] + sigmoidf_(a[2]) * __uint_as_float(pw.y << 16); r[3] = b[3] + sigmoidf_(a[3]) * __uint_as_float(pw.y & 0xffff0000u);
                *(f32x4*)(out + off + (q >> 1) * 128 + (q & 1) * 4) = r; }
            asm volatile("" ::: "memory"); }
#undef EPL_LOAD
    }
};

constexpr int PARAM_OFF = LDS_BYTES - 512;
struct Ctx { int tid, lane, wid, bid, nb; unsigned char* ws; LAS unsigned char* lds;
    __device__ __forceinline__ unsigned long long raw(int i) const { const unsigned long long v = ((const LAS unsigned long long*)(lds + PARAM_OFF))[i];
        const unsigned lo = __builtin_amdgcn_readfirstlane((unsigned)v), hi = __builtin_amdgcn_readfirstlane((unsigned)(v >> 32)); return ((unsigned long long)hi << 32) | lo; }
    __device__ __forceinline__ const float* in(int i) const { return (const float*)(const __attribute__((address_space(1))) float*)raw(i); }
    __device__ __forceinline__ unsigned char* gptr(int i) const { return (unsigned char*)(__attribute__((address_space(1))) unsigned char*)raw(i); }
};

__device__ __forceinline__ void phase_prep0a(const Ctx& C) {
    const int gt = C.bid * NTHR + C.tid, gn = C.nb * NTHR;
    typedef float f32x2_ __attribute__((ext_vector_type(2))); f32x2_* TW = (f32x2_*)(C.ws + OFF_TW);
    for (int k = gt; k < 8192; k += gn) { float s, c; sincospif((float)k * (1.0f / 8192.0f), &s, &c); { f32x2_ tv; tv.x = c; tv.y = -s; TW[k] = tv; } }
    float* FAB = (float*)(C.ws + OFF_FAB);
    for (int i = gt; i < 2 * 4 * 2 * 4096; i += gn) {
        const int d = i & 63, c = (i >> 6) & 63, ab = (i >> 12) & 1, g = (i >> 13) & 3, l = i >> 15;
        const float* w = C.in(7) + (size_t)((l * 4 + g) * 64) * 64;
        float acc = 0.f;
        for (int dp = 0; dp < 64; ++dp) { float s, cc; sincospif((float)((dp * c) & 63) * (1.0f / 32.0f), &s, &cc); acc += (ab ? s : cc) * w[dp * 64 + d]; }
        const float sc = 1.0f / sqrtf(64.0f * 8192.0f);
        FAB[i] = ab ? -acc * sc : acc * sc;
    }
    float* H2 = (float*)(C.ws + OFF_H2);
    const int gw = C.bid * 8 + C.wid, lane = C.lane;
#pragma unroll 1
    for (int l = 0; l < 2; ++l) {
        const float* w1 = C.in(10) + l * 33 * 64; const float* w2 = C.in(13) + l * 4096;
        const float b1 = C.in(11)[l * 64 + lane], b2 = C.in(14)[l * 64 + lane], fq0 = C.in(12)[l * 128 + lane], fq1 = C.in(12)[l * 128 + 64 + lane];
        float w1c[33], w2c[64];
#pragma unroll
        for (int i = 0; i < 33; ++i) w1c[i] = w1[i * 64 + lane];
#pragma unroll
        for (int i = 0; i < 64; ++i) w2c[i] = w2[i * 64 + lane];
#pragma unroll 1
        for (int s = gw; s < 8192; s += C.nb * 8) {
            const float t = (float)s / 8191.0f;
            const float ang = (float)(2.0 * 3.14159265358979323846 / 8192.0) * (float)s;
            float feat = 0.f;
            if (lane == 0) feat = t;
            else if (lane <= 32) { const int bi = (lane - 1) & 15; const float band = 1e-4f + (float)bi * ((15.0f - 1e-4f) / 15.0f); const float fb = ang * band; feat = lane <= 16 ? cosf(fb) : -sinf(fb); }
            float a = b1;
#pragma unroll
            for (int i = 0; i < 33; ++i) a += __shfl(feat, i) * w1c[i];
            const float h1 = sinf(fq0 * a);
            float a2 = b2;
#pragma unroll
            for (int i = 0; i < 64; ++i) a2 += __shfl(h1, i) * w2c[i];
            H2[(size_t)(l * 8192 + s) * 64 + lane] = sinf(fq1 * a2);
        }
    }
}

template <class ColF>
__device__ __forceinline__ void wtranspose(ColF colp, int ldw, int NOUT, int K, const float* gain, bf16_t* dst, const Ctx& C) {
    LAS float* tile = (LAS float*)C.lds;
    const int ntn = NOUT / 64, ntk = K / 64;
    for (int t = C.bid; t < ntn * ntk; t += C.nb) {
        const int tn = t % ntn, tk = t / ntn;
#pragma unroll
        for (int i = 0; i < 8; ++i) { const int e = C.tid + NTHR * i, jj = e & 63, ii = e >> 6, k = tk * 64 + ii;
            float v = __builtin_nontemporal_load(colp(tn * 64 + jj) + (size_t)k * ldw); if (gain) v *= gain[k]; tile[ii * 65 + jj] = v; }
        __syncthreads();
#pragma unroll
        for (int i = 0; i < 8; ++i) { const int e = C.tid + NTHR * i, ii = e & 63, jj = e >> 6; dst[(size_t)(tn * 64 + jj) * K + tk * 64 + ii] = f2bf(tile[ii * 65 + jj]); }
        __syncthreads();
    }
}
__device__ __forceinline__ void phase_weights(const Ctx& C) {
    for (int l = 0; l < 2; ++l) {
        unsigned char* wb = C.ws + OFF_W + (size_t)l * W_LAYER;
        const float* w_in = C.in(5) + (size_t)l * DM * NIN;
        const float* g_mix = C.in(4) + l * DM;
        wtranspose([=](int n) { return w_in + (n < 768 ? n : n + 1024); }, NIN, 1792, DM, g_mix, (bf16_t*)(wb + W_INA), C);
        wtranspose([=](int n) { return w_in + 1024 + n; }, NIN, 768, DM, g_mix, (bf16_t*)(wb + W_INB) + (size_t)512 * DM, C);
        const float* w_out = C.in(20) + (size_t)l * DM * DM;
        wtranspose([=](int n) { return w_out + n; }, DM, DM, DM, C.in(19) + l * DM, (bf16_t*)(wb + W_OUT), C);
        const float* w_g = C.in(22) + (size_t)l * DM * DFF; const float* w_u = C.in(23) + (size_t)l * DM * DFF;
        const long long gu_delta = (long long)(w_u - w_g);
        wtranspose([=](int r) { return w_g + ((r & 128) ? gu_delta : 0ll) + 128 * (r >> 8) + (r & 127); }, DFF, 2 * DFF, DM, C.in(21) + l * DM, (bf16_t*)(wb + W_GU), C);
        const float* w_d = C.in(24) + (size_t)l * DFF * DM;
        wtranspose([=](int n) { return w_d + n; }, DM, DM, DFF, nullptr, (bf16_t*)(wb + W_DOWN), C);
        const float* w_pg = C.in(26) + (size_t)l * DM * DM;
        wtranspose([=](int n) { return w_pg + n; }, DM, DM, DM, C.in(25) + l * DM, (bf16_t*)(wb + W_PG), C);
        const float* w_pp = C.in(27) + (size_t)l * 256 * DM;
        wtranspose([=](int n) { return w_pp + n; }, DM, DM, 256, nullptr, (bf16_t*)(wb + W_PP), C);
    }
    LAS float* wt = (LAS float*)C.lds; LAS float* fa = wt + 64 * 65; LAS float* fb = fa + 4096;
    const float* FAB = (const float*)(C.ws + OFF_FAB);
    for (int t = C.bid; t < 2 * 4 * 16; t += C.nb) {
        const int tk = t & 15, g = (t >> 4) & 3, l = t >> 6;
        const float* w_in = C.in(5) + (size_t)l * DM * NIN; const float* g_mix = C.in(4) + l * DM;
#pragma unroll
        for (int i = 0; i < 8; ++i) { const int e = C.tid + NTHR * i, cc = e & 63, ii = e >> 6, k = tk * 64 + ii;
            wt[ii * 65 + cc] = w_in[(size_t)k * NIN + 768 + 64 * g + cc] * g_mix[k];
            fa[e] = FAB[((l * 4 + g) * 2 + 0) * 4096 + e]; fb[e] = FAB[((l * 4 + g) * 2 + 1) * 4096 + e]; }
        __syncthreads();
        const int k = C.tid & 63, dg = C.tid >> 6;
        float ap[8], aq[8];
#pragma unroll
        for (int i = 0; i < 8; ++i) { ap[i] = 0.f; aq[i] = 0.f; }
        for (int c = 0; c < 64; ++c) { const float w = wt[k * 65 + c];
#pragma unroll
            for (int i = 0; i < 8; ++i) { ap[i] += w * fa[c * 64 + dg * 8 + i]; aq[i] += w * fb[c * 64 + dg * 8 + i]; } }
        bf16_t* wB = (bf16_t*)(C.ws + OFF_W + (size_t)l * W_LAYER + W_INB);
#pragma unroll
        for (int i = 0; i < 8; ++i) { const int d = dg * 8 + i; wB[(size_t)(64 * g + d) * DM + tk * 64 + k] = f2bf(ap[i]); wB[(size_t)(256 + 64 * g + d) * DM + tk * 64 + k] = f2bf(aq[i]); }
        __syncthreads();
    }
}

__device__ __forceinline__ void phase_norm(const float* x0, const float* x1, const Ctx& C, const float* gate_w  , const float* gate_gain) {
    bf16_t* XB = (bf16_t*)(C.ws + OFF_XB);
    float* gates = (float*)(C.ws + OFF_GATES);
    LAS float* wg = (LAS float*)C.lds;
    if (gate_w) {
        for (int e = C.tid; e < 16 * 1024; e += NTHR) { const int j = e & 15, k = e >> 4; wg[j * 1024 + k] = gate_w[(size_t)k * NIN + 2816 + j] * gate_gain[k]; }
        __syncthreads();
    }
    const int lane = C.lane;
    const int rstep = C.nb * 8;
    f32x4 nx[4], ny[4];
    { const int row = C.bid * 8 + C.wid; if (row < T_TOK) { const float* xr = xrow_ptr(x0, x1, row);
#pragma unroll
        for (int j = 0; j < 4; ++j) nx[j] = __builtin_nontemporal_load((const f32x4*)(xr + 4 * lane + 256 * j)); }
      if (row + rstep < T_TOK) { const float* xr = xrow_ptr(x0, x1, row + rstep);
#pragma unroll
        for (int j = 0; j < 4; ++j) ny[j] = __builtin_nontemporal_load((const f32x4*)(xr + 4 * lane + 256 * j)); } }
    for (int row = C.bid * 8 + C.wid; row < T_TOK; row += rstep) {
        f32x4 v[4]; float ss = 0.f;
#pragma unroll
        for (int j = 0; j < 4; ++j) { v[j] = nx[j]; nx[j] = ny[j]; }
        if (row + 2 * rstep < T_TOK) { const float* xn = xrow_ptr(x0, x1, row + 2 * rstep);
#pragma unroll
            for (int j = 0; j < 4; ++j) ny[j] = __builtin_nontemporal_load((const f32x4*)(xn + 4 * lane + 256 * j)); }
#pragma unroll
        for (int j = 0; j < 4; ++j) ss += v[j][0] * v[j][0] + v[j][1] * v[j][1] + v[j][2] * v[j][2] + v[j][3] * v[j][3];
        ss = wave_sum(ss);
        const float rstd = rsqrtf(ss * (1.0f / 1024.0f) + EPSF);
#pragma unroll
        for (int j = 0; j < 4; ++j) { u32x2 w; w.x = pack2bf(v[j][0] * rstd, v[j][1] * rstd); w.y = pack2bf(v[j][2] * rstd, v[j][3] * rstd); *(u32x2*)(XB + (size_t)row * DM + 4 * lane + 256 * j) = w; }
        if (gate_w) {
            float p[16];
#pragma unroll
            for (int jg = 0; jg < 16; ++jg) { float a = 0.f;
#pragma unroll
                for (int j = 0; j < 4; ++j) { const f32x4 w4 = *(const LAS f32x4*)(wg + jg * 1024 + 4 * lane + 256 * j); a += v[j][0] * w4[0] + v[j][1] * w4[1] + v[j][2] * w4[2] + v[j][3] * w4[3]; }
                p[jg] = a; asm volatile("" ::: "memory"); }
            float q8[8], q4[4], q2[2], q1;
            { const bool hi = lane & 32;
#pragma unroll
              for (int j = 0; j < 8; ++j) { const float mine = hi ? p[j + 8] : p[j], oth = hi ? p[j] : p[j + 8]; q8[j] = mine + __shfl_xor(oth, 32); } }
            { const bool hi = lane & 16;
#pragma unroll
              for (int j = 0; j < 4; ++j) { const float mine = hi ? q8[j + 4] : q8[j], oth = hi ? q8[j] : q8[j + 4]; q4[j] = mine + __shfl_xor(oth, 16); } }
            { const bool hi = lane & 8;
#pragma unroll
              for (int j = 0; j < 2; ++j) { const float mine = hi ? q4[j + 2] : q4[j], oth = hi ? q4[j] : q4[j + 2]; q2[j] = mine + __shfl_xor(oth, 8); } }
            { const bool hi = lane & 4; const float mine = hi ? q2[1] : q2[0], oth = hi ? q2[0] : q2[1]; q1 = mine + __shfl_xor(oth, 4); }
            q1 += __shfl_xor(q1, 2); q1 += __shfl_xor(q1, 1);
            if ((lane & 3) == 0) gates[(size_t)row * 16 + (((lane >> 5) & 1) * 8 + ((lane >> 4) & 1) * 4 + ((lane >> 3) & 1) * 2 + ((lane >> 2) & 1))] = q1 * rstd;
        }
    }
    if (gate_w) __syncthreads();
}
__device__ __forceinline__ void phase_pconv(const float* p0, const float* p1, const Ctx& C) {
    bf16_t* PB = (bf16_t*)(C.ws + OFF_PB);
    const size_t n4 = (size_t)T_TOK * 256 / 4, split = (size_t)T_PROMPT * 256 / 4;
#pragma unroll 4
    for (size_t i = (size_t)C.bid * NTHR + C.tid; i < n4; i += (size_t)C.nb * NTHR) {
        const f32x4 v = __builtin_nontemporal_load(i < split ? (const f32x4*)p0 + i : (const f32x4*)p1 + (i - split));
        u32x2 w; w.x = pack2bf(v[0], v[1]); w.y = pack2bf(v[2], v[3]); ((u32x2*)PB)[i] = w;
    }
}
__device__ __forceinline__ void phase_final_norm(float* out, const float* gain, const Ctx& C) {
    const int lane = C.lane, rstep = C.nb * 8;
    f32x4 g4[4], nx[4], ny[4];
#pragma unroll
    for (int j = 0; j < 4; ++j) g4[j] = *(const f32x4*)(gain + 4 * lane + 256 * j);
    { const int row = C.bid * 8 + C.wid; if (row < T_TOK) {
#pragma unroll
        for (int j = 0; j < 4; ++j) nx[j] = __builtin_nontemporal_load((const f32x4*)(out + (size_t)row * DM + 4 * lane + 256 * j)); }
      if (row + rstep < T_TOK) {
#pragma unroll
        for (int j = 0; j < 4; ++j) ny[j] = __builtin_nontemporal_load((const f32x4*)(out + (size_t)(row + rstep) * DM + 4 * lane + 256 * j)); } }
    for (int row = C.bid * 8 + C.wid; row < T_TOK; row += rstep) {
        float* xr = out + (size_t)row * DM;
        f32x4 v[4]; float ss = 0.f;
#pragma unroll
        for (int j = 0; j < 4; ++j) { v[j] = nx[j]; nx[j] = ny[j]; }
        if (row + 2 * rstep < T_TOK) {
#pragma unroll
            for (int j = 0; j < 4; ++j) ny[j] = __builtin_nontemporal_load((const f32x4*)(out + (size_t)(row + 2 * rstep) * DM + 4 * lane + 256 * j)); }
#pragma unroll
        for (int j = 0; j < 4; ++j) ss += v[j][0] * v[j][0] + v[j][1] * v[j][1] + v[j][2] * v[j][2] + v[j][3] * v[j][3];
        ss = wave_sum(ss);
        const float rstd = rsqrtf(ss * (1.0f / 1024.0f) + EPSF);
#pragma unroll
        for (int j = 0; j < 4; ++j) __builtin_nontemporal_store(v[j] * rstd * g4[j], (f32x4*)(xr + 4 * lane + 256 * j));
    }
}

typedef float f32x2 __attribute__((ext_vector_type(2)));
__device__ __forceinline__ f32x2 mk2(float a, float b) { f32x2 r; r.x = a; r.y = b; return r; }
__device__ __forceinline__ int padi(int i) { return i + ((i >> 6) << 2); }
__device__ __forceinline__ f32x2 cmul(f32x2 a, f32x2 b) { return mk2(a.x * b.x - a.y * b.y, a.x * b.y + a.y * b.x); }
__device__ __forceinline__ f32x2 cmulc(f32x2 a, f32x2 b) { return mk2(a.x * b.x + a.y * b.y, a.y * b.x - a.x * b.y); }
template <bool CONJ> __device__ __forceinline__ f32x2 mul_w16(f32x2 a, int j) {
    const float cs[8] = {1.0f, 0.92387953251128674f, 0.70710678118654752f, 0.38268343236508977f, 0.0f, -0.38268343236508977f, -0.70710678118654752f, -0.92387953251128674f};
    const float sn[8] = {0.0f, 0.38268343236508977f, 0.70710678118654752f, 0.92387953251128674f, 1.0f, 0.92387953251128674f, 0.70710678118654752f, 0.38268343236508977f};
    if (j == 0) return a;
    if (j == 4) return CONJ ? mk2(-a.y, a.x) : mk2(a.y, -a.x);
    const f32x2 w = mk2(cs[j], sn[j]);
    return CONJ ? cmul(a, w) : cmulc(a, w);
}
constexpr int bitrev_c(int k, int R) { int r = 0; for (int b = 0; b < R; ++b) if (k & (1 << b)) r |= 1 << (R - 1 - b); return r; }
template <int LOGN, int S_HI, int R, bool INV, bool HALF = false>
__device__ __forceinline__ void fft_pass(LAS f32x2* X, const f32x2* __restrict__ TW, int tid) {
    constexpr int N = 1 << LOGN, S_LO = S_HI - R + 1, NG = N >> R, NK = 1 << R;
#pragma unroll 1
    for (int g = tid; g < NG; g += NTHR) {
        const int low = g & ((1 << S_LO) - 1), high = g >> S_LO, base = (high << (S_HI + 1)) + low;
        f32x2 pw[NK];
        if (S_LO > 0) { float f_ = (float)low * __uint_as_float((unsigned)(126 - S_HI) << 23); asm volatile("" : "+v"(f_)); pw[1] = mk2(__builtin_amdgcn_cosf(f_), -__builtin_amdgcn_sinf(f_));
#pragma unroll
            for (int e = 2; e < NK; ++e) pw[e] = (e & 1) ? cmul(pw[e - 1], pw[1]) : cmul(pw[e >> 1], pw[e >> 1]); }
        f32x2 x[NK];
#pragma unroll
        for (int k = 0; k < NK; ++k) x[k] = (HALF && !INV && k >= NK / 2) ? mk2(0.f, 0.f) : X[padi(base + (k << S_LO))];
        if (!INV) {
#pragma unroll
            for (int st = 0; st < R; ++st) { const int hk = 1 << (R - 1 - st);
#pragma unroll
                for (int k0 = 0; k0 < NK; ++k0) { if (k0 & hk) continue; const int k1 = k0 + hk;
                    const f32x2 a = x[k0], b = x[k1];
                    x[k0] = mk2(a.x + b.x, a.y + b.y);
                    x[k1] = mul_w16<false>(mk2(a.x - b.x, a.y - b.y), (k0 & (hk - 1)) * (8 / hk)); } }
            if (S_LO > 0) {
#pragma unroll
                for (int k = 1; k < NK; ++k) x[k] = cmul(x[k], pw[bitrev_c(k, R)]); }
        } else {
            if (S_LO > 0) {
#pragma unroll
                for (int k = 1; k < NK; ++k) x[k] = cmulc(x[k], pw[bitrev_c(k, R)]); }
#pragma unroll
            for (int st = R - 1; st >= 0; --st) { const int hk = 1 << (R - 1 - st);
#pragma unroll
                for (int k0 = 0; k0 < NK; ++k0) { if (k0 & hk) continue; const int k1 = k0 + hk;
                    const f32x2 a = x[k0], b = mul_w16<true>(x[k1], (k0 & (hk - 1)) * (8 / hk));
                    x[k0] = mk2(a.x + b.x, a.y + b.y);
                    x[k1] = mk2(a.x - b.x, a.y - b.y); } }
        }
#pragma unroll
        for (int k = 0; k < NK; ++k) if (!(HALF && INV && k >= NK / 2)) X[padi(base + (k << S_LO))] = x[k];
    }
    __syncthreads();
}
__device__ __forceinline__ void fft_mid_mul14(LAS f32x2* X, const f32x2* __restrict__ K, int tid) {
    f32x4 kk[8][2];
#pragma unroll
    for (int q = 0; q < 8; ++q) { const int g = tid + NTHR * q; kk[q][0] = *(const f32x4*)(K + 4 * g); kk[q][1] = *(const f32x4*)(K + 4 * g + 2); }
#pragma unroll
    for (int q = 0; q < 8; ++q) { const int g = tid + NTHR * q; LAS f32x2* xp = X + padi(4 * g);
        const f32x4 v01 = *(const LAS f32x4*)xp, v23 = *(const LAS f32x4*)(xp + 2);
        f32x2 x0 = mk2(v01[0], v01[1]), x1 = mk2(v01[2], v01[3]), x2 = mk2(v23[0], v23[1]), x3 = mk2(v23[2], v23[3]);
        { const f32x2 a = x0, b = x2; x0 = mk2(a.x + b.x, a.y + b.y); x2 = mk2(a.x - b.x, a.y - b.y); }
        { const f32x2 a = x1, b = x3; x1 = mk2(a.x + b.x, a.y + b.y); const f32x2 d = mk2(a.x - b.x, a.y - b.y); x3 = mk2(d.y, -d.x); }
        { const f32x2 a = x0, b = x1; x0 = mk2(a.x + b.x, a.y + b.y); x1 = mk2(a.x - b.x, a.y - b.y); }
        { const f32x2 a = x2, b = x3; x2 = mk2(a.x + b.x, a.y + b.y); x3 = mk2(a.x - b.x, a.y - b.y); }
        x0 = cmul(x0, mk2(kk[q][0][0], kk[q][0][1])); x1 = cmul(x1, mk2(kk[q][0][2], kk[q][0][3])); x2 = cmul(x2, mk2(kk[q][1][0], kk[q][1][1])); x3 = cmul(x3, mk2(kk[q][1][2], kk[q][1][3]));
        { const f32x2 a = x0, b = x1; x0 = mk2(a.x + b.x, a.y + b.y); x1 = mk2(a.x - b.x, a.y - b.y); }
        { const f32x2 a = x2, b = x3; x2 = mk2(a.x + b.x, a.y + b.y); x3 = mk2(a.x - b.x, a.y - b.y); }
        { const f32x2 a = x0, b = x2; x0 = mk2(a.x + b.x, a.y + b.y); x2 = mk2(a.x - b.x, a.y - b.y); }
        { const f32x2 a = x1, b = mk2(-x3.y, x3.x); x1 = mk2(a.x + b.x, a.y + b.y); x3 = mk2(a.x - b.x, a.y - b.y); }
        *(LAS f32x4*)xp = (f32x4){x0.x, x0.y, x1.x, x1.y}; *(LAS f32x4*)(xp + 2) = (f32x4){x2.x, x2.y, x3.x, x3.y}; }
    __syncthreads();
}
__device__ __forceinline__ void fft_fwd14_head(LAS f32x2* X, const f32x2* __restrict__ TW, int tid) {
    fft_pass<14, 13, 4, false, true>(X, TW, tid); fft_pass<14, 9, 4, false>(X, TW, tid); fft_pass<14, 5, 4, false>(X, TW, tid);
}
__device__ __forceinline__ void fft_inv14_tail(LAS f32x2* X, const f32x2* __restrict__ TW, int tid) {
    fft_pass<14, 5, 4, true>(X, TW, tid); fft_pass<14, 9, 4, true>(X, TW, tid); fft_pass<14, 13, 4, true, true>(X, TW, tid);
}
template <int LOGN>
__device__ __forceinline__ void fft_fwd(LAS f32x2* X, const f32x2* __restrict__ TW, int tid) {
    if (LOGN == 14) fft_pass<LOGN, 13, 4, false>(X, TW, tid); else fft_pass<LOGN, 12, 3, false>(X, TW, tid);
    fft_pass<LOGN, 9, 4, false>(X, TW, tid); fft_pass<LOGN, 5, 4, false>(X, TW, tid); fft_pass<LOGN, 1, 2, false>(X, TW, tid);
}
template <int LOGN>
__device__ __forceinline__ void fft_inv(LAS f32x2* X, const f32x2* __restrict__ TW, int tid) {
    fft_pass<LOGN, 1, 2, true>(X, TW, tid); fft_pass<LOGN, 5, 4, true>(X, TW, tid); fft_pass<LOGN, 9, 4, true>(X, TW, tid);
    if (LOGN == 14) fft_pass<LOGN, 13, 4, true>(X, TW, tid); else fft_pass<LOGN, 12, 3, true>(X, TW, tid);
}

__device__ __forceinline__ void phase_kspec(const Ctx& C, int l) {
    LAS f32x2* X = (LAS f32x2*)C.lds;
    LAS float* w3s = (LAS float*)(C.lds + 139264);
    const f32x2* TW = (const f32x2*)(C.ws + OFF_TW);
    const float* H2 = (const float*)(C.ws + OFF_H2) + (size_t)l * 8192 * 64;
    f32x2* KS = (f32x2*)(C.ws + OFF_KS);
    const float* w3 = C.in(15) + (size_t)l * 64 * 1024;
    const float* dec = C.in(16) + l * 1024;
    for (int task = C.bid; task < 512; task += C.nb) {
        const int o = task >> 8, ch = task & 255;
        if (C.tid < 128) { const int dir = C.tid >> 6, i = C.tid & 63; w3s[C.tid] = w3[i * 1024 + o * 512 + dir * 256 + ch]; }
        const float dfw = dec[o * 512 + ch], dbw = dec[o * 512 + 256 + ch];
        __syncthreads();
        for (int s = C.tid; s < 8192; s += NTHR) {
            const f32x4* h = (const f32x4*)(H2 + (size_t)s * 64);
            float af = 0.f, ab = 0.f;
            f32x4 hh[16];
#pragma unroll
            for (int i4 = 0; i4 < 16; ++i4) hh[i4] = h[i4];
#pragma unroll
            for (int i4 = 0; i4 < 16; ++i4) { const f32x4 hv = hh[i4];
                af += hv[0] * w3s[4 * i4] + hv[1] * w3s[4 * i4 + 1] + hv[2] * w3s[4 * i4 + 2] + hv[3] * w3s[4 * i4 + 3];
                ab += hv[0] * w3s[64 + 4 * i4] + hv[1] * w3s[64 + 4 * i4 + 1] + hv[2] * w3s[64 + 4 * i4 + 2] + hv[3] * w3s[64 + 4 * i4 + 3]; }
            const float t = (float)s / 8191.0f;
            af *= expf(-t * dfw); ab *= expf(-t * dbw);
            X[padi(s)] = mk2(af, 0.f);
            if (s >= 1) X[padi(16384 - s)] = mk2(ab, 0.f);
        }
        if (C.tid == 0) { float zz = 0.f; asm volatile("" : "+v"(zz)); X[padi(8192)] = mk2(zz, zz); }
        __syncthreads();
        fft_fwd<14>(X, TW, C.tid);
        f32x2* dst = KS + (size_t)(o * 256 + ch) * 16384;
        for (int i = C.tid; i < 16384; i += NTHR) dst[i] = X[padi(i)];
        __syncthreads();
    }
}

__device__ __forceinline__ void unpack8(const u32x4 w, float (&u)[10]) {
    u[1] = __uint_as_float(w.x << 16); u[2] = __uint_as_float(w.x & 0xffff0000u); u[3] = __uint_as_float(w.y << 16); u[4] = __uint_as_float(w.y & 0xffff0000u);
    u[5] = __uint_as_float(w.z << 16); u[6] = __uint_as_float(w.z & 0xffff0000u); u[7] = __uint_as_float(w.w << 16); u[8] = __uint_as_float(w.w & 0xffff0000u);
}
struct Raw8 { u32x4 w; bf16_t pm, pn; };
__device__ __forceinline__ Raw8 load_raw8(const bf16_t* row, int i8) { Raw8 r; r.w = *(const u32x4*)(row + i8); r.pm = row[i8 > 0 ? i8 - 1 : 0]; r.pn = row[i8 + 8 < SEQL ? i8 + 8 : 0]; return r; }
__device__ __forceinline__ void sconv8r(const Raw8& r, int i8, float w0, float w1, float w2, float bias, float (&o)[8]) {
    float u[10];
    unpack8(r.w, u);
    u[0] = i8 > 0 ? bf2f(r.pm) : 0.f;
    u[9] = i8 + 8 < SEQL ? bf2f(r.pn) : 0.f;
#pragma unroll
    for (int e = 0; e < 8; ++e) o[e] = u[e] * w0 + u[e + 1] * w1 + u[e + 2] * w2 + bias;
}
__device__ __forceinline__ void phase_hyena(const Ctx& C, int l) {
    LAS f32x2* X = (LAS f32x2*)C.lds;
    const f32x2* TW = (const f32x2*)(C.ws + OFF_TW);
    const f32x2* KS = (const f32x2*)(C.ws + OFF_KS);
    bf16_t* zB = (bf16_t*)(C.ws + OFF_ZB);
    const float* cw = C.in(8) + l * 3 * 768; const float* cb = C.in(9) + l * 768; const float* skip = C.in(17) + l * 512;
    for (int task = C.bid; task < 5 * 256; task += C.nb) {
        const int pr = task >> 8, c = task & 255;
        const size_t t0 = (size_t)(2 * pr) * SEQL, t1 = t0 + SEQL;
        bf16_t* rv = zB + (size_t)(512 + c) * T_TOK; const bf16_t* rx1 = zB + (size_t)(768 + c) * T_TOK; const bf16_t* rx2 = zB + (size_t)(1024 + c) * T_TOK;
        const f32x2* K0 = KS + (size_t)c * 16384; const f32x2* K1 = KS + (size_t)(256 + c) * 16384;
        f32x4 keep[2][4];
        Raw8 rx[2][2];
        { const float v0 = cw[c], v1 = cw[768 + c], v2 = cw[1536 + c], vb = cb[c];
          Raw8 rw[2][2];
#pragma unroll
          for (int q = 0; q < 2; ++q) { const int i8 = (C.tid + NTHR * q) * 8; rw[q][0] = load_raw8(rv + t0, i8); rw[q][1] = load_raw8(rv + t1, i8); }
#pragma unroll
          for (int q = 0; q < 2; ++q) { const int i8 = (C.tid + NTHR * q) * 8; float va[8], vc[8];
              sconv8r(rw[q][0], i8, v0, v1, v2, vb, va); sconv8r(rw[q][1], i8, v0, v1, v2, vb, vc);
              const int p0 = padi(i8), p1 = padi(i8 + 8192);
#pragma unroll
              for (int e = 0; e < 8; e += 2) { const f32x4 w = (f32x4){va[e], vc[e], va[e + 1], vc[e + 1]};
                  keep[q][e >> 1] = w; *(LAS f32x4*)(X + p0 + e) = w; } } }
        __syncthreads();
        fft_fwd14_head(X, TW, C.tid); fft_mid_mul14(X, K0, C.tid); fft_inv14_tail(X, TW, C.tid);
        { const float a0 = cw[256 + c], a1 = cw[768 + 256 + c], a2 = cw[1536 + 256 + c], abi = cb[256 + c], sk0 = skip[c];
#pragma unroll
          for (int q = 0; q < 2; ++q) { const int i8 = (C.tid + NTHR * q) * 8; rx[q][0] = load_raw8(rx1 + t0, i8); rx[q][1] = load_raw8(rx1 + t1, i8); }
#pragma unroll
          for (int q = 0; q < 2; ++q) { const int i8 = (C.tid + NTHR * q) * 8; float xa[8], xb[8];
              sconv8r(rx[q][0], i8, a0, a1, a2, abi, xa); sconv8r(rx[q][1], i8, a0, a1, a2, abi, xb);
              const int p0 = padi(i8), p1 = padi(i8 + 8192);
#pragma unroll
              for (int e = 0; e < 8; e += 2) { const f32x4 cv = *(const LAS f32x4*)(X + p0 + e), v = keep[q][e >> 1];
                  const f32x4 y = (f32x4){xa[e] * (cv[0] * (1.0f / 16384.0f) + v[0] * sk0), xb[e] * (cv[1] * (1.0f / 16384.0f) + v[1] * sk0),
                                          xa[e + 1] * (cv[2] * (1.0f / 16384.0f) + v[2] * sk0), xb[e + 1] * (cv[3] * (1.0f / 16384.0f) + v[3] * sk0)};
                  keep[q][e >> 1] = y; *(LAS f32x4*)(X + p0 + e) = y; } } }
        __syncthreads();
        fft_fwd14_head(X, TW, C.tid); fft_mid_mul14(X, K1, C.tid); fft_inv14_tail(X, TW, C.tid);
        { const float b0 = cw[512 + c], b1 = cw[768 + 512 + c], b2 = cw[1536 + 512 + c], bbi = cb[512 + c], sk1 = skip[256 + c];
#pragma unroll
          for (int q = 0; q < 2; ++q) { const int i8 = (C.tid + NTHR * q) * 8; rx[q][0] = load_raw8(rx2 + t0, i8); rx[q][1] = load_raw8(rx2 + t1, i8); }
#pragma unroll
          for (int q = 0; q < 2; ++q) { const int i8 = (C.tid + NTHR * q) * 8; float xa[8], xb[8], ya[8], yb[8];
              sconv8r(rx[q][0], i8, b0, b1, b2, bbi, xa); sconv8r(rx[q][1], i8, b0, b1, b2, bbi, xb);
              const int p0 = padi(i8);
#pragma unroll
              for (int e = 0; e < 8; e += 2) { const f32x4 cv = *(const LAS f32x4*)(X + p0 + e), y1 = keep[q][e >> 1];
                  ya[e] = xa[e] * (cv[0] * (1.0f / 16384.0f) + y1[0] * sk1); yb[e] = xb[e] * (cv[1] * (1.0f / 16384.0f) + y1[1] * sk1);
                  ya[e + 1] = xa[e + 1] * (cv[2] * (1.0f / 16384.0f) + y1[2] * sk1); yb[e + 1] = xb[e + 1] * (cv[3] * (1.0f / 16384.0f) + y1[3] * sk1); }
              u32x4 wa, wb; wa.x = pack2bf(ya[0], ya[1]); wa.y = pack2bf(ya[2], ya[3]); wa.z = pack2bf(ya[4], ya[5]); wa.w = pack2bf(ya[6], ya[7]);
              wb.x = pack2bf(yb[0], yb[1]); wb.y = pack2bf(yb[2], yb[3]); wb.z = pack2bf(yb[4], yb[5]); wb.w = pack2bf(yb[6], yb[7]);
              *(u32x4*)(rv + t0 + i8) = wa; *(u32x4*)(rv + t1 + i8) = wb; } }
        __syncthreads();
    }
}

__device__ __forceinline__ void phase_fnet(const Ctx& C) {
    LAS f32x2* X = (LAS f32x2*)C.lds;
    const f32x2* TW = (const f32x2*)(C.ws + OFF_TW);
    bf16_t* zB = (bf16_t*)(C.ws + OFF_ZB);
    for (int task = C.bid; task < NSEQ * 256; task += C.nb) {
        const int b = task >> 8, r = task & 255;
        bf16_t* rp = zB + (size_t)r * T_TOK + (size_t)b * SEQL; const bf16_t* rq = zB + (size_t)(256 + r) * T_TOK + (size_t)b * SEQL;
#pragma unroll 2
        for (int q = 0; q < 2; ++q) { const int i8 = (C.tid + NTHR * q) * 8; float up[10], uq[10];
            unpack8(*(const u32x4*)(rp + i8), up); unpack8(*(const u32x4*)(rq + i8), uq);
            const int p0 = padi(i8);
#pragma unroll
            for (int e = 0; e < 8; e += 2) *(LAS f32x4*)(X + p0 + e) = (f32x4){up[e + 1], uq[e + 1], up[e + 2], uq[e + 2]}; }
        __syncthreads();
        fft_fwd<13>(X, TW, C.tid);
#pragma unroll 1
        for (int q = 0; q < 2; ++q) { const int k8 = (C.tid + NTHR * q) * 8; float y[8];
#pragma unroll
            for (int e = 0; e < 8; ++e) y[e] = X[padi((int)(__brev((unsigned)(k8 + e)) >> 19))].x;
            u32x4 w; w.x = pack2bf(y[0], y[1]); w.y = pack2bf(y[2], y[3]); w.z = pack2bf(y[4], y[5]); w.w = pack2bf(y[6], y[7]);
            *(u32x4*)(rp + k8) = w; }
        __syncthreads();
    }
}

__device__ __forceinline__ void phase_headnorm_cm(const Ctx& C) {
    LAS float* S = (LAS float*)C.lds;
    const bf16_t* zB = (const bf16_t*)(C.ws + OFF_ZB);
    bf16_t* XB = (bf16_t*)(C.ws + OFF_XB);
    for (int task = C.bid; task < T_TOK / 64; task += C.nb) {
        const size_t tok0 = (size_t)task * 64;
#pragma unroll 8
        for (int e = C.tid; e < 512 * 8; e += NTHR) { const int ch = e >> 3, part = e & 7; const int row = ch < 256 ? ch : ch + 256;
            const u32x4 w = *(const u32x4*)(zB + (size_t)row * T_TOK + tok0 + part * 8);
            LAS float* d = S + ch * 68 + part * 8;
            *(LAS f32x4*)d = (f32x4){__uint_as_float(w.x << 16), __uint_as_float(w.x & 0xffff0000u), __uint_as_float(w.y << 16), __uint_as_float(w.y & 0xffff0000u)};
            *(LAS f32x4*)(d + 4) = (f32x4){__uint_as_float(w.z << 16), __uint_as_float(w.z & 0xffff0000u), __uint_as_float(w.w << 16), __uint_as_float(w.w & 0xffff0000u)}; }
        __syncthreads();
        const int tok = C.tid & 63, head = C.tid >> 6;
        float ss = 0.f;
        for (int c = 0; c < 64; ++c) { const float v = S[(head * 64 + c) * 68 + tok]; ss += v * v; }
        const float rstd = rsqrtf(ss * (1.0f / 64.0f) + EPSF);
        bf16_t* dst = XB + (tok0 + tok) * DM + 256 + head * 64;
#pragma unroll 2
        for (int c8 = 0; c8 < 8; ++c8) { u32x4 w; const LAS float* sp = S + (head * 64 + c8 * 8) * 68 + tok;
            w.x = pack2bf(sp[0] * rstd, sp[68] * rstd); w.y = pack2bf(sp[136] * rstd, sp[204] * rstd); w.z = pack2bf(sp[272] * rstd, sp[340] * rstd); w.w = pack2bf(sp[408] * rstd, sp[476] * rstd);
            *(u32x4*)(dst + c8 * 8) = w; }
        __syncthreads();
    }
}

typedef short bf16x8_n __attribute__((ext_vector_type(8)));
__device__ __forceinline__ void phase_na(const Ctx& C, int l) {
    LAS unsigned char* Kb = C.lds;
    LAS unsigned char* VT = C.lds + 65536;
    LAS unsigned char* Qb = C.lds + 131072;
    LAS unsigned char* Pw = Qb + 9216;
    LAS float* Bs = (LAS float*)(Pw + 4 * 2304);
    const bf16_t* zA = (const bf16_t*)(C.ws + OFF_Z);
    bf16_t* XB = (bf16_t*)(C.ws + OFF_XB);
    const float* rpb = C.in(6) + l * 4 * 15 * 31;
    const int lane = C.lane, w = C.wid, jl = lane & 15, quad = lane >> 4;
    const int scol = C.tid >> 3, spart = C.tid & 7;
    for (int task = C.bid; task < NSEQ * 4 * 32; task += C.nb) {
        const int h = task & 3, strip = (task >> 2) & 31, b = task >> 7;
        const bf16_t* zrow = zA + (size_t)b * SEQL * ZA_LD + 64 * h + spart * 8;
        { const int r = 4 * strip, kr0 = min(max(r - 4, 0), 120);
          u32x4 kreg[8], vreg[8];
#pragma unroll
          for (int i = 0; i < 8; ++i) { const bf16_t* src = zrow + (size_t)((kr0 + i) * 64 + scol) * ZA_LD; kreg[i] = *(const u32x4*)(src + 256); vreg[i] = *(const u32x4*)(src + 512); }
          const u32x4 qreg = *(const u32x4*)(zrow + (size_t)(r * 64 + scol) * ZA_LD);
          __syncthreads();
          for (int e = C.tid; e < 15 * 31; e += NTHR) Bs[e] = rpb[h * 465 + e];
          for (int e = C.tid; e < 4 * 2304 / 16; e += NTHR) *(LAS u32x4*)(Pw + e * 16) = (u32x4){0u, 0u, 0u, 0u};
#pragma unroll
          for (int i = 0; i < 8; ++i) { const int slot = (kr0 + i) & 7;
              *(LAS u32x4*)(Kb + slot * 8192 + scol * 128 + ((spart ^ (scol & 7)) * 16)) = kreg[i];
              const unsigned va[4] = {vreg[i].x, vreg[i].y, vreg[i].z, vreg[i].w};
#pragma unroll
              for (int t = 0; t < 8; ++t) { const unsigned hv = (t & 1) ? (va[t >> 1] >> 16) : (va[t >> 1] & 0xffffu);
                  *(LAS bf16_t*)(VT + slot * 8192 + (spart * 8 + t) * 128 + (((scol >> 3) ^ t ^ spart) * 16) + (scol & 7) * 2) = (bf16_t)hv; } }
          *(LAS u32x4*)(Qb + scol * 144 + spart * 16) = qreg; }
#pragma unroll 1
        for (int rr = 0; rr < 4; ++rr) {
            const int r = 4 * strip + rr, kr0 = min(max(r - 4, 0), 120);
            const int krn = min(max(r + 1 - 4, 0), 120); const bool more = rr < 3, newrow = more && (krn != kr0);
            u32x4 nk = (u32x4){0u, 0u, 0u, 0u}, nv = nk, nq = nk;
            if (more) nq = *(const u32x4*)(zrow + (size_t)((r + 1) * 64 + scol) * ZA_LD);
            if (newrow) { const bf16_t* src = zrow + (size_t)((krn + 7) * 64 + scol) * ZA_LD; nk = *(const u32x4*)(src + 256); nv = *(const u32x4*)(src + 512); }
            __syncthreads();
            if (w < 4) {
                const int jt = w, c = 16 * jt + jl, cs = min(max(c - 8, 0), 48);
                const int ct_lo = jt < 2 ? 0 : jt - 1, nct = (jt == 0 || jt == 3) ? 2 : 3;
                bf16x8_n qf[2];
#pragma unroll
                for (int kk = 0; kk < 2; ++kk) qf[kk] = *(const LAS bf16x8_n*)(Qb + c * 144 + kk * 64 + quad * 16);
                f32x4 S[8][3]; float mx = -3.0e38f;
#pragma unroll
                for (int krow = 0; krow < 8; ++krow) { const int slot = (kr0 + krow) & 7; const int brow = (kr0 + krow - r + 7) * 31 - c + 15;
#pragma unroll
                    for (int t = 0; t < 3; ++t) { S[krow][t] = (f32x4){-3.0e38f, -3.0e38f, -3.0e38f, -3.0e38f};
                        if (t < nct) { const int ct = ct_lo + t; f32x4 sa = (f32x4){0.f, 0.f, 0.f, 0.f};
#pragma unroll
                            for (int kk = 0; kk < 2; ++kk) { const bf16x8_n ak = *(const LAS bf16x8_n*)(Kb + slot * 8192 + (16 * ct + jl) * 128 + (((kk * 4 + quad) ^ (jl & 7)) * 16));
                                sa = __builtin_amdgcn_mfma_f32_16x16x32_bf16(ak, qf[kk], sa, 0, 0, 0); }
#pragma unroll
                            for (int i = 0; i < 4; ++i) { const int kc = 16 * ct + 4 * quad + i; const bool valid = (kc >= cs) && (kc < cs + 16);
                                const float bias = Bs[valid ? brow + kc : 0];
                                const float sc = valid ? sa[i] * 0.125f + bias : -3.0e38f; S[krow][t][i] = sc; mx = fmaxf(mx, sc); } } } }
                mx = fmaxf(mx, __shfl_xor(mx, 16)); mx = fmaxf(mx, __shfl_xor(mx, 32));
                float sum = 0.f;
#pragma unroll
                for (int krow = 0; krow < 8; ++krow)
#pragma unroll
                    for (int t = 0; t < 3; ++t)
#pragma unroll
                        for (int i = 0; i < 4; ++i) { const float p = __expf(S[krow][t][i] - mx); S[krow][t][i] = p; sum += p; }
                sum += __shfl_xor(sum, 16); sum += __shfl_xor(sum, 32);
                const float inv = __builtin_amdgcn_rcpf(sum);
                f32x4 oacc[4];
#pragma unroll
                for (int et = 0; et < 4; ++et) oacc[et] = (f32x4){0.f, 0.f, 0.f, 0.f};
                LAS unsigned char* pw = Pw + w * 2304 + jl * 144;
#pragma unroll
                for (int krow = 0; krow < 8; ++krow) { const int slot = (kr0 + krow) & 7;
#pragma unroll
                    for (int t = 0; t < 3; ++t) if (t < nct) { const f32x4 p = S[krow][t] * inv; u32x2 pk; pk.x = pack2bf(p[0], p[1]); pk.y = pack2bf(p[2], p[3]);
                        *(LAS u32x2*)(pw + (16 * (ct_lo + t) + 4 * quad) * 2) = pk; }
                    asm volatile("s_waitcnt lgkmcnt(0)" ::: "memory");
#pragma unroll
                    for (int step = 0; step < 2; ++step) if ((step == 0 && jt != 3) || (step == 1 && jt != 0)) {
                        const bf16x8_n bp = *(const LAS bf16x8_n*)(pw + step * 64 + quad * 16);
#pragma unroll
                        for (int et = 0; et < 4; ++et) { const bf16x8_n av = *(const LAS bf16x8_n*)(VT + slot * 8192 + (16 * et + jl) * 128 + (((step * 4 + quad) ^ (jl & 7) ^ ((2 * et + (jl >> 3)) & 7)) * 16));
                            oacc[et] = __builtin_amdgcn_mfma_f32_16x16x32_bf16(av, bp, oacc[et], 0, 0, 0); } }
                    asm volatile("s_waitcnt lgkmcnt(0)" ::: "memory"); }
                float ss = 0.f;
#pragma unroll
                for (int et = 0; et < 4; ++et) ss += oacc[et][0] * oacc[et][0] + oacc[et][1] * oacc[et][1] + oacc[et][2] * oacc[et][2] + oacc[et][3] * oacc[et][3];
                ss += __shfl_xor(ss, 16); ss += __shfl_xor(ss, 32);
                const float rstd = rsqrtf(ss * (1.0f / 64.0f) + EPSF);
                const size_t tokq = (size_t)b * SEQL + r * 64 + c;
#pragma unroll
                for (int et = 0; et < 4; ++et) { u32x2 ww; ww.x = pack2bf(oacc[et][0] * rstd, oacc[et][1] * rstd); ww.y = pack2bf(oacc[et][2] * rstd, oacc[et][3] * rstd);
                    *(u32x2*)(XB + tokq * DM + 64 * h + 16 * et + 4 * quad) = ww; }
            }
            __syncthreads();
            if (more) *(LAS u32x4*)(Qb + scol * 144 + spart * 16) = nq;
            if (newrow) { const int slot = (krn + 7) & 7;
                *(LAS u32x4*)(Kb + slot * 8192 + scol * 128 + ((spart ^ (scol & 7)) * 16)) = nk;
                const unsigned va[4] = {nv.x, nv.y, nv.z, nv.w};
#pragma unroll
                for (int t = 0; t < 8; ++t) { const unsigned hv = (t & 1) ? (va[t >> 1] >> 16) : (va[t >> 1] & 0xffffu);
                    *(LAS bf16_t*)(VT + slot * 8192 + (spart * 8 + t) * 128 + (((scol >> 3) ^ t ^ spart) * 16) + (scol & 7) * 2) = (bf16_t)hv; } }
        }
    }
    __syncthreads();
}

typedef short bf16x8_t __attribute__((ext_vector_type(8)));
__device__ __forceinline__ float wave_incl_sum(float v, int lane) {
#pragma unroll
    for (int o = 1; o < 64; o <<= 1) { const float t = __shfl_up(v, o); if (lane >= o) v += t; }
    return v;
}
__device__ __forceinline__ float wave_incl_max_up(float v, int lane) {
#pragma unroll
    for (int o = 1; o < 64; o <<= 1) { const float t = __shfl_up(v, o); if (lane >= o) v = fmaxf(v, t); }
    return v;
}
__device__ __forceinline__ float wave_incl_max_down(float v, int lane) {
#pragma unroll
    for (int o = 1; o < 64; o <<= 1) { const float t = __shfl_down(v, o); if (lane + o < 64) v = fmaxf(v, t); }
    return v;
}
__device__ __forceinline__ void mlstm_gates(const Ctx& C, int l, int b, int h, int c, LAS float* lff, LAS float* lfb, LAS float* lif, LAS float* lib) {
    if (C.tid < 128) {
        const float* gates = (const float*)(C.ws + OFF_GATES) + ((size_t)b * SEQL + c * 128 + C.tid) * 16;
        const float* gb = C.in(18) + l * 16;
        lif[C.tid] = gates[h] + gb[h];
        lff[C.tid] = logsigmoidf_(gates[4 + h] + gb[4 + h]);
        lib[C.tid] = gates[8 + h] + gb[8 + h];
        lfb[C.tid] = logsigmoidf_(gates[12 + h] + gb[12 + h]);
    }
}
__device__ __forceinline__ void phase_mlstm_local(const Ctx& C, int l) {
    typedef short bf16x8_l __attribute__((ext_vector_type(8)));
    constexpr int VS = 136;
    LAS bf16_t* VT = (LAS bf16_t*)C.lds;
    LAS bf16_t* KfT = VT + 80 * VS;
    LAS bf16_t* KbT = KfT + 64 * VS;
    LAS float* sm = (LAS float*)(KbT + 64 * VS);
    LAS float* lff = sm, *lfb = sm + 128, *lif = sm + 256, *lib = sm + 384, *wf = sm + 512, *wbk = sm + 640;
    const bf16_t* zA = (const bf16_t*)(C.ws + OFF_Z);
    float* STS = (float*)(C.ws + OFF_STS); float* STN = (float*)(C.ws + OFF_STN); float* STC = (float*)(C.ws + OFF_STC);
    const int lane = C.lane, w = C.wid, jl = lane & 15, quad = lane >> 4;
    for (int task = C.bid; task < NSEQ * 4 * 64; task += C.nb) {
        const int c = task & 63, h = (task >> 6) & 3, b = task >> 8;
        const size_t tok0 = (size_t)b * SEQL + c * 128;
        const size_t sF = (size_t)((0 * 10 + b) * 4 + h) * 64 + c, sB = (size_t)((1 * 10 + b) * 4 + h) * 64 + c;
        mlstm_gates(C, l, b, h, c, lff, lfb, lif, lib);
        for (int e = C.tid; e < 16 * VS; e += NTHR) VT[64 * VS + e] = (e < 128) ? (bf16_t)0x3f80 : (bf16_t)0;
        __syncthreads();
        if (w == 0) { const float a0 = lff[2 * lane], a1 = lff[2 * lane + 1]; const float inc = wave_incl_sum(a0 + a1, lane); const float g = __shfl(inc, 63);
            const float x0 = g - (inc - a1) + lif[2 * lane], x1 = g - inc + lif[2 * lane + 1];
            const float m = wave_max(fmaxf(x0, x1));
            wf[2 * lane] = 0.125f * __expf(x0 - m); wf[2 * lane + 1] = 0.125f * __expf(x1 - m);
            if (lane == 0) { STC[sF * 4 + 0] = m; STC[sF * 4 + 1] = g; } }
        if (w == 1) { const float a0 = lfb[2 * lane], a1 = lfb[2 * lane + 1]; const float inc = wave_incl_sum(a0 + a1, lane); const float g = __shfl(inc, 63);
            const float b0 = g - (inc - a0 - a1), b1 = g - (inc - a1);
            const float x0 = g - b0 + lib[2 * lane], x1 = g - b1 + lib[2 * lane + 1];
            const float m = wave_max(fmaxf(x0, x1));
            wbk[2 * lane] = 0.125f * __expf(x0 - m); wbk[2 * lane + 1] = 0.125f * __expf(x1 - m);
            if (lane == 0) { STC[sB * 4 + 0] = m; STC[sB * 4 + 1] = g; } }
        __syncthreads();
#pragma unroll 2
        for (int e = C.tid; e < 1024; e += NTHR) { const int s = e & 127, part = e >> 7;
            const bf16_t* src = zA + (tok0 + s) * ZA_LD + 64 * h + part * 8;
            const u32x4 kv = *(const u32x4*)(src + 1024), vv = *(const u32x4*)(src + 1280);
            const unsigned ka[4] = {kv.x, kv.y, kv.z, kv.w}, va[4] = {vv.x, vv.y, vv.z, vv.w};
            const float wfs = wf[s], wbs = wbk[s];
#pragma unroll
            for (int i = 0; i < 4; ++i) { const int d0 = part * 8 + 2 * i; const float k0 = __uint_as_float(ka[i] << 16), k1 = __uint_as_float(ka[i] & 0xffff0000u);
                KfT[d0 * VS + s] = f2bf(k0 * wfs); KfT[(d0 + 1) * VS + s] = f2bf(k1 * wfs); KbT[d0 * VS + s] = f2bf(k0 * wbs); KbT[(d0 + 1) * VS + s] = f2bf(k1 * wbs);
                VT[d0 * VS + s] = (bf16_t)(va[i] & 0xffffu); VT[(d0 + 1) * VS + s] = (bf16_t)(va[i] >> 16); } }
        __syncthreads();
        { const int dir = w >> 2, dt = w & 3; const LAS bf16_t* KT = dir ? KbT : KfT; const size_t sD = dir ? sB : sF;
          bf16x8_l kf[4];
#pragma unroll
          for (int kk = 0; kk < 4; ++kk) kf[kk] = *(const LAS bf16x8_l*)(KT + (16 * dt + jl) * VS + kk * 32 + quad * 8);
          const int d = 16 * dt + jl;
#pragma unroll
          for (int et = 0; et < 5; ++et) { f32x4 acc = (f32x4){0.f, 0.f, 0.f, 0.f};
#pragma unroll
              for (int kk = 0; kk < 4; ++kk) { const bf16x8_l av = *(const LAS bf16x8_l*)(VT + (16 * et + jl) * VS + kk * 32 + quad * 8); acc = __builtin_amdgcn_mfma_f32_16x16x32_bf16(av, kf[kk], acc, 0, 0, 0); }
              if (et < 4) *(f32x4*)(STS + sD * 4096 + d * 64 + 16 * et + 4 * quad) = acc;
              else if (quad == 0) STN[sD * 64 + d] = acc[0]; } }
        __syncthreads();
    }
}
__device__ __forceinline__ void phase_mlstm_scan(const Ctx& C) {
    float* STS = (float*)(C.ws + OFF_STS); float* STN = (float*)(C.ws + OFF_STN); float* STC = (float*)(C.ws + OFF_STC);
    for (int idx = C.bid * NTHR + C.tid; idx < 80 * 4160; idx += C.nb * NTHR) {
        const int scan = idx / 4160, e = idx - scan * 4160, dir = scan / 40;
        float* base; int stride;
        if (e < 4096) { base = STS + (size_t)scan * 64 * 4096 + e; stride = 4096; } else { base = STN + (size_t)scan * 64 * 64 + (e - 4096); stride = 64; }
        float* sc = STC + (size_t)scan * 64 * 4;
        float st = 0.f, m = 0.f;
#pragma unroll 1
        for (int s0 = 0; s0 < 64; s0 += 8) {
            float loc[8], ml[8], gg[8];
#pragma unroll
            for (int u = 0; u < 8; ++u) { const int c = dir ? 63 - (s0 + u) : s0 + u; loc[u] = base[(size_t)c * stride]; ml[u] = sc[c * 4 + 0]; gg[u] = sc[c * 4 + 1]; }
#pragma unroll
            for (int u = 0; u < 8; ++u) { const int c = dir ? 63 - (s0 + u) : s0 + u;
                base[(size_t)c * stride] = st; if (e == 0) sc[c * 4 + 2] = m;
                const float mn = fmaxf(gg[u] + m, ml[u]); const float dold = __expf(gg[u] + m - mn), dnew = __expf(ml[u] - mn);
                st = dold * st + dnew * loc[u]; m = mn; }
        }
    }
}
__device__ __forceinline__ void phase_mlstm_out(const Ctx& C, int l) {
    constexpr int QS = 72, VS = 136;
    LAS bf16_t* Qb = (LAS bf16_t*)C.lds;
    LAS bf16_t* Kb = Qb + 128 * QS;
    LAS bf16_t* VT = Kb + 128 * QS;
    LAS bf16_t* SfT = VT + 64 * VS;
    LAS bf16_t* SbT = SfT + 64 * QS;
    LAS bf16_t* Pb = SbT + 64 * QS;
    LAS float* sm = (LAS float*)(Pb + 128 * VS);
    LAS float* lff = sm, *lfb = sm + 128, *lif = sm + 256, *lib = sm + 384, *bfw = sm + 512, *bbw = sm + 640, *cF = sm + 768, *cB = sm + 896,
             *mtF = sm + 1024, *mtB = sm + 1152, *wiF = sm + 1280, *wiB = sm + 1408, *qnF = sm + 1536, *qnB = sm + 1664, *n0f = sm + 1792, *n0b = sm + 1856;
    const bf16_t* zA = (const bf16_t*)(C.ws + OFF_Z);
    bf16_t* XB = (bf16_t*)(C.ws + OFF_XB);
    const float* STS = (const float*)(C.ws + OFF_STS); const float* STN = (const float*)(C.ws + OFF_STN); const float* STC = (const float*)(C.ws + OFF_STC);
    const int lane = C.lane, w = C.wid, jl = lane & 15, quad = lane >> 4;
    for (int task = C.bid; task < NSEQ * 4 * 64; task += C.nb) {
        const int c = task & 63, h = (task >> 6) & 3, b = task >> 8;
        const size_t tok0 = (size_t)b * SEQL + c * 128;
        const size_t sF = (size_t)((0 * 10 + b) * 4 + h) * 64 + c, sB = (size_t)((1 * 10 + b) * 4 + h) * 64 + c;
#pragma unroll 2
        for (int e = C.tid; e < 1024; e += NTHR) { const int s = e & 127, part = e >> 7;
            const bf16_t* src = zA + (tok0 + s) * ZA_LD + 64 * h + part * 8;
            const u32x4 qv = *(const u32x4*)(src + 768), kv = *(const u32x4*)(src + 1024), vv = *(const u32x4*)(src + 1280);
            *(LAS u32x4*)(Qb + s * QS + part * 8) = qv; *(LAS u32x4*)(Kb + s * QS + part * 8) = kv;
            const unsigned va[4] = {vv.x, vv.y, vv.z, vv.w};
#pragma unroll
            for (int i = 0; i < 4; ++i) { VT[(part * 8 + 2 * i) * VS + s] = (bf16_t)(va[i] & 0xffffu); VT[(part * 8 + 2 * i + 1) * VS + s] = (bf16_t)(va[i] >> 16); } }
#pragma unroll 2
        for (int e = C.tid; e < 1024; e += NTHR) { const int d = e & 63, e4 = (e >> 6) * 4;
            const f32x4 f = *(const f32x4*)(STS + sF * 4096 + d * 64 + e4), g = *(const f32x4*)(STS + sB * 4096 + d * 64 + e4);
#pragma unroll
            for (int i = 0; i < 4; ++i) { SfT[(e4 + i) * QS + d] = f2bf(f[i]); SbT[(e4 + i) * QS + d] = f2bf(g[i]); } }
        if (C.tid < 64) n0f[C.tid] = STN[sF * 64 + C.tid]; else if (C.tid < 128) n0b[C.tid - 64] = STN[sB * 64 + C.tid - 64];
        mlstm_gates(C, l, b, h, c, lff, lfb, lif, lib);
        const float m0f = STC[sF * 4 + 2], m0b = STC[sB * 4 + 2];
        __syncthreads();
        if (w == 0) { const float a0 = lff[2 * lane], a1 = lff[2 * lane + 1]; const float inc = wave_incl_sum(a0 + a1, lane);
            const float b0 = inc - a1, b1 = inc; bfw[2 * lane] = b0; bfw[2 * lane + 1] = b1;
            const float c0 = lif[2 * lane] - b0, c1 = lif[2 * lane + 1] - b1; cF[2 * lane] = c0; cF[2 * lane + 1] = c1;
            const float pm = wave_incl_max_up(fmaxf(c0, c1), lane); float pprev = __shfl_up(pm, 1); if (lane == 0) pprev = -3.0e38f;
            const float cm0 = fmaxf(pprev, c0), cm1 = pm;
            const float mf0 = b0 + fmaxf(m0f, cm0), mf1 = b1 + fmaxf(m0f, cm1);
            mtF[2 * lane] = mf0; mtF[2 * lane + 1] = mf1; wiF[2 * lane] = __expf(b0 + m0f - mf0); wiF[2 * lane + 1] = __expf(b1 + m0f - mf1); }
        if (w == 1) { const float a0 = lfb[2 * lane], a1 = lfb[2 * lane + 1]; const float inc = wave_incl_sum(a0 + a1, lane); const float tot = __shfl(inc, 63);
            const float b0 = tot - (inc - a0 - a1), b1 = tot - (inc - a1); bbw[2 * lane] = b0; bbw[2 * lane + 1] = b1;
            const float c0 = lib[2 * lane] - b0, c1 = lib[2 * lane + 1] - b1; cB[2 * lane] = c0; cB[2 * lane + 1] = c1;
            const float pm = wave_incl_max_down(fmaxf(c0, c1), lane); float pnext = __shfl_down(pm, 1); if (lane == 63) pnext = -3.0e38f;
            const float cm0 = pm, cm1 = fmaxf(pnext, c1);
            const float mb0 = b0 + fmaxf(m0b, cm0), mb1 = b1 + fmaxf(m0b, cm1);
            mtB[2 * lane] = mb0; mtB[2 * lane + 1] = mb1; wiB[2 * lane] = __expf(b0 + m0b - mb0); wiB[2 * lane + 1] = __expf(b1 + m0b - mb1); }
        { const int j = C.tid >> 2, part = C.tid & 3; float a = 0.f, a2 = 0.f;
#pragma unroll
          for (int i = 0; i < 16; i += 2) { const unsigned qq = *(const LAS unsigned*)(Qb + j * QS + part * 16 + i);
              const float q0 = __uint_as_float(qq << 16), q1 = __uint_as_float(qq & 0xffff0000u);
              a += q0 * n0f[part * 16 + i] + q1 * n0f[part * 16 + i + 1]; a2 += q0 * n0b[part * 16 + i] + q1 * n0b[part * 16 + i + 1]; }
          a += __shfl_xor(a, 1); a += __shfl_xor(a, 2); a2 += __shfl_xor(a2, 1); a2 += __shfl_xor(a2, 2);
          if (part == 0) { qnF[j] = a; qnB[j] = a2; } }
        __syncthreads();
        const int j = 16 * w + jl;
        bf16x8_t qf[2];
#pragma unroll
        for (int kk = 0; kk < 2; ++kk) qf[kk] = *(const LAS bf16x8_t*)(Qb + j * QS + kk * 32 + quad * 8);
        u32x2 ogate[4];
#pragma unroll
        for (int et = 0; et < 4; ++et) ogate[et] = *(const u32x2*)(zA + (tok0 + j) * ZA_LD + 1536 + 64 * h + 16 * et + 4 * quad);
        f32x4 accF[4], accB[4];
#pragma unroll
        for (int et = 0; et < 4; ++et) { accF[et] = (f32x4){0.f, 0.f, 0.f, 0.f}; accB[et] = (f32x4){0.f, 0.f, 0.f, 0.f};
#pragma unroll
            for (int kk = 0; kk < 2; ++kk) { const bf16x8_t af = *(const LAS bf16x8_t*)(SfT + (16 * et + jl) * QS + kk * 32 + quad * 8), ab = *(const LAS bf16x8_t*)(SbT + (16 * et + jl) * QS + kk * 32 + quad * 8);
                accF[et] = __builtin_amdgcn_mfma_f32_16x16x32_bf16(af, qf[kk], accF[et], 0, 0, 0); accB[et] = __builtin_amdgcn_mfma_f32_16x16x32_bf16(ab, qf[kk], accB[et], 0, 0, 0); } }
        const float ef = bfw[j] - mtF[j], ebk = bbw[j] - mtB[j];
        f32x4 pf[8], pb[8]; float rsf = 0.f, rsb = 0.f;
#pragma unroll
        for (int st = 0; st < 8; ++st) { f32x4 sa = (f32x4){0.f, 0.f, 0.f, 0.f};
#pragma unroll
            for (int kk = 0; kk < 2; ++kk) { const bf16x8_t ak = *(const LAS bf16x8_t*)(Kb + (16 * st + jl) * QS + kk * 32 + quad * 8); sa = __builtin_amdgcn_mfma_f32_16x16x32_bf16(ak, qf[kk], sa, 0, 0, 0); }
            const int s0 = 16 * st + 4 * quad;
            const f32x4 cf4 = *(const LAS f32x4*)(cF + s0), cb4 = *(const LAS f32x4*)(cB + s0);
#pragma unroll
            for (int i = 0; i < 4; ++i) { const int s = s0 + i; const float sv = sa[i] * 0.125f;
                const float x = (s <= j) ? __expf(ef + cf4[i]) * sv : 0.f, y = (s >= j) ? __expf(ebk + cb4[i]) * sv : 0.f;
                pf[st][i] = x; pb[st][i] = y; rsf += x; rsb += y; } }
        rsf += __shfl_xor(rsf, 16); rsf += __shfl_xor(rsf, 32); rsb += __shfl_xor(rsb, 16); rsb += __shfl_xor(rsb, 32);
        const float denF = wiF[j] * qnF[j] + rsf, denB = wiB[j] * qnB[j] + rsb;
        const float rF = __builtin_amdgcn_rcpf(fmaxf(fabsf(denF), __expf(-mtF[j]))), rB = __builtin_amdgcn_rcpf(fmaxf(fabsf(denB), __expf(-mtB[j])));
        const float aF = wiF[j] * rF, aB = wiB[j] * rB;
#pragma unroll
        for (int st = 0; st < 8; ++st) { const f32x4 pc = pf[st] * rF + pb[st] * rB; u32x2 pw; pw.x = pack2bf(pc[0], pc[1]); pw.y = pack2bf(pc[2], pc[3]);
            *(LAS u32x2*)(Pb + j * VS + 16 * st + 4 * quad) = pw; }
        asm volatile("s_waitcnt lgkmcnt(0)" ::: "memory");
        f32x4 oacc[4];
#pragma unroll
        for (int et = 0; et < 4; ++et) { oacc[et] = accF[et] * aF + accB[et] * aB;
#pragma unroll
            for (int kk = 0; kk < 4; ++kk) { const bf16x8_t av = *(const LAS bf16x8_t*)(VT + (16 * et + jl) * VS + kk * 32 + quad * 8), bp = *(const LAS bf16x8_t*)(Pb + j * VS + kk * 32 + quad * 8);
                oacc[et] = __builtin_amdgcn_mfma_f32_16x16x32_bf16(av, bp, oacc[et], 0, 0, 0); } }
        { const size_t tok = tok0 + j; float ss = 0.f; f32x4 val[4];
#pragma unroll
          for (int et = 0; et < 4; ++et) { const u32x2 ow = ogate[et];
              val[et][0] = sigmoidf_(__uint_as_float(ow.x << 16)) * oacc[et][0]; val[et][1] = sigmoidf_(__uint_as_float(ow.x & 0xffff0000u)) * oacc[et][1];
              val[et][2] = sigmoidf_(__uint_as_float(ow.y << 16)) * oacc[et][2]; val[et][3] = sigmoidf_(__uint_as_float(ow.y & 0xffff0000u)) * oacc[et][3];
              ss += val[et][0] * val[et][0] + val[et][1] * val[et][1] + val[et][2] * val[et][2] + val[et][3] * val[et][3]; }
          ss += __shfl_xor(ss, 16); ss += __shfl_xor(ss, 32);
          const float rstd = rsqrtf(ss * (1.0f / 64.0f) + EPSF);
#pragma unroll
          for (int et = 0; et < 4; ++et) { u32x2 ww; ww.x = pack2bf(val[et][0] * rstd, val[et][1] * rstd); ww.y = pack2bf(val[et][2] * rstd, val[et][3] * rstd);
              *(u32x2*)(XB + tok * DM + 768 + 64 * h + 16 * et + 4 * quad) = ww; } }
        __syncthreads();
    }
}

#ifndef NO_MIXERS
#define NO_MIXERS 0
#endif
__device__ __forceinline__ void grid_barrier(unsigned* bar, unsigned target) {
    __syncthreads();
    if (threadIdx.x == 0) {
        __threadfence();
        __hip_atomic_fetch_add(bar, 1u, __ATOMIC_RELAXED, __HIP_MEMORY_SCOPE_AGENT);
        while (__hip_atomic_load(bar, __ATOMIC_RELAXED, __HIP_MEMORY_SCOPE_AGENT) < target) __builtin_amdgcn_s_sleep(1);
        __threadfence();
    }
    __syncthreads();
}
__global__ void __launch_bounds__(NTHR, 2) mk_fwd(Params P) {
    extern __shared__ __attribute__((aligned(16))) unsigned char lds_raw[];
    cg::grid_group grid = cg::this_grid();
    Ctx C; C.tid = threadIdx.x; C.lane = C.tid & 63; C.wid = __builtin_amdgcn_readfirstlane(C.tid >> 6); C.bid = blockIdx.x; C.nb = gridDim.x; C.lds = (LAS unsigned char*)lds_raw;
    if (C.tid == 0) { LAS unsigned long long* sp = (LAS unsigned long long*)(C.lds + PARAM_OFF);
#pragma unroll
        for (int i = 0; i < 29; ++i) sp[i] = (unsigned long long)P.in[i];
        sp[29] = (unsigned long long)P.out; sp[30] = (unsigned long long)P.ws; }
    __syncthreads();
    unsigned char* ws = C.gptr(30); C.ws = ws;
    bf16_t* XB = (bf16_t*)(ws + OFF_XB);
    bf16_t* zA = (bf16_t*)(ws + OFF_Z);
    bf16_t* zB = (bf16_t*)(ws + OFF_ZB);
    bf16_t* ACT = (bf16_t*)(ws + OFF_Z);
    bf16_t* PROJ = (bf16_t*)(ws + OFF_Z);
    bf16_t* PB = (bf16_t*)(ws + OFF_PB);
    float* out = (float*)C.gptr(29);
#ifndef PROBE_GROUP
#define PROBE_GROUP 0
#endif
    unsigned long long tacc = 0ull, tbeg = 0ull;
#define TB(g) do { if (PROBE_GROUP & (1 << (g))) tbeg = __builtin_amdgcn_s_memrealtime(); } while (0)
#define TE(g) do { if (PROBE_GROUP & (1 << (g))) tacc += __builtin_amdgcn_s_memrealtime() - tbeg; } while (0)

    unsigned* gbar = (unsigned*)(ws + OFF_BAR); unsigned gcount = 0;
    if (C.bid == 0 && C.tid == 0) __hip_atomic_store(gbar, 0u, __ATOMIC_RELAXED, __HIP_MEMORY_SCOPE_AGENT);
#define GSYNC() do { gcount += (unsigned)C.nb; grid_barrier((unsigned*)(C.gptr(30) + OFF_BAR), gcount); } while (0)
    TB(10); phase_prep0a(C);
    phase_norm(C.in(0), C.in(1), C, C.in(5), C.in(4));
    grid.sync();
    phase_weights(C);
#if !NO_MIXERS
    phase_kspec(C, 0);
#endif
    GSYNC(); TE(10);

#define FRESH() do { asm volatile("" : "+s"(l)); { LAS unsigned char* lp_ = (LAS unsigned char*)lds_raw; asm volatile("" : "+s"(lp_)); C.lds = lp_; } asm volatile("" : "+v"(C.tid)); C.lane = C.tid & 63; C.wid = __builtin_amdgcn_readfirstlane(C.tid >> 6); asm volatile("" : "+s"(C.bid), "+s"(C.nb)); ws = C.gptr(30); C.ws = ws; \
        XB = (bf16_t*)(ws + OFF_XB); zA = (bf16_t*)(ws + OFF_Z); zB = (bf16_t*)(ws + OFF_ZB); ACT = zA; PROJ = zA; PB = (bf16_t*)(ws + OFF_PB); out = (float*)C.gptr(29); wb = ws + OFF_W + (size_t)l * W_LAYER; } while (0)
    for (int l = 0; l < 2; ++l) {
        unsigned char* wb = ws + OFF_W + (size_t)l * W_LAYER;
        TB(1); __syncthreads(); FRESH();
        { pg8::Gemm g{XB, (const bf16_t*)(wb + W_INA), T_TOK, ZA_LD, DM}; pg8::StaticOrder S; S.init(T_TOK, ZA_LD, C.nb, C.bid);
          pg8::EpiBf16<0> E{zA, ZA_LD, nullptr, 0, 0}; pg8::gemm_phase<pg8::EpiBf16<0>, pg8::StaticOrder>(C.lds, g, S, E, nullptr); }
        __syncthreads(); FRESH();
        { pg8::Gemm g{(const bf16_t*)(wb + W_INB), XB, ZB_ROWS, T_TOK, DM}; pg8::StaticOrder S; S.init(ZB_ROWS, T_TOK, C.nb, (C.bid + ((T_TOK / 256) * (ZA_LD / 256)) % C.nb) % C.nb);
          pg8::EpiBf16<0> E{zB, T_TOK, nullptr, 0, 0}; pg8::gemm_phase<pg8::EpiBf16<0>, pg8::StaticOrder>(C.lds, g, S, E, nullptr); }
        __syncthreads();
#if !NO_MIXERS
        FRESH(); if (l == 1) phase_kspec(C, 1);
#endif
        GSYNC(); TE(1);
#if !NO_MIXERS
        TB(2); TB(17); FRESH(); phase_mlstm_local(C, l); TE(17);
        TB(11); FRESH(); phase_hyena(C, l); TE(11);
        GSYNC(); TE(2);
        TB(3); TB(14); FRESH(); phase_mlstm_scan(C); TE(14);
        TB(12); FRESH(); phase_fnet(C); TE(12);
        TB(13); FRESH(); phase_na(C, l); TE(13);
        GSYNC(); TE(3);
        TB(4); TB(16); FRESH(); phase_mlstm_out(C, l); TE(16);
        TB(15); FRESH(); phase_headnorm_cm(C); TE(15);
        GSYNC(); TE(4);
#else
        for (size_t i = (size_t)C.bid * NTHR + C.tid; i < (size_t)T_TOK * DM / 8; i += (size_t)C.nb * NTHR) ((u32x4*)XB)[i] = (u32x4){0u, 0u, 0u, 0u};
        GSYNC();
#endif
        TB(5); __syncthreads(); FRESH();
        { pg8::Gemm g{XB, (const bf16_t*)(wb + W_OUT), T_TOK, DM, DM}; pg8::StaticOrder S; S.init(T_TOK, DM, C.nb, C.bid);
          EpiResF32 E{l == 0 ? C.in(0) : out, l == 0 ? C.in(1) : out + (size_t)T_PROMPT * DM, out}; pg8::gemm_phase<EpiResF32, pg8::StaticOrder>(C.lds, g, S, E, nullptr); }
        GSYNC(); TE(5);
        TB(6); FRESH(); phase_norm(out, out + (size_t)T_PROMPT * DM, C, nullptr, nullptr);
        FRESH(); phase_pconv(C.in(2) + (size_t)l * T_PROMPT * 256, C.in(3) + (size_t)l * (T_TOK - T_PROMPT) * 256, C);
        GSYNC(); TE(6);
        TB(7); __syncthreads(); FRESH();
        { pg8::Gemm g{XB, (const bf16_t*)(wb + W_GU), T_TOK, 2 * DFF, DM}; pg8::StaticOrder S; S.init(T_TOK, 2 * DFF, C.nb, C.bid);
          EpiSwiGLU E{ACT}; pg8::gemm_phase<EpiSwiGLU, pg8::StaticOrder>(C.lds, g, S, E, nullptr); }
        GSYNC(); TE(7);
        TB(8); __syncthreads(); FRESH();
        { pg8::Gemm g{ACT, (const bf16_t*)(wb + W_DOWN), T_TOK, DM, DFF}; pg8::StaticOrder S; S.init(T_TOK, DM, C.nb, C.bid);
          EpiResF32 E{out, out + (size_t)T_PROMPT * DM, out}; pg8::gemm_phase<EpiResF32, pg8::StaticOrder>(C.lds, g, S, E, nullptr); }
        GSYNC(); TE(8);
        TB(6); FRESH(); phase_norm(out, out + (size_t)T_PROMPT * DM, C, nullptr, nullptr); TE(6);
        TB(9); __syncthreads(); FRESH();
        { pg8::Gemm g{PB, (const bf16_t*)(wb + W_PP), T_TOK, DM, 256}; pg8::StaticOrder S; S.init(T_TOK, DM, C.nb, C.bid);
          pg8::EpiBf16<0> E{PROJ, DM, nullptr, 0, 0}; pg8::gemm_phase<pg8::EpiBf16<0>, pg8::StaticOrder>(C.lds, g, S, E, nullptr); }
        GSYNC();
        __syncthreads(); FRESH();
        { pg8::Gemm g{XB, (const bf16_t*)(wb + W_PG), T_TOK, DM, DM}; pg8::StaticOrder S; S.init(T_TOK, DM, C.nb, C.bid);
          EpiPle E{out, PROJ}; pg8::gemm_phase<EpiPle, pg8::StaticOrder>(C.lds, g, S, E, nullptr); }
        GSYNC(); TE(9);
        TB(6); FRESH();
        if (l == 0) { phase_norm(out, out + (size_t)T_PROMPT * DM, C, C.in(5) + (size_t)DM * NIN, C.in(4) + DM); GSYNC(); }
        else phase_final_norm(out, C.in(28), C);
        TE(6);
    }
#if PROBE_GROUP
    if (C.bid == 0) { if (C.tid == 0) { const unsigned long long t0 = __builtin_amdgcn_s_memrealtime(); while (__builtin_amdgcn_s_memrealtime() - t0 < tacc) __builtin_amdgcn_s_sleep(8); } __syncthreads(); }
#endif
}

extern "C" void kernel_launch(void* const* d_in, const int* in_sizes, int n_in, void* d_out, int out_size, void* d_ws, size_t ws_size, hipStream_t stream) {
    static int grid_blocks = 0;
    if (grid_blocks == 0) {
        if (n_in != 29 || ws_size < WS_END) { fprintf(stderr, "kernel_launch: unexpected n_in %d or workspace %zu < %zu\n", n_in, ws_size, (size_t)WS_END); grid_blocks = -1; return; }
        int dev = 0, cus = 0, per_cu = 0;
        hipGetDevice(&dev);
        hipDeviceGetAttribute(&cus, hipDeviceAttributeMultiprocessorCount, dev);
        if (hipFuncSetAttribute((const void*)mk_fwd, hipFuncAttributeMaxDynamicSharedMemorySize, LDS_BYTES) != hipSuccess) { fprintf(stderr, "kernel_launch: hipFuncSetAttribute failed\n"); grid_blocks = -1; return; }
        if (hipOccupancyMaxActiveBlocksPerMultiprocessor(&per_cu, (const void*)mk_fwd, NTHR, LDS_BYTES) != hipSuccess || per_cu < 1) { fprintf(stderr, "kernel_launch: occupancy query says %d\n", per_cu); per_cu = 1; }
        (void)hipGetLastError();
        grid_blocks = cus * per_cu;
    }
    if (grid_blocks < 0) return;
    Params p{};
    for (int i = 0; i < 29; ++i) p.in[i] = (const float*)d_in[i];
    p.out = (float*)d_out; p.ws = (unsigned char*)d_ws;
    void* args[] = {&p};
    hipError_t e = hipLaunchCooperativeKernel((const void*)mk_fwd, dim3(grid_blocks), dim3(NTHR), args, LDS_BYTES, stream);
    if (e != hipSuccess) fprintf(stderr, "cooperative launch failed: %s (grid %d)\n", hipGetErrorString(e), grid_blocks);
}
```
